# Optimizing an MI355X kernel written in HIP

```python
import jax, jax.numpy as jnp
from jax import lax
import numpy as np

D_MODEL = 1024
BATCH = 16
SEQ = 2048
DEPTH = 2

GRID_W = 64
CTX_LEN = 256
N_MIXERS = 2
N_HGRN_LAYERS = (DEPTH + 1) // 2
N_MLSTM_LAYERS = DEPTH // 2
EPS = 1e-6
HG_HEADS = 8
HG_DK = D_MODEL // HG_HEADS
HG_DV = D_MODEL // HG_HEADS
HG_CHUNK = 64
ML_HEADS = 8
ML_QK = D_MODEL // 2
ML_V = D_MODEL
ML_DK = ML_QK // ML_HEADS
ML_DV = ML_V // ML_HEADS
ML_CHUNK = 64
GATE_CAP = 15.0
CONV_K = 3
FGATE_BIAS_LO = 3.0
FGATE_BIAS_HI = 6.0
N_EXPERTS = 32
TOP_K = 4
D_FF = D_MODEL
SWIGLU_LIMIT = 7.0
SWIGLU_ALPHA = 1.702
MOE_BLOCK = 256

kernel_name = "hybrid_hgrn2_mlstm_moe_flow_backbone"


def _split_heads(a, n_heads):
    b, l, _ = a.shape
    return a.reshape(b, l, n_heads, -1).transpose(0, 2, 1, 3)


def _merge_heads(a):
    b, h, l, d = a.shape
    return a.transpose(0, 2, 1, 3).reshape(b, l, h * d)


def _to_chunks(a, size):
    b, h, l = a.shape[:3]
    a = a.reshape(b, h, l // size, size, *a.shape[3:])
    return jnp.moveaxis(a, 2, 0)


def _from_chunks(a):
    n, b, h, size = a.shape[:4]
    return jnp.moveaxis(a, 0, 2).reshape(b, h, n * size, *a.shape[4:])


def rms_norm(x, g):
    x32 = x.astype(jnp.float32)
    y = x32 * lax.rsqrt(jnp.mean(x32 * x32, axis=-1, keepdims=True) + EPS)
    return (y * g.astype(jnp.float32)).astype(x.dtype)


def head_rms_norm(a, g, n_heads):
    b, l, d = a.shape
    a32 = a.astype(jnp.float32).reshape(b, l, n_heads, d // n_heads)
    a32 = a32 * lax.rsqrt(jnp.mean(a32 * a32, axis=-1, keepdims=True) + EPS)
    return a32.reshape(b, l, d) * g.astype(jnp.float32)


def modulate(x, g, shift, scale):
    return rms_norm(x, g) * (1 + scale) + shift


def run_direction(scan_fn, ctx_args, lat_args, init, reverse):
    flip = (lambda a: jnp.flip(a, axis=2)) if reverse else (lambda a: a)
    o_ctx, ctx_state = scan_fn(*[flip(a) for a in ctx_args], init)
    o_lat, _ = scan_fn(*[flip(a) for a in lat_args], ctx_state)
    return flip(o_ctx), flip(o_lat)


def hgrn2_scan(q, k, v, logf, s0):
    q, k, v, logf = [a.astype(jnp.float32) for a in (q, k, v, logf)]
    size = HG_CHUNK
    mid = size // 2
    tril = jnp.tril(jnp.ones((size, size), bool))

    def body(s, xs):
        qc, kc, vc, lc = xs
        b = jnp.cumsum(lc, axis=2)
        b_ref = b[:, :, mid:mid + 1]
        att = jnp.einsum('bhtd,bhsd->bhts', qc * jnp.exp(b - b_ref), kc * jnp.exp(b_ref - b))
        att = jnp.where(tril, att, 0.0)
        o = jnp.einsum('bhts,bhse->bhte', att, vc) + jnp.einsum('bhtd,bhde->bhte', qc * jnp.exp(b), s)
        b_end = b[:, :, -1:]
        s_new = jnp.exp(b_end[:, :, 0])[..., None] * s + jnp.einsum('bhsd,bhse->bhde', kc * jnp.exp(b_end - b), vc)
        return s_new, o

    xs = tuple(_to_chunks(a, size) for a in (q, k, v, logf))
    s_final, o = lax.scan(body, s0.astype(jnp.float32), xs)
    return _from_chunks(o), s_final


def mlstm_scan(q, k, v, ig, logf, state):
    q, k, v, ig, logf = [a.astype(jnp.float32) for a in (q, k, v, ig, logf)]
    size = ML_CHUNK
    tril = jnp.tril(jnp.ones((size, size), bool))

    def body(carry, xs):
        c0, n0, m0 = carry
        qc, kc, vc, ic, fc = xs
        b = jnp.cumsum(fc, axis=-1)
        dmat = jnp.where(tril, b[..., :, None] - b[..., None, :] + ic[..., None, :], -jnp.inf)
        inter_log = b + m0[..., None]
        m_t = jnp.maximum(inter_log, jnp.max(dmat, axis=-1))
        w_intra = jnp.exp(dmat - m_t[..., None])
        w_inter = jnp.exp(inter_log - m_t)
        sc = jnp.einsum('bhtd,bhsd->bhts', qc, kc) * w_intra
        num = jnp.einsum('bhts,bhse->bhte', sc, vc) + w_inter[..., None] * jnp.einsum('bhtd,bhde->bhte', qc, c0)
        den = jnp.sum(sc, axis=-1) + w_inter * jnp.einsum('bhtd,bhd->bht', qc, n0)
        h = num / jnp.maximum(jnp.abs(den), jnp.exp(-m_t))[..., None]
        b_end = b[..., -1]
        g = b_end[..., None] - b + ic
        m_new = jnp.maximum(b_end + m0, jnp.max(g, axis=-1))
        wk = jnp.exp(g - m_new[..., None])
        decay = jnp.exp(b_end + m0 - m_new)
        c_new = decay[..., None, None] * c0 + jnp.einsum('bhs,bhsd,bhse->bhde', wk, kc, vc)
        n_new = decay[..., None] * n0 + jnp.einsum('bhs,bhsd->bhd', wk, kc)
        return (c_new, n_new, m_new), h

    xs = tuple(_to_chunks(a, size) for a in (q, k, v, ig, logf))
    final, h = lax.scan(body, state, xs)
    return _from_chunks(h), final


def short_conv(u, w, bias, on_grid):
    b, l, ch = u.shape
    if on_grid:
        rows = l // GRID_W
        y = lax.conv_general_dilated(u.reshape(b, rows, GRID_W, ch), w[:, :, None, :], (1, 1), 'SAME',
                                     dimension_numbers=('NHWC', 'HWIO', 'NHWC'), feature_group_count=ch)
        y = y.reshape(b, l, ch)
    else:
        y = lax.conv_general_dilated(u, w[CONV_K // 2][:, None, :], (1,), 'SAME',
                                     dimension_numbers=('NWC', 'WIO', 'NWC'), feature_group_count=ch)
    return jax.nn.silu(y + bias)


def hgrn2_mixer(h_ctx, h_lat, w_in, lb_fwd, lb_bwd, norm_g, w_out, need_ctx):
    def prep(h):
        q, i, zf, zb, g = jnp.split(h @ w_in, 5, axis=-1)
        f_f = lb_fwd + (1.0 - lb_fwd) * jax.nn.sigmoid(zf.astype(jnp.float32))
        f_b = lb_bwd + (1.0 - lb_bwd) * jax.nn.sigmoid(zb.astype(jnp.float32))
        sh = lambda a: _split_heads(a, HG_HEADS)
        fwd = (sh(jax.nn.silu(q)), sh(1.0 - f_f), sh(i), sh(jnp.log(f_f)))
        bwd = (sh(jax.nn.silu(q)), sh(1.0 - f_b), sh(i), sh(jnp.log(f_b)))
        return fwd, bwd, g

    fwd_c, bwd_c, g_c = prep(h_ctx)
    fwd_l, bwd_l, g_l = prep(h_lat)
    s0 = jnp.zeros((h_lat.shape[0], HG_HEADS, HG_DK, HG_DV), jnp.float32)
    of_c, of_l = run_direction(hgrn2_scan, fwd_c, fwd_l, s0, False)
    ob_c, ob_l = run_direction(hgrn2_scan, bwd_c, bwd_l, s0, True)

    def readout(o, g, dtype):
        y = head_rms_norm(_merge_heads(o), norm_g, HG_HEADS) * jax.nn.silu(g.astype(jnp.float32))
        return y.astype(dtype) @ w_out

    y_lat = readout(of_l + ob_l, g_l, h_lat.dtype)
    y_ctx = readout(of_c + ob_c, g_c, h_ctx.dtype) if need_ctx else None
    return y_ctx, y_lat


def mlstm_mixer(h_ctx, h_lat, w_in, b_gate, conv_w, conv_b, norm_g, w_out, need_ctx):
    def prep(h, on_grid):
        qk, v, o, gates = jnp.split(h @ w_in, [2 * ML_QK, 2 * ML_QK + ML_V, 2 * ML_QK + 2 * ML_V], axis=-1)
        q, k = jnp.split(short_conv(qk, conv_w, conv_b, on_grid), 2, axis=-1)
        gates = GATE_CAP * jnp.tanh((gates.astype(jnp.float32) + b_gate) / GATE_CAP)
        i_f, i_b, f_f, f_b = [a.transpose(0, 2, 1) for a in jnp.split(gates, 4, axis=-1)]
        qh = _split_heads(q, ML_HEADS) * (ML_DK ** -0.5)
        kh = _split_heads(k, ML_HEADS)
        vh = _split_heads(v, ML_HEADS)
        fwd = (qh, kh, vh, i_f, jax.nn.log_sigmoid(f_f))
        bwd = (qh, kh, vh, i_b, jax.nn.log_sigmoid(f_b))
        return fwd, bwd, o

    fwd_c, bwd_c, o_c = prep(h_ctx, False)
    fwd_l, bwd_l, o_l = prep(h_lat, True)
    bsz = h_lat.shape[0]
    init = (jnp.zeros((bsz, ML_HEADS, ML_DK, ML_DV), jnp.float32),
            jnp.zeros((bsz, ML_HEADS, ML_DK), jnp.float32),
            jnp.zeros((bsz, ML_HEADS), jnp.float32))
    hf_c, hf_l = run_direction(mlstm_scan, fwd_c, fwd_l, init, False)
    hb_c, hb_l = run_direction(mlstm_scan, bwd_c, bwd_l, init, True)

    def readout(hh, o, dtype):
        y = head_rms_norm(_merge_heads(hh), norm_g, ML_HEADS) * jax.nn.sigmoid(o.astype(jnp.float32))
        return y.astype(dtype) @ w_out

    y_lat = readout(hf_l + hb_l, o_l, h_lat.dtype)
    y_ctx = readout(hf_c + hb_c, o_c, h_ctx.dtype) if need_ctx else None
    return y_ctx, y_lat


def moe_ffn(h, router_w, router_b, w1, b1, w2, b2):
    n_tok, d = h.shape
    logits = (h @ router_w + router_b).astype(jnp.float32)
    top_v, top_e = lax.top_k(logits, TOP_K)
    gates = jax.nn.softmax(top_v, axis=-1)
    e_flat = top_e.reshape(-1)
    g_flat = gates.reshape(-1)
    tok_flat = jnp.repeat(jnp.arange(n_tok, dtype=jnp.int32), TOP_K)
    n_slots = n_tok * TOP_K
    order = jnp.argsort(e_flat)
    e_sorted = e_flat[order]
    counts = jnp.bincount(e_flat, length=N_EXPERTS)
    starts = jnp.cumsum(counts) - counts
    padded = (counts + MOE_BLOCK - 1) // MOE_BLOCK * MOE_BLOCK
    pends = jnp.cumsum(padded)
    pstarts = pends - padded
    dest = pstarts[e_sorted] + (jnp.arange(n_slots) - starts[e_sorted])
    n_rows = -(-(n_slots + N_EXPERTS * (MOE_BLOCK - 1)) // MOE_BLOCK) * MOE_BLOCK
    n_blocks = n_rows // MOE_BLOCK
    row_tok = jnp.full((n_rows,), n_tok, jnp.int32).at[dest].set(tok_flat[order])
    row_gate = jnp.zeros((n_rows,), jnp.float32).at[dest].set(g_flat[order])
    h_pad = jnp.concatenate([h, jnp.zeros((1, d), h.dtype)], axis=0)
    xs = h_pad[row_tok].reshape(n_blocks, MOE_BLOCK, d)
    block_e = jnp.minimum(jnp.searchsorted(pends, jnp.arange(n_blocks) * MOE_BLOCK, side='right'), N_EXPERTS - 1)

    def expert_block(args):
        xb, e = args
        u = xb @ w1[e] + b1[e]
        glu, lin = jnp.split(u, 2, axis=-1)
        glu = jnp.minimum(glu, SWIGLU_LIMIT)
        lin = jnp.clip(lin, -SWIGLU_LIMIT, SWIGLU_LIMIT)
        y = glu * jax.nn.sigmoid(SWIGLU_ALPHA * glu) * (lin + 1.0)
        return y @ w2[e] + b2[e]

    ys = lax.map(expert_block, (xs, block_e)).reshape(n_rows, d)
    out = jax.ops.segment_sum(ys * row_gate[:, None], row_tok, num_segments=n_tok + 1)[:n_tok]
    return out.astype(h.dtype)


def setup_inputs(seed: int = 0) -> dict:
    key = jax.random.key(seed)
    ks = iter(jax.random.split(key, 32))

    def nrm(shape, scale):
        return jax.random.normal(next(ks), shape, jnp.float32) * scale

    d = D_MODEL
    ml_in = 2 * ML_QK + 2 * ML_V + 4 * ML_HEADS
    f_bias = jnp.tile(jnp.linspace(FGATE_BIAS_LO, FGATE_BIAS_HI, ML_HEADS), 2)
    ml_b_gate = jnp.concatenate([jnp.zeros((2 * ML_HEADS,), jnp.float32), f_bias])[None, :] + nrm((N_MLSTM_LAYERS, 4 * ML_HEADS), 0.1)
    return {
        'x': nrm((BATCH, SEQ, d), 1.0),
        'c': nrm((BATCH, d), 1.0),
        'ctx': nrm((BATCH, CTX_LEN, d), 1.0),
        'c_ctx': nrm((d,), 1.0),
        'ada_w': nrm((DEPTH, d, 6 * d), 0.5 * d ** -0.5),
        'ada_b': nrm((DEPTH, 6 * d), 0.02),
        'norm_mix_g': 1.0 + nrm((DEPTH, d), 0.02),
        'norm_ffn_g': 1.0 + nrm((DEPTH, d), 0.02),
        'hg_w_in': nrm((N_HGRN_LAYERS, d, 5 * d), d ** -0.5),
        'hg_lb_logits': nrm((2, DEPTH + 1, d), 0.1),
        'hg_norm_g': 1.0 + nrm((N_HGRN_LAYERS, d), 0.02),
        'hg_w_out': nrm((N_HGRN_LAYERS, d, d), d ** -0.5),
        'ml_w_in': nrm((N_MLSTM_LAYERS, d, ml_in), d ** -0.5),
        'ml_b_gate': ml_b_gate,
        'ml_conv_w': nrm((N_MLSTM_LAYERS, CONV_K, CONV_K, 2 * ML_QK), 1.0 / CONV_K),
        'ml_conv_b': nrm((N_MLSTM_LAYERS, 2 * ML_QK), 0.02),
        'ml_norm_g': 1.0 + nrm((N_MLSTM_LAYERS, ML_V), 0.02),
        'ml_w_out': nrm((N_MLSTM_LAYERS, ML_V, d), ML_V ** -0.5),
        'router_w': nrm((DEPTH, d, N_EXPERTS), d ** -0.5),
        'router_b': nrm((DEPTH, N_EXPERTS), 0.01),
        'moe_w1': nrm((DEPTH, N_EXPERTS, d, 2 * D_FF), d ** -0.5),
        'moe_b1': nrm((DEPTH, N_EXPERTS, 2 * D_FF), 0.01),
        'moe_w2': nrm((DEPTH, N_EXPERTS, D_FF, d), D_FF ** -0.5),
        'moe_b2': nrm((DEPTH, N_EXPERTS, d), 0.01),
        'final_norm_g': 1.0 + nrm((d,), 0.02),
    }


def reference(x, c, ctx, c_ctx, ada_w, ada_b, norm_mix_g, norm_ffn_g, hg_w_in, hg_lb_logits, hg_norm_g, hg_w_out,
              ml_w_in, ml_b_gate, ml_conv_w, ml_conv_b, ml_norm_g, ml_w_out, router_w, router_b,
              moe_w1, moe_b1, moe_w2, moe_b2, final_norm_g):
    d = D_MODEL
    c_act = jax.nn.silu(c)
    cc_act = jax.nn.silu(c_ctx)
    lb_all = jnp.cumsum(jax.nn.softmax(hg_lb_logits.astype(jnp.float32), axis=1), axis=1)
    for layer in range(DEPTH):
        need_ctx = layer < DEPTH - 1
        j = layer // N_MIXERS
        mod_l = jnp.split((c_act @ ada_w[layer] + ada_b[layer])[:, None, :], 6, axis=-1)
        mod_c = jnp.split(cc_act @ ada_w[layer] + ada_b[layer], 6, axis=-1)
        h_lat = modulate(x, norm_mix_g[layer], mod_l[0], mod_l[1])
        h_ctx = modulate(ctx, norm_mix_g[layer], mod_c[0], mod_c[1])
        if layer % N_MIXERS == 0:
            y_ctx, y_lat = hgrn2_mixer(h_ctx, h_lat, hg_w_in[j], lb_all[0, layer], lb_all[1, layer],
                                       hg_norm_g[j], hg_w_out[j], need_ctx)
        else:
            y_ctx, y_lat = mlstm_mixer(h_ctx, h_lat, ml_w_in[j], ml_b_gate[j], ml_conv_w[j], ml_conv_b[j],
                                       ml_norm_g[j], ml_w_out[j], need_ctx)
        x = x + mod_l[2] * y_lat
        f_lat = modulate(x, norm_ffn_g[layer], mod_l[3], mod_l[4]).reshape(-1, d)
        moe_args = (router_w[layer], router_b[layer], moe_w1[layer], moe_b1[layer], moe_w2[layer], moe_b2[layer])
        if need_ctx:
            ctx = ctx + mod_c[2] * y_ctx
            f_ctx = modulate(ctx, norm_ffn_g[layer], mod_c[3], mod_c[4]).reshape(-1, d)
            out = moe_ffn(jnp.concatenate([f_ctx, f_lat], axis=0), *moe_args)
            n_ctx_tok = f_ctx.shape[0]
            ctx = ctx + mod_c[5] * out[:n_ctx_tok].reshape(ctx.shape)
            out_lat = out[n_ctx_tok:]
        else:
            out_lat = moe_ffn(f_lat, *moe_args)
        x = x + mod_l[5] * out_lat.reshape(x.shape)
    return rms_norm(x, final_norm_g)
```

```cpp
#include <hip/hip_runtime.h>
#include <cstdio>
#include <cstdint>

#ifndef MK_ONE_LAUNCH
#define MK_ONE_LAUNCH 1
#endif

#define LAS __attribute__((address_space(3)))
#define GAS __attribute__((address_space(1)))
typedef unsigned short bf16;
typedef unsigned v4u __attribute__((ext_vector_type(4)));
typedef unsigned v2u __attribute__((ext_vector_type(2)));
typedef float f32x4 __attribute__((ext_vector_type(4)));
typedef float f32x2 __attribute__((ext_vector_type(2)));
typedef short bf16x8 __attribute__((ext_vector_type(8)));

constexpr int NB = 16, SEQ = 2048, D = 1024, CTX = 256;
constexpr int NTC = NB * CTX, NTL = NB * SEQ, NT = NTC + NTL;
constexpr int NE = 32, TOPK = 4;
constexpr int HG_N = 5 * D;
constexpr int ML_N = 3104, ML_NP = 3328;
constexpr int NPADMAX = 155648;
constexpr float EPS = 1e-6f;
constexpr int NWAVES = 8, NTHREADS = 512;

constexpr size_t MiB = 1u << 20;
constexpr size_t WS_CTL = 0, CTL_ZERO_BYTES = 1 * MiB;
constexpr size_t WS_SM = 1 * MiB;
constexpr size_t SM_MODL = 0, SM_MODC = 786432, SM_OML = 835584;
constexpr size_t WS_SLOT = 2 * MiB;
constexpr size_t WS_GATE = 3 * MiB;
constexpr size_t WS_RTE = 4 * MiB;
constexpr size_t WS_GT = 10 * MiB;
constexpr size_t WS_WHGIN = 16 * MiB, WS_WHGOUT = 26 * MiB, WS_WMLIN = 28 * MiB, WS_WMLOUT = 35 * MiB;
constexpr size_t WS_W1 = 40 * MiB, WS_W2 = 296 * MiB;
constexpr size_t WS_X1 = 424 * MiB, WS_X2 = 568 * MiB, WS_ACT = 712 * MiB, WS_BIG = 784 * MiB;
constexpr size_t T72 = 72 * MiB;
constexpr size_t WS_END = WS_BIG + 608 * MiB;
constexpr int CW_CNT = 1024;
constexpr int CW_TILE = 2048, CW_BAR = 4096;

constexpr int LDS_BYTES = 160 * 1024;
constexpr int LDS_MISC = LDS_BYTES - 4096;
constexpr int LDS_TAB = LDS_MISC + 64;

__device__ __forceinline__ float bf2f(unsigned v) { return __uint_as_float(v << 16); }
typedef __bf16 bf2_t __attribute__((ext_vector_type(2)));
__device__ __forceinline__ unsigned pk2(float lo, float hi) { bf2_t v; v[0] = (__bf16)lo; v[1] = (__bf16)hi; return __builtin_bit_cast(unsigned, v); }
__device__ __forceinline__ unsigned f2bf(float f) { return pk2(f, f) & 0xffffu; }
__device__ __forceinline__ float fexp(float x) { return __builtin_amdgcn_exp2f(x * 1.44269504089f); }
__device__ __forceinline__ float frcp(float x) { return __builtin_amdgcn_rcpf(x); }
__device__ __forceinline__ float siluf(float v) { return v * frcp(1.0f + fexp(-v)); }
#define LDS_WAIT() asm volatile("s_waitcnt lgkmcnt(0)" ::: "memory")
__device__ __forceinline__ unsigned pk4_fp8(float a, float b, float c, float d) { int w = 0; w = __builtin_amdgcn_cvt_pk_fp8_f32(a, b, w, false); w = __builtin_amdgcn_cvt_pk_fp8_f32(c, d, w, true); return (unsigned)w; }
template <int CTRL, int RMASK> __device__ __forceinline__ float dppf(float old, float src) { return __int_as_float(__builtin_amdgcn_update_dpp(__float_as_int(old), __float_as_int(src), CTRL, RMASK, 0xf, false)); }

namespace pg8 {
#define PG8_LAS __attribute__((address_space(3)))
typedef unsigned short bf16_t;
typedef unsigned u32x4 __attribute__((ext_vector_type(4)));
constexpr int BM = 256, BK = 64, HALF = 128, HTB = HALF * BK * 2, STAGE_BYTES = 8 * HTB, NXCD = 8, WGM = 8;
__host__ __device__ __forceinline__ int lds_byte(int r, int c) { const int st = (r >> 4) * 2 + (c >> 5), rr = r & 15, cc = c & 31, ob = rr * 64 + cc * 2; return st * 1024 + (ob ^ (((ob >> 9) & 1) << 5)); }
__host__ __device__ __forceinline__ void stage_rc(int b, int& R, int& C) { const int st = b / 1024, sb = b % 1024, swz = sb ^ (((sb >> 9) & 1) << 5); R = (st >> 1) * 16 + swz / 64; C = (st & 1) * 32 + (swz % 64) / 2; }
__host__ __device__ __forceinline__ int perm32(int rho) { const int n = rho >> 4, i = rho & 15; return 8 * (i >> 2) + 4 * n + (i & 3); }

__device__ __forceinline__ int lane_now() { int l; asm volatile("v_mbcnt_lo_u32_b32 %0, -1, 0\n\tv_mbcnt_hi_u32_b32 %0, -1, %0" : "=v"(l)); return l; }
struct Unit { int pm, pn, bt; };
struct Gemm { const bf16_t* A; const bf16_t* Bt; int K; };

struct StaticOrder {
    int nM, nN, nwg, G, c;
    __device__ void init(int M, int N, int G_, int c_) { nM = M / BM; nN = N / BM; nwg = nM * nN; G = G_; c = c_; }
    __device__ bool next(int i, Unit& u) const {
        const long L = (long)i * G + c; if (L >= nwg) return false;
        int wgid = (int)L; { const int q = nwg / NXCD, r = nwg % NXCD, xcd = wgid % NXCD, off = wgid / NXCD; wgid = (xcd < r ? xcd * (q + 1) : r * (q + 1) + (xcd - r) * q) + off; }
        const int nig = WGM * nN, gid = wgid / nig, fm = gid * WGM, gsz = (nM - fm) < WGM ? (nM - fm) : WGM;
        u.pm = fm + ((wgid % nig) % gsz); u.pn = (wgid % nig) / gsz; u.bt = u.pn; return true;
    }
};
struct MlInOrder {
    StaticOrder lat; int G, c;
    __device__ void init(int G_, int c_) { lat.init(NTL, ML_NP, G_, 0); G = G_; c = c_; }
    __device__ bool next(int i, Unit& u) const {
        const long L = (long)i * G + c;
        if (L < lat.nwg) { StaticOrder t = lat; t.G = 1; t.c = 0; t.next((int)L, u); u.pm += NTC / BM; return true; }
        const int r = (int)(L - lat.nwg); if (r >= 16 * 7) return false;
        const int j = r % 7; u.pm = r / 7; u.pn = j < 2 ? 2 + j : j < 6 ? 2 + j : 12; u.bt = u.pn; return true;
    }
};
struct MoeOrder {
    int nblk, tilesN, G, c; const LAS int* blkE;
    __device__ bool next(int i, Unit& u) const {
        int pm, pn;
        const int J = G / 8;
        if ((G % 8) == 0 && (J % tilesN) == 0) { const int x = c % 8, j = c / 8, RB = J / tilesN; pm = (i * 8 + x) * RB + j / tilesN; pn = j % tilesN; }
        else { const long L = (long)i * G + c; pm = (int)(L / tilesN); pn = (int)(L % tilesN); }
        if (pm >= nblk) return false;
        u.pm = pm; u.pn = pn; u.bt = blkE[pm] * tilesN + pn; return true;
    }
};

__device__ __forceinline__ unsigned cvt_pk_bf16(float lo, float hi) { return pk2(lo, hi); }

__device__ __forceinline__ __attribute__((ext_vector_type(8))) int pk8(bf16x8 lo, bf16x8 hi) { typedef int v4i __attribute__((ext_vector_type(4))); const v4i a = __builtin_bit_cast(v4i, lo), b = __builtin_bit_cast(v4i, hi);
    return (__attribute__((ext_vector_type(8))) int){a[0], a[1], a[2], a[3], b[0], b[1], b[2], b[3]}; }
typedef int v8i_t __attribute__((ext_vector_type(8)));
typedef int v4i_q __attribute__((ext_vector_type(4)));
__device__ __forceinline__ int pg8_x16(int v) { int r; asm volatile("v_xor_b32 %0, 16, %1" : "=v"(r) : "v"(v)); return r; }
__device__ __forceinline__ v8i_t pk8q(v4i_q a, v4i_q b) { return __builtin_shufflevector(a, b, 0, 1, 2, 3, 4, 5, 6, 7); }
template <class Epi, class Sched, bool ALIGN_EPI = true, bool SP2 = true, bool GATHER = false, bool FP8 = false>
__device__ __forceinline__ void gemm_phase(PG8_LAS unsigned char* lds, const Gemm g, const Sched& S, const Epi& E, const PG8_LAS int* tokL = nullptr) {
    const int tid = threadIdx.x, wid = __builtin_amdgcn_readfirstlane(tid >> 6), lane = tid & 63, wr = wid >> 2, wc = wid & 3, fr = lane & 15, fq = lane >> 4;
    const int K = FP8 ? g.K / 2 : g.K, nt = K / BK;
    unsigned voffA[2], voffB[2];
#pragma unroll
    for (int i = 0; i < 2; ++i) { int R, C; stage_rc(tid * 16 + i * 8192, R, C); const int Rb = Epi::PERM ? ((R & ~31) + perm32(R & 31)) : R;
        voffA[i] = (unsigned)(R * K + C) * 2u; voffB[i] = (unsigned)(Rb * K + C) * 2u; }
    unsigned gA[2][2], gU[2][2];
#define PG8_GTOK(dst, uidx) do { const int _t = wid * 64 + lane_now(); _Pragma("unroll") for (int _i = 0; _i < 2; ++_i) { int _R, _C; stage_rc(_t * 16 + _i * 8192, _R, _C); _Pragma("unroll") for (int _h = 0; _h < 2; ++_h) dst[_h][_i] = (unsigned)tokL[(uidx) * 256 + _h * HALF + _R] * (unsigned)(K * 2) + (unsigned)(_C * 2); } } while (0)
    const unsigned kstep = (unsigned)(BK * 2);
    const unsigned hstep = (unsigned)HALF * K * 2;
    const unsigned tstep = 2 * hstep;
    const __amdgpu_buffer_rsrc_t rsA = __builtin_amdgcn_make_buffer_rsrc((void*)g.A, 0, -1, 0x00020000), rsB = __builtin_amdgcn_make_buffer_rsrc((void*)g.Bt, 0, -1, 0x00020000);
    const unsigned ldsw = (unsigned)wid * 1024u;
    const int aoff = FP8 ? (lds_byte(wr * 64 + fr, fq * 16) | ((fq & 1) << 4)) : lds_byte(wr * 64 + fr, fq * 8), boff = FP8 ? (lds_byte(wc * 32 + fr, fq * 16) | ((fq & 1) << 4)) : lds_byte(wc * 32 + fr, fq * 8);
#define aoffH pg8_x16(aoff)
#define boffH pg8_x16(boff)
    constexpr int aoff1 = FP8 ? 16 : 1024, boff1 = FP8 ? 16 : 1024;
#define PG8_SA(b, h) (((b) * 2 + (h)) * HTB)
#define PG8_SB(b, h) ((4 + (b) * 2 + (h)) * HTB)
#define PG8_STAGE_R(bufoff, rs, soff, voff) do { _Pragma("unroll") for (int _i = 0; _i < 2; ++_i) \
        __builtin_amdgcn_raw_ptr_buffer_load_lds(rs, (PG8_LAS void*)(lds + (bufoff) + ldsw + _i * 8192), 16, (int)(voff)[_i], (int)(soff), 0, 0); } while (0)
#define PG8_STAGE_B(bufoff, soff) PG8_STAGE_R(bufoff, rsB, soff, voffB)
#define PG8_STAGE_A1(b, h, ptr) do { if constexpr (GATHER) { PG8_STAGE_R(PG8_SA(b, h), rsA, ptr, gA[h]); } else { PG8_STAGE_R(PG8_SA(b, h), rsA, (ptr) + (h) * hstep, voffA); } } while (0)
#define PG8_STAGE_A2(b, h, ptr) do { if constexpr (GATHER) { PG8_STAGE_R(PG8_SA(b, h), rsA, ptr, gU[h]); } else { PG8_STAGE_R(PG8_SA(b, h), rsA, (ptr) + (h) * hstep, voffA); } } while (0)
#define PG8_LDA(dst, b, h) do { if constexpr (FP8) { _Pragma("unroll") for (int m = 0; m < 4; ++m) dst##8[m] = pk8q(*(const PG8_LAS v4i_q*)(lds + PG8_SA(b, h) + aoff + m * 2048), *(const PG8_LAS v4i_q*)(lds + PG8_SA(b, h) + aoffH + m * 2048)); } else { _Pragma("unroll") for (int m = 0; m < 4; ++m) _Pragma("unroll") for (int k = 0; k < 2; ++k) dst[m][k] = *(const PG8_LAS bf16x8*)(lds + PG8_SA(b, h) + aoff + m * 2048 + k * aoff1); } } while (0)
#define PG8_LDB(dst, b, h) do { if constexpr (FP8) { _Pragma("unroll") for (int n = 0; n < 2; ++n) dst##8[n] = pk8q(*(const PG8_LAS v4i_q*)(lds + PG8_SB(b, h) + boff + n * 2048), *(const PG8_LAS v4i_q*)(lds + PG8_SB(b, h) + boffH + n * 2048)); } else { _Pragma("unroll") for (int n = 0; n < 2; ++n) _Pragma("unroll") for (int k = 0; k < 2; ++k) dst[n][k] = *(const PG8_LAS bf16x8*)(lds + PG8_SB(b, h) + boff + n * 2048 + k * boff1); } } while (0)
#define PG8_MMA(ai, bj, At, Bt) do { __builtin_amdgcn_s_setprio(1); if constexpr (FP8) { _Pragma("unroll") for (int m = 0; m < 4; ++m) _Pragma("unroll") for (int n = 0; n < 2; ++n) \
        acc[ai][bj][m][n] = __builtin_amdgcn_mfma_scale_f32_16x16x128_f8f6f4(Bt##8[n], At##8[m], acc[ai][bj][m][n], 0, 0, 0, 0, 0, 0); } \
        else { _Pragma("unroll") for (int m = 0; m < 4; ++m) _Pragma("unroll") for (int n = 0; n < 2; ++n) _Pragma("unroll") for (int k = 0; k < 2; ++k) \
        acc[ai][bj][m][n] = __builtin_amdgcn_mfma_f32_16x16x32_bf16(Bt[n][k], At[m][k], acc[ai][bj][m][n], 0, 0, 0); } __builtin_amdgcn_s_setprio(0); } while (0)
#define PG8_WAIT_V(n) asm volatile("s_waitcnt vmcnt(" #n ")" ::: "memory")
#define PG8_WAIT_L(n) asm volatile("s_waitcnt lgkmcnt(" #n ")" ::: "memory")
#define PG8_BAR __builtin_amdgcn_s_barrier()
#define PG8_SCHED __builtin_amdgcn_sched_barrier(0)
    Unit cur, nxt; int ui = 0;
    if (!S.next(0, cur)) return;
    f32x4 acc[2][2][4][2];
#pragma unroll
    for (int a = 0; a < 2; ++a)
#pragma unroll
        for (int b = 0; b < 2; ++b)
#pragma unroll
            for (int m = 0; m < 4; ++m)
#pragma unroll
                for (int n = 0; n < 2; ++n) acc[a][b][m][n] = (f32x4){0.f, 0.f, 0.f, 0.f};
    bf16x8 At[4][2], B0[2][2], B1[2][2]; v8i_t At8[4], B08[2], B18[2];
    unsigned cA = GATHER ? 0u : (unsigned)cur.pm * tstep, cB = (unsigned)cur.bt * tstep;
    if constexpr (GATHER) { PG8_GTOK(gA, 0); }
    if constexpr (SP2) {
        PG8_STAGE_B(PG8_SB(0, 0), cB); PG8_STAGE_B(PG8_SB(0, 1), cB + hstep); PG8_STAGE_A1(0, 0, cA); PG8_STAGE_A1(0, 1, cA);
        if (wr == 1) PG8_BAR;
        PG8_WAIT_V(2); PG8_BAR;
        PG8_STAGE_B(PG8_SB(1, 0), cB + kstep); PG8_STAGE_A1(1, 0, cA + kstep); PG8_STAGE_B(PG8_SB(1, 1), cB + hstep + kstep);
        PG8_WAIT_V(6); PG8_BAR;
    } else {
        static_assert(SP2 || !GATHER, "gathered A rows: SP2 loop only");
        PG8_STAGE_B(PG8_SB(0, 0), cB); PG8_STAGE_R(PG8_SA(0, 0), rsA, cA, voffA); PG8_STAGE_B(PG8_SB(0, 1), cB + hstep); PG8_STAGE_R(PG8_SA(0, 1), rsA, cA + hstep, voffA);
        if (wr == 1) PG8_BAR;
        PG8_WAIT_V(4); PG8_BAR;
        PG8_STAGE_B(PG8_SB(1, 0), cB + kstep); PG8_STAGE_R(PG8_SA(1, 0), rsA, cA + kstep, voffA); PG8_STAGE_B(PG8_SB(1, 1), cB + hstep + kstep);
        PG8_WAIT_V(6); PG8_BAR;
    }
    for (;;) {
        const bool has_next = S.next(ui + 1, nxt);
        const unsigned nA = GATHER ? cA : (has_next ? (unsigned)nxt.pm * tstep : cA), nB = has_next ? (unsigned)nxt.bt * tstep : cB;
#pragma unroll 1
        for (int t = 0; t < nt; t += 2) {
            const bool last = (t == nt - 2);
            if constexpr (GATHER) {
#pragma unroll
                for (int _h = 0; _h < 2; ++_h)
#pragma unroll
                    for (int _i = 0; _i < 2; ++_i) gU[_h][_i] = gA[_h][_i];
                if (last && has_next) { PG8_GTOK(gU, ui + 1); } }

            const unsigned a1 = cA + (unsigned)(t + 1) * kstep;
            const unsigned a2 = last ? nA : cA + (unsigned)(t + 2) * kstep, b2 = last ? nB : cB + (unsigned)(t + 2) * kstep;
            const unsigned a3 = a2 + kstep, b3 = b2 + kstep;
            if constexpr (SP2) {
            PG8_LDB(B0, 0, 0); PG8_LDB(B1, 0, 1); PG8_SCHED; PG8_LDA(At, 0, 0); PG8_STAGE_A1(1, 1, a1);
            PG8_WAIT_V(8); PG8_WAIT_L(0); PG8_BAR; PG8_MMA(0, 0, At, B0); PG8_MMA(0, 1, At, B1); PG8_BAR; PG8_SCHED;
            PG8_LDA(At, 0, 1); PG8_STAGE_B(PG8_SB(0, 0), b2); PG8_STAGE_B(PG8_SB(0, 1), b2 + hstep); PG8_STAGE_A2(0, 0, a2);
            PG8_WAIT_V(8); PG8_WAIT_L(0); PG8_BAR; PG8_MMA(1, 0, At, B0); PG8_MMA(1, 1, At, B1); PG8_BAR; PG8_SCHED;
            PG8_LDB(B0, 1, 0); PG8_LDB(B1, 1, 1); PG8_SCHED; PG8_LDA(At, 1, 0); PG8_STAGE_A2(0, 1, a2);
            PG8_WAIT_V(8); PG8_WAIT_L(0); PG8_BAR; PG8_MMA(0, 0, At, B0); PG8_MMA(0, 1, At, B1); PG8_BAR; PG8_SCHED;
            PG8_LDA(At, 1, 1); PG8_STAGE_B(PG8_SB(1, 0), b3); PG8_STAGE_B(PG8_SB(1, 1), b3 + hstep); PG8_STAGE_A2(1, 0, a3);
            PG8_WAIT_V(8); PG8_WAIT_L(0); PG8_BAR; PG8_MMA(1, 0, At, B0); PG8_MMA(1, 1, At, B1); PG8_BAR; PG8_SCHED;
            } else {
            PG8_LDB(B0, 0, 0); PG8_SCHED; PG8_LDA(At, 0, 0); PG8_STAGE_R(PG8_SA(1, 1), rsA, a1 + hstep, voffA);
            PG8_WAIT_L(8); PG8_BAR; PG8_WAIT_L(0); PG8_MMA(0, 0, At, B0); PG8_BAR; PG8_SCHED;
            PG8_LDB(B1, 0, 1); PG8_STAGE_B(PG8_SB(0, 0), b2);
            PG8_BAR; PG8_WAIT_L(0); PG8_MMA(0, 1, At, B1); PG8_BAR;
            PG8_LDA(At, 0, 1); PG8_STAGE_R(PG8_SA(0, 0), rsA, a2, voffA);
            PG8_BAR; PG8_WAIT_L(0); PG8_MMA(1, 0, At, B0); PG8_BAR; PG8_SCHED;
            PG8_STAGE_B(PG8_SB(0, 1), b2 + hstep);
            PG8_WAIT_V(6); PG8_BAR; PG8_MMA(1, 1, At, B1); PG8_BAR;
            PG8_LDB(B0, 1, 0); PG8_SCHED; PG8_LDA(At, 1, 0); PG8_STAGE_R(PG8_SA(0, 1), rsA, a2 + hstep, voffA);
            PG8_WAIT_L(8); PG8_BAR; PG8_WAIT_L(0); PG8_MMA(0, 0, At, B0); PG8_BAR; PG8_SCHED;
            PG8_LDB(B1, 1, 1); PG8_STAGE_B(PG8_SB(1, 0), b3);
            PG8_BAR; PG8_WAIT_L(0); PG8_MMA(0, 1, At, B1); PG8_BAR;
            PG8_LDA(At, 1, 1); PG8_STAGE_R(PG8_SA(1, 0), rsA, a3, voffA);
            PG8_BAR; PG8_WAIT_L(0); PG8_MMA(1, 0, At, B0); PG8_BAR; PG8_SCHED;
            PG8_STAGE_B(PG8_SB(1, 1), b3 + hstep);
            PG8_WAIT_V(6); PG8_BAR; PG8_MMA(1, 1, At, B1); PG8_BAR;
            }
        }
        if constexpr (ALIGN_EPI) { if (wr == 0) PG8_BAR; }
        E(acc, cur, wr, wc, fr, fq);
        if (!has_next) break;
#pragma unroll
        for (int a = 0; a < 2; ++a)
#pragma unroll
            for (int b = 0; b < 2; ++b)
#pragma unroll
                for (int m = 0; m < 4; ++m)
#pragma unroll
                    for (int n = 0; n < 2; ++n) { f32x2 z0, z1; asm volatile("v_mov_b64 %0, 0\n\tv_mov_b64 %1, 0" : "=v"(z0), "=v"(z1)); acc[a][b][m][n] = (f32x4){z0[0], z0[1], z1[0], z1[1]}; }
        cur = nxt; cA = nA; cB = nB; ++ui;
        if constexpr (GATHER) { PG8_GTOK(gA, ui); }
        if constexpr (ALIGN_EPI) { if (wr == 1) PG8_BAR; }
    }
    PG8_WAIT_V(0);
    if constexpr (!ALIGN_EPI) { if (wr == 0) PG8_BAR; }
    PG8_BAR;
#undef PG8_SA
#undef PG8_SB
#undef PG8_STAGE_R
#undef PG8_STAGE_B
#undef PG8_LDA
#undef PG8_STAGE_A1
#undef PG8_STAGE_A2
#undef PG8_GTOK
#undef PG8_LDB
#undef PG8_MMA
#undef PG8_WAIT_V
#undef PG8_WAIT_L
#undef PG8_BAR
#undef PG8_SCHED
}

struct EpiHgIn {
    static constexpr bool PERM = true;
    bf16_t* out0; size_t seg_stride; const float* omlF; const float* omlB;
    __device__ __forceinline__ void operator()(const f32x4 (&acc)[2][2][4][2], const Unit& u, int wr, int wc, int fr, int fq) const {
        const int seg = u.pn >> 2, colt = (u.pn & 3) * BM;
        bf16_t* base = out0 + (size_t)seg * seg_stride;
        const int row0 = u.pm * BM + wr * 64 + fr, col0 = colt + wc * 32 + 8 * fq;
        f32x4 ov[2][2];
        const float* oml = (seg == 2) ? omlF : omlB;
#pragma unroll
        for (int bj = 0; bj < 2; ++bj)
#pragma unroll
            for (int n = 0; n < 2; ++n) ov[bj][n] = (seg == 2 || seg == 3) ? *(const f32x4*)(oml + col0 + bj * HALF + 4 * n) : (f32x4){1.f, 1.f, 1.f, 1.f};
        auto body = [&](auto act) {
#pragma unroll
            for (int ai = 0; ai < 2; ++ai)
#pragma unroll
                for (int m = 0; m < 4; ++m) { bf16_t* rowp = base + (size_t)(row0 + ai * HALF + m * 16) * D + col0;
#pragma unroll
                    for (int bj = 0; bj < 2; ++bj) { f32x4 v[2] = {acc[ai][bj][m][0], acc[ai][bj][m][1]};
#pragma unroll
                        for (int n = 0; n < 2; ++n)
#pragma unroll
                            for (int j = 0; j < 4; ++j) v[n][j] = act(v[n][j], ov[bj][n][j]);
                        u32x4 w; w.x = cvt_pk_bf16(v[0][0], v[0][1]); w.y = cvt_pk_bf16(v[0][2], v[0][3]); w.z = cvt_pk_bf16(v[1][0], v[1][1]); w.w = cvt_pk_bf16(v[1][2], v[1][3]);
                        *(u32x4*)(rowp + bj * HALF) = w; } } };
        if (seg == 0 || seg == 4) body([](float x, float) { return siluf(x); });
        else if (seg == 1) body([](float x, float) { return x; });
        else body([](float x, float o) { return o * frcp(1.0f + fexp(x)); });
    }
};
struct EpiMlIn {
    static constexpr bool PERM = true;
    bf16_t* out0; size_t seg_stride; float* gt; const float* bgate;
    __device__ __forceinline__ void operator()(const f32x4 (&acc)[2][2][4][2], const Unit& u, int wr, int wc, int fr, int fq) const {
        const int seg = u.pn >> 2, colt = (u.pn & 3) * BM;
        const int row0 = u.pm * BM + wr * 64 + fr, col0 = colt + wc * 32 + 8 * fq;
        if (seg == 3) {
            if (wc == 0) {
                const f32x4 b0 = *(const f32x4*)(bgate + 8 * fq), b1 = *(const f32x4*)(bgate + 8 * fq + 4);
#pragma unroll
                for (int ai = 0; ai < 2; ++ai)
#pragma unroll
                    for (int m = 0; m < 4; ++m) { float* rowp = gt + (size_t)(row0 + ai * HALF + m * 16) * 32 + 8 * fq; f32x4 v[2] = {acc[ai][0][m][0] + b0, acc[ai][0][m][1] + b1};
#pragma unroll
                        for (int n = 0; n < 2; ++n)
#pragma unroll
                            for (int j = 0; j < 4; ++j) { const float y = v[n][j] * (1.0f / 15.0f); float t = 15.0f * (1.0f - 2.0f * frcp(1.0f + fexp(2.0f * y)));
                                if (fq >= 2) t = fminf(t, 0.f) - __logf(1.0f + fexp(-fabsf(t)));
                                v[n][j] = t; }
                        *(f32x4*)(rowp) = v[0]; *(f32x4*)(rowp + 4) = v[1]; }
            }
            return;
        }
        bf16_t* base = out0 + (size_t)seg * seg_stride;
#pragma unroll
        for (int ai = 0; ai < 2; ++ai)
#pragma unroll
            for (int m = 0; m < 4; ++m) { bf16_t* rowp = base + (size_t)(row0 + ai * HALF + m * 16) * D + col0;
#pragma unroll
                for (int bj = 0; bj < 2; ++bj) { f32x4 v[2] = {acc[ai][bj][m][0], acc[ai][bj][m][1]};
                    if (seg == 2) {
#pragma unroll
                        for (int n = 0; n < 2; ++n)
#pragma unroll
                            for (int j = 0; j < 4; ++j) v[n][j] = frcp(1.0f + fexp(-v[n][j])); }
                    u32x4 w; w.x = cvt_pk_bf16(v[0][0], v[0][1]); w.y = cvt_pk_bf16(v[0][2], v[0][3]); w.z = cvt_pk_bf16(v[1][0], v[1][1]); w.w = cvt_pk_bf16(v[1][2], v[1][3]);
                    *(u32x4*)(rowp + bj * HALF) = w; } }
    }
};
template <bool IN_BF16> struct EpiResid {
    static constexpr bool PERM = true;
    const void* in_ctx; const void* in_lat; bf16_t* out; const float* mod_ctx; const float* mod_lat; int row_off;
    __device__ __forceinline__ void operator()(const f32x4 (&acc)[2][2][4][2], const Unit& u, int wr, int wc, int fr, int fq) const {
        const int R0 = u.pm * BM + row_off;
        const bool isctx = R0 < NTC;
        const float* mod = isctx ? mod_ctx : mod_lat + (size_t)((R0 - NTC) / SEQ) * (6 * D);
        const size_t inrow0 = isctx ? (size_t)R0 : (size_t)(R0 - NTC);
        const int rl0 = wr * 64 + fr, col0 = u.pn * BM + wc * 32 + 8 * fq;
        const unsigned long long inb = (isctx ? (unsigned long long)in_ctx : (unsigned long long)in_lat) + (unsigned long long)(inrow0 * D) * (IN_BF16 ? 2u : 4u);
        f32x4 mv[2][2];
#pragma unroll
        for (int bj = 0; bj < 2; ++bj)
#pragma unroll
            for (int n = 0; n < 2; ++n) mv[bj][n] = *(const f32x4*)(mod + col0 + bj * HALF + 4 * n);
#pragma unroll
        for (int ai = 0; ai < 2; ++ai) {
            if constexpr (IN_BF16) {
                u32x4 rb[4][2];
#pragma unroll
                for (int m = 0; m < 4; ++m)
#pragma unroll
                    for (int bj = 0; bj < 2; ++bj) rb[m][bj] = *(const __attribute__((address_space(1))) u32x4*)(inb + ((unsigned long long)(rl0 + ai * HALF + m * 16) * D + col0 + bj * HALF) * 2u);
                __builtin_amdgcn_sched_barrier(0);
#pragma unroll
                for (int m = 0; m < 4; ++m)
#pragma unroll
                    for (int bj = 0; bj < 2; ++bj) { const u32x4 w = rb[m][bj];
                        const f32x4 x0 = (f32x4){__uint_as_float(w.x << 16), __uint_as_float(w.x & 0xffff0000u), __uint_as_float(w.y << 16), __uint_as_float(w.y & 0xffff0000u)};
                        const f32x4 x1 = (f32x4){__uint_as_float(w.z << 16), __uint_as_float(w.z & 0xffff0000u), __uint_as_float(w.w << 16), __uint_as_float(w.w & 0xffff0000u)};
                        const f32x4 v0 = x0 + mv[bj][0] * acc[ai][bj][m][0], v1 = x1 + mv[bj][1] * acc[ai][bj][m][1];
                        u32x4 o; o.x = cvt_pk_bf16(v0[0], v0[1]); o.y = cvt_pk_bf16(v0[2], v0[3]); o.z = cvt_pk_bf16(v1[0], v1[1]); o.w = cvt_pk_bf16(v1[2], v1[3]);
                        *(u32x4*)(out + (size_t)(R0 + rl0 + ai * HALF + m * 16) * D + col0 + bj * HALF) = o; }
            } else {
                f32x4 rf[4][2][2];
#pragma unroll
                for (int m = 0; m < 4; ++m)
#pragma unroll
                    for (int bj = 0; bj < 2; ++bj) { const __attribute__((address_space(1))) f32x4* ip = (const __attribute__((address_space(1))) f32x4*)(inb + ((unsigned long long)(rl0 + ai * HALF + m * 16) * D + col0 + bj * HALF) * 4u); rf[m][bj][0] = ip[0]; rf[m][bj][1] = ip[1]; }
                __builtin_amdgcn_sched_barrier(0);
#pragma unroll
                for (int m = 0; m < 4; ++m)
#pragma unroll
                    for (int bj = 0; bj < 2; ++bj) { const f32x4 v0 = rf[m][bj][0] + mv[bj][0] * acc[ai][bj][m][0], v1 = rf[m][bj][1] + mv[bj][1] * acc[ai][bj][m][1];
                        u32x4 o; o.x = cvt_pk_bf16(v0[0], v0[1]); o.y = cvt_pk_bf16(v0[2], v0[3]); o.z = cvt_pk_bf16(v1[0], v1[1]); o.w = cvt_pk_bf16(v1[2], v1[3]);
                        *(u32x4*)(out + (size_t)(R0 + rl0 + ai * HALF + m * 16) * D + col0 + bj * HALF) = o; }
            }
            __builtin_amdgcn_sched_barrier(0);
        }
    }
};
struct EpiSwiglu {
    static constexpr bool PERM = true;
    bf16_t* H; const float* b1;
    __device__ __forceinline__ void operator()(const f32x4 (&acc)[2][2][4][2], const Unit& u, int wr, int wc, int, int) const {
        const int e = u.bt >> 3; const int ln = lane_now(), fr = ln & 15, fq = ln >> 4;
        const int row0 = u.pm * BM + wr * 64 + fr, col0 = u.pn * HALF + wc * 32 + 8 * fq;
        const float* bb = b1 + (size_t)e * 2048 + col0;
        f32x4 bg[2], bl[2];
#pragma unroll
        for (int n = 0; n < 2; ++n) { bg[n] = *(const f32x4*)(bb + 4 * n); bl[n] = *(const f32x4*)(bb + 1024 + 4 * n) + 1.0f; }
#pragma unroll
        for (int ai = 0; ai < 2; ++ai)
#pragma unroll
            for (int m = 0; m < 4; ++m) { unsigned char* rowp = (unsigned char*)H + (size_t)(row0 + ai * HALF + m * 16) * D + col0;
                f32x2 v[2][2];
#pragma unroll
                for (int n = 0; n < 2; ++n)
#pragma unroll
                    for (int jp = 0; jp < 2; ++jp) {
                        const f32x2 ag = (f32x2){acc[ai][0][m][n][2 * jp], acc[ai][0][m][n][2 * jp + 1]}, al = (f32x2){acc[ai][1][m][n][2 * jp], acc[ai][1][m][n][2 * jp + 1]};
                        const f32x2 g2 = __builtin_elementwise_fma(ag, (f32x2){0.0625f, 0.0625f}, (f32x2){bg[n][2 * jp], bg[n][2 * jp + 1]});
                        const f32x2 l2 = __builtin_elementwise_fma(al, (f32x2){0.0625f, 0.0625f}, (f32x2){bl[n][2 * jp], bl[n][2 * jp + 1]});
                        const f32x2 gl = (f32x2){fminf(g2[0], 7.0f), fminf(g2[1], 7.0f)};
                        const f32x2 lc = (f32x2){__builtin_amdgcn_fmed3f(l2[0], -6.0f, 8.0f), __builtin_amdgcn_fmed3f(l2[1], -6.0f, 8.0f)};
                        const f32x2 t2 = gl * (f32x2){-1.702f * 1.44269504089f, -1.702f * 1.44269504089f};
                        const f32x2 d2 = (f32x2){__builtin_amdgcn_exp2f(t2[0]), __builtin_amdgcn_exp2f(t2[1])} + (f32x2){1.0f, 1.0f};
                        const f32x2 r2 = (f32x2){frcp(d2[0]), frcp(d2[1])};
                        v[n][jp] = (gl * lc) * r2; }
                v2u w; w.x = pk4_fp8(v[0][0][0], v[0][0][1], v[0][1][0], v[0][1][1]); w.y = pk4_fp8(v[1][0][0], v[1][0][1], v[1][1][0], v[1][1][1]);
                *(v2u*)(rowp) = w; }
    }
};
struct EpiW2 {
    static constexpr bool PERM = true;
    bf16_t* Y; const float* b2;
    __device__ __forceinline__ void operator()(const f32x4 (&acc)[2][2][4][2], const Unit& u, int wr, int wc, int fr, int fq) const {
        const int e = u.bt >> 2;
        const int row0 = u.pm * BM + wr * 64 + fr, col0 = u.pn * BM + wc * 32 + 8 * fq;
        const float* bb = b2 + (size_t)e * 1024 + col0;
        f32x4 bv[2][2];
#pragma unroll
        for (int bj = 0; bj < 2; ++bj)
#pragma unroll
            for (int n = 0; n < 2; ++n) bv[bj][n] = *(const f32x4*)(bb + bj * HALF + 4 * n) * 16.0f;
#pragma unroll
        for (int ai = 0; ai < 2; ++ai)
#pragma unroll
            for (int m = 0; m < 4; ++m) { unsigned char* rowp = (unsigned char*)Y + (size_t)(row0 + ai * HALF + m * 16) * D + col0;
#pragma unroll
                for (int bj = 0; bj < 2; ++bj) { f32x4 v0 = acc[ai][bj][m][0] + bv[bj][0], v1 = acc[ai][bj][m][1] + bv[bj][1];
#pragma unroll
                    for (int j = 0; j < 4; ++j) { v0[j] = __builtin_amdgcn_fmed3f(v0[j], -448.0f, 448.0f); v1[j] = __builtin_amdgcn_fmed3f(v1[j], -448.0f, 448.0f); }
                    v2u w; w.x = pk4_fp8(v0[0], v0[1], v0[2], v0[3]); w.y = pk4_fp8(v1[0], v1[1], v1[2], v1[3]);
                    *(v2u*)(rowp + bj * HALF) = w; } }
    }
};
}

#define XB_TMO      128
#define XB_XCNT(j)  (256  + 64 * (j))
#define XB_XSUB(j)  (1280 + 64 * (j))
#define XB_XGEN(j)  (2304 + 64 * (j))
#define XB_TOP      3328
#define XB_TOPGEN   3392
#define XCD_BAR_WORDS 3456
#define XB_SPIN_CAP (1u << 18)
__device__ __forceinline__ unsigned xb_ld(unsigned* p)              { return __hip_atomic_load(p, __ATOMIC_RELAXED, __HIP_MEMORY_SCOPE_AGENT); }
__device__ __forceinline__ unsigned xb_add(unsigned* p, unsigned v) { return __hip_atomic_fetch_add(p, v, __ATOMIC_RELAXED, __HIP_MEMORY_SCOPE_AGENT); }
__device__ __forceinline__ unsigned xb_xcc_id() { return (unsigned)__builtin_amdgcn_s_getreg((3 << 11) | 20) & 0xFu; }
#define XB_SPIN(cond, bar) do { unsigned _sp = 0; while (cond) { __builtin_amdgcn_s_sleep(1); \
    if ((++_sp & 255u) == 0u) { if (xb_ld(&(bar)[XB_TMO])) break; if (_sp > XB_SPIN_CAP) { atomicAdd(&(bar)[XB_TMO], 1u); break; } } } } while (0)
struct XcdBarrier { unsigned* bar; unsigned x; volatile LAS unsigned* st; };
__device__ __forceinline__ XcdBarrier xcd_barrier_post(unsigned* bar, volatile LAS unsigned* st) {
    XcdBarrier b; b.bar = bar; b.x = xb_xcc_id(); b.st = st;
    if (threadIdx.x == 0) (void)xb_add(&bar[XB_XCNT(b.x)], 1u);
    return b;
}
__device__ __forceinline__ void xcd_barrier_complete(unsigned* bar, unsigned x, unsigned& nloc, unsigned& nx) {
    const unsigned G = gridDim.x * gridDim.y * gridDim.z;
    unsigned sum, cnt, mine, sp = 0u;
    for (;;) {
        sum = 0u; cnt = 0u; mine = 0u;
#pragma unroll
        for (unsigned j = 0; j < 16; ++j) { const unsigned c = xb_ld(&bar[XB_XCNT(j)]); sum += c; cnt += (c > 0u) ? 1u : 0u; mine = (j == x) ? c : mine; }
        if (sum == G) break;
        __builtin_amdgcn_s_sleep(1);
        if ((++sp & 255u) == 0u) { if (xb_ld(&bar[XB_TMO])) break; if (sp > XB_SPIN_CAP) { atomicAdd(&bar[XB_TMO], 1u); break; } }
    }
    nloc = mine > 0u ? mine : 1u; nx = cnt > 0u ? cnt : 1u;
}
__device__ __forceinline__ void xcd_barrier(const XcdBarrier& b) {
    asm volatile("s_waitcnt vmcnt(0)" ::: "memory");
    __syncthreads();
    if (threadIdx.x == 0) {
        unsigned* bar = b.bar;
        __builtin_amdgcn_s_waitcnt(0);
        unsigned nloc = b.st[0], nx = b.st[1];
        if (nloc == 0u) { xcd_barrier_complete(bar, b.x, nloc, nx); b.st[0] = nloc; b.st[1] = nx; }
        const unsigned old = xb_add(&bar[XB_XSUB(b.x)], 1u);
        const unsigned gen = old / nloc;
        if (old + 1u == (gen + 1u) * nloc) {
            __builtin_amdgcn_fence(__ATOMIC_RELEASE, "agent");
            asm volatile("s_waitcnt vmcnt(0)" ::: "memory");
            const unsigned og = xb_add(&bar[XB_TOP], 1u);
            const unsigned tg = og / nx;
            if (og + 1u == (tg + 1u) * nx) xb_add(&bar[XB_TOPGEN], 1u);
            else XB_SPIN(xb_ld(&bar[XB_TOPGEN]) == tg, bar);
            __builtin_amdgcn_fence(__ATOMIC_ACQUIRE, "agent");
            xb_add(&bar[XB_XGEN(b.x)], 1u);
            asm volatile("s_waitcnt vmcnt(0)" ::: "memory");
        } else {
            XB_SPIN(xb_ld(&bar[XB_XGEN(b.x)]) == gen, bar);
            __builtin_amdgcn_fence(__ATOMIC_ACQUIRE, "agent");
            asm volatile("s_waitcnt vmcnt(0)" ::: "memory");
        }
    }
    __syncthreads();
}

struct Args { const float* in[25]; float* out; unsigned char* ws; int ph_lo, ph_hi; };
typedef const volatile __attribute__((address_space(4))) Args& ArgsRef;
enum { I_X = 0, I_C, I_CTX, I_CCTX, I_ADAW, I_ADAB, I_NMIXG, I_NFFNG, I_HGWIN, I_HGLB, I_HGNG, I_HGWOUT, I_MLWIN, I_MLBG, I_MLCW, I_MLCB, I_MLNG, I_MLWOUT, I_RW, I_RB, I_W1, I_B1, I_W2, I_B2, I_FNG };

__device__ __forceinline__ float wave_sum(float v) {
#pragma unroll
    for (int o = 1; o < 64; o <<= 1) v += __shfl_xor(v, o);
    return v;
}

struct TItem { const float* W; bf16* WT; int N, drow, k0, n0, f8; };
__device__ __forceinline__ void titem_load(const TItem& t, float (&tv)[32], int lane) {
#pragma unroll
    for (int i = 0; i < 32; ++i) tv[i] = t.W[(size_t)(t.k0 + 2 * i + (lane >> 5)) * t.N + t.n0 + (lane & 31)];
}

template <int LAYER> __device__ __forceinline__ void expert_tiles(ArgsRef a, LAS unsigned char* lds, int max_tiles) {
    const int tid = threadIdx.x, lane = tid & 63, wave = __builtin_amdgcn_readfirstlane(tid >> 6);
    constexpr int TP = 260;
    LAS float* T = (LAS float*)lds;
    const float* W1 = a.in[I_W1] + (size_t)LAYER * 32 * D * 2048; const float* W2 = a.in[I_W2] + (size_t)LAYER * 32 * D * D;
    unsigned char* W1T = a.ws + WS_W1 + (size_t)LAYER * 32 * 2048 * D; unsigned char* W2T = a.ws + WS_W2 + (size_t)LAYER * 32 * D * D;
    constexpr int NT1 = 32 * 64, NL = NT1 + 32 * 32;
    auto tsrc = [&](int t, int& N) -> const float* { if (t < NT1) { const int mat = t >> 6, r = t & 63; N = 2048; return W1 + ((size_t)mat * D + 128 * (r >> 3)) * 2048 + 256 * (r & 7); }
        const int t2 = t - NT1, mat = t2 >> 5, r = t2 & 31; N = D; return W2 + ((size_t)mat * D + 128 * (r >> 2)) * D + 256 * (r & 3); };
    unsigned* tcnt = (unsigned*)(a.ws + WS_CTL) + CW_TILE + LAYER; LAS int* tq = (LAS int*)(lds + LDS_MISC + 16);
    __syncthreads();
    if (tid == 0) { tq[1] = max_tiles >= 1 ? (int)__hip_atomic_fetch_add(tcnt, 1u, __ATOMIC_RELAXED, __HIP_MEMORY_SCOPE_AGENT) : NL;
                    tq[0] = max_tiles >= 2 ? (int)__hip_atomic_fetch_add(tcnt, 1u, __ATOMIC_RELAXED, __HIP_MEMORY_SCOPE_AGENT) : NL; }
    __syncthreads();
    int t = tq[1];
    if (t < NL) {
        f32x4 v[16]; { int N; const float* sp = tsrc(t, N) + (size_t)(16 * wave) * N + 4 * lane;
#pragma unroll
            for (int i = 0; i < 16; ++i) v[i] = *(const f32x4*)(sp + (size_t)i * N); }
        for (int k = 1; ; ++k) {
#pragma unroll
            for (int i = 0; i < 16; ++i) *(LAS f32x4*)(T + (16 * wave + i) * TP + ((4 * lane + 8 * wave) & 255)) = v[i];
            __syncthreads();
            const int tn = tq[(k + 1) & 1]; unsigned tnn = 0u; const bool want = (k + 2 <= max_tiles) && tn < NL;
            if (tid == 0 && want) tnn = __hip_atomic_fetch_add(tcnt, 1u, __ATOMIC_RELAXED, __HIP_MEMORY_SCOPE_AGENT);
            if (tn < NL) { int N2; const float* sp = tsrc(tn, N2) + (size_t)(16 * wave) * N2 + 4 * lane;
#pragma unroll
                for (int i = 0; i < 16; ++i) v[i] = *(const f32x4*)(sp + (size_t)i * N2); }
            const int ks = lane & 7, nl = lane >> 3;
#pragma unroll
            for (int q = 0; q < 4; ++q) { const int n = 32 * wave + 8 * q + nl; unsigned char* dp;
                if (t < NT1) { const int mat = t >> 6, r = t & 63, ng = 256 * (r & 7) + n, cc = ng & 1023, bj = ng >> 10; dp = W1T + ((size_t)mat * 2048 + 256 * (cc >> 7) + 128 * bj + (cc & 127)) * D + 128 * (r >> 3); }
                else { const int t2 = t - NT1, mat = t2 >> 5, r = t2 & 31; dp = W2T + ((size_t)mat * D + 256 * (r & 3) + n) * D + 128 * (r >> 2); }
                const LAS float* tp = T + (16 * ks) * TP + ((n + 8 * ks) & 255); float x[16];
#pragma unroll
                for (int i = 0; i < 16; ++i) x[i] = 16.f * tp[i * TP];
                v4u o; o.x = pk4_fp8(x[0], x[1], x[2], x[3]); o.y = pk4_fp8(x[4], x[5], x[6], x[7]); o.z = pk4_fp8(x[8], x[9], x[10], x[11]); o.w = pk4_fp8(x[12], x[13], x[14], x[15]);
                *(v4u*)(dp + 16 * ks) = o; }
            if (tid == 0) tq[k & 1] = want ? (int)tnn : NL;
            __syncthreads();
            if (tn >= NL) break;
            t = tn;
        }
    }
}
template <class Sched> __device__ __forceinline__ bool idle_last_round(const Sched& S) { pg8::Unit u; Sched S0 = S; S0.c = 0; int n = 0, n0 = 0; while (S.next(n, u)) ++n; while (S0.next(n0, u)) ++n0; return n < n0; }

__device__ __forceinline__ void ph_prologue(ArgsRef a, LAS unsigned char* lds) {
    const int tid = threadIdx.x, lane = tid & 63, wave = __builtin_amdgcn_readfirstlane(tid >> 6), G = gridDim.x;
    unsigned char* ws = a.ws;
    float* modl = (float*)(ws + WS_SM + SM_MODL); float* modc = (float*)(ws + WS_SM + SM_MODC); float* oml = (float*)(ws + WS_SM + SM_OML);
    {
        LAS float* actT = (LAS float*)lds;
        LAS float* red = (LAS float*)(lds + 81920);
        bool staged = false;
        for (int it = blockIdx.x; it < 192; it += G) {
            if (!staged) {
                { float cv[34];
#pragma unroll
                    for (int i = 0; i < 34; ++i) { const int r = i >> 1, k = tid + 512 * (i & 1); cv[i] = r < 16 ? a.in[I_C][r * 1024 + k] : a.in[I_CCTX][k]; }
#pragma unroll
                    for (int i = 0; i < 34; ++i) { const int r = i >> 1, k = tid + 512 * (i & 1); actT[k * 20 + r] = siluf(cv[i]); } }
                __syncthreads(); staged = true;
            }
            const int layer = it / 96, n0 = (it % 96) * 64;
            const float* W = a.in[I_ADAW] + (size_t)layer * D * 6 * D + n0 + lane;
            float acc[17];
#pragma unroll
            for (int r = 0; r < 17; ++r) acc[r] = 0.f;
#pragma unroll 1
            for (int kb = wave * 128; kb < wave * 128 + 128; kb += 32) {
              float wv[32];
#pragma unroll
              for (int i = 0; i < 32; ++i) wv[i] = W[(size_t)(kb + i) * (6 * D)];
#pragma unroll
              for (int i = 0; i < 32; ++i) { const int k = kb + i; const float w = wv[i];
                const LAS f32x4* ap = (const LAS f32x4*)(actT + k * 20);
                const f32x4 a0 = ap[0], a1 = ap[1], a2 = ap[2], a3 = ap[3]; const float a16 = actT[k * 20 + 16];
                acc[0] += a0[0] * w; acc[1] += a0[1] * w; acc[2] += a0[2] * w; acc[3] += a0[3] * w;
                acc[4] += a1[0] * w; acc[5] += a1[1] * w; acc[6] += a1[2] * w; acc[7] += a1[3] * w;
                acc[8] += a2[0] * w; acc[9] += a2[1] * w; acc[10] += a2[2] * w; acc[11] += a2[3] * w;
                acc[12] += a3[0] * w; acc[13] += a3[1] * w; acc[14] += a3[2] * w; acc[15] += a3[3] * w;
                acc[16] += a16 * w;
              }
            }
#pragma unroll
            for (int r = 0; r < 17; ++r) red[(wave * 17 + r) * 64 + lane] = acc[r];
            __syncthreads();
            for (int idx = tid; idx < 17 * 64; idx += NTHREADS) { const int r = idx >> 6, l = idx & 63; float s = a.in[I_ADAB][layer * 6 * D + n0 + l];
#pragma unroll
                for (int w = 0; w < 8; ++w) s += red[(w * 17 + r) * 64 + l];
                const int sl = (n0 + l) >> 10, dcol = (n0 + l) & 1023;
                if (sl == 1) s = a.in[I_NMIXG][layer * D + dcol] * (1.0f + s); else if (sl == 4) s = a.in[I_NFFNG][layer * D + dcol] * (1.0f + s);
                if (r < 16) modl[((size_t)layer * 16 + r) * (6 * D) + n0 + l] = s; else modc[(size_t)layer * (6 * D) + n0 + l] = s; }
            __syncthreads();
        }
        __syncthreads();
    }
    {
        const int gt = blockIdx.x * NTHREADS + tid;
        if (gt < 2 * D) { const int dir = gt >> 10, c = gt & 1023; const float* lg = a.in[I_HGLB] + (size_t)dir * 3 * D + c;
            const float l0 = lg[0], l1 = lg[D], l2 = lg[2 * D]; const float mx = fmaxf(l0, fmaxf(l1, l2));
            const float e0 = __expf(l0 - mx), e1 = __expf(l1 - mx), e2 = __expf(l2 - mx);
            oml[gt] = (e1 + e2) / (e0 + e1 + e2); }
    }
    {
        LAS float* scr = (LAS float*)(lds + wave * 16384);
        const int gw = blockIdx.x * NWAVES + wave, NGW = G * NWAVES;
        bf16* WHGIN = (bf16*)(ws + WS_WHGIN); bf16* WHGOUT = (bf16*)(ws + WS_WHGOUT); bf16* WMLIN = (bf16*)(ws + WS_WMLIN); bf16* WMLOUT = (bf16*)(ws + WS_WMLOUT);
        bf16* W1T = (bf16*)(ws + WS_W1); bf16* W2T = (bf16*)(ws + WS_W2);
        constexpr int S0 = 16 * 160, S1 = 16 * 32, S2 = 16 * 97, S3 = 16 * 32, S4 = 64 * 16 * 64, S5 = 64 * 16 * 32;
        constexpr int NITEMS = S0 + S1 + S2 + S3;
        auto decode = [&](int it) -> TItem { int r = it; TItem t;
            if (r < S0) { t.f8 = 0; t.W = a.in[I_HGWIN]; t.N = HG_N; t.WT = WHGIN; t.drow = (r % 160) * 32; t.k0 = (r / 160) * 64; t.n0 = (r % 160) * 32; return t; } r -= S0;
            if (r < S1) { t.f8 = 0; t.W = a.in[I_HGWOUT]; t.N = D; t.WT = WHGOUT; t.drow = (r % 32) * 32; t.k0 = (r / 32) * 64; t.n0 = (r % 32) * 32; return t; } r -= S1;
            if (r < S2) { t.f8 = 0; t.W = a.in[I_MLWIN]; t.N = ML_N; t.WT = WMLIN; t.drow = (r % 97) * 32; t.k0 = (r / 97) * 64; t.n0 = (r % 97) * 32; return t; } r -= S2;
            if (r < S3) { t.f8 = 0; t.W = a.in[I_MLWOUT]; t.N = D; t.WT = WMLOUT; t.drow = (r % 32) * 32; t.k0 = (r / 32) * 64; t.n0 = (r % 32) * 32; return t; } r -= S3;
            if (r < S4) { const int mat = r >> 10, q = r & 1023, nb = q & 63, kb = q >> 6; const int n0 = nb * 32, cc = n0 & 1023, bj = n0 >> 10;
                t.f8 = 1; t.W = a.in[I_W1] + (size_t)mat * D * 2048; t.N = 2048; t.WT = (bf16*)((unsigned char*)W1T + (size_t)mat * 2048 * D); t.drow = 256 * (cc >> 7) + 128 * bj + (cc & 127); t.k0 = kb * 64; t.n0 = n0; return t; } r -= S4;
            { const int mat = r >> 9, q = r & 511, nb = q & 31, kb = q >> 5;
                t.f8 = 1; t.W = a.in[I_W2] + (size_t)mat * D * D; t.N = D; t.WT = (bf16*)((unsigned char*)W2T + (size_t)mat * D * D); t.drow = nb * 32; t.k0 = kb * 64; t.n0 = nb * 32; return t; } };
        float tv[32]; TItem cur = decode(gw < NITEMS ? gw : 0);
        titem_load(cur, tv, lane);
        for (int it = gw; it < NITEMS; it += NGW) {
#pragma unroll
            for (int i = 0; i < 32; ++i) scr[(2 * i + (lane >> 5)) * 33 + (lane & 31)] = tv[i];
            LDS_WAIT(); asm volatile("" ::: "memory");
            const TItem nxt = decode(it + NGW < NITEMS ? it + NGW : it);
            if (it + NGW < NITEMS) titem_load(nxt, tv, lane);
            const int c = lane & 7;
#pragma unroll
            for (int j = 0; j < 4; ++j) { const int n = (lane >> 3) + 8 * j; const LAS float* sp = scr + (8 * c) * 33 + n;
                if (cur.f8) { v2u o8; o8.x = pk4_fp8(16.f * sp[0 * 33], 16.f * sp[1 * 33], 16.f * sp[2 * 33], 16.f * sp[3 * 33]); o8.y = pk4_fp8(16.f * sp[4 * 33], 16.f * sp[5 * 33], 16.f * sp[6 * 33], 16.f * sp[7 * 33]);
                    *(v2u*)((unsigned char*)cur.WT + (size_t)(cur.drow + n) * D + cur.k0 + 8 * c) = o8; }
                else { v4u o; o.x = pk2(sp[0 * 33], sp[1 * 33]); o.y = pk2(sp[2 * 33], sp[3 * 33]); o.z = pk2(sp[4 * 33], sp[5 * 33]); o.w = pk2(sp[6 * 33], sp[7 * 33]);
                    *(v4u*)(cur.WT + (size_t)(cur.drow + n) * D + cur.k0 + 8 * c) = o; } }
            LDS_WAIT(); asm volatile("" ::: "memory");
            cur = nxt;
        }
        for (size_t i = (size_t)blockIdx.x * NTHREADS + tid; i < (size_t)(ML_NP - ML_N) * D / 8; i += (size_t)G * NTHREADS) ((v4u*)(WMLIN + (size_t)ML_N * D))[i] = (v4u){0u, 0u, 0u, 0u};
    }
    expert_tiles<0>(a, lds, 1 << 30);
}

__device__ __forceinline__ void ph_modulate(ArgsRef a, const float* src_ctx, const float* src_lat, const float* g, int layer, int shift_idx, int R0, int R1, bf16* out) {
    const int tid = threadIdx.x, lane = tid & 63, wave = __builtin_amdgcn_readfirstlane(tid >> 6);
    const float* modl = (const float*)(a.ws + WS_SM + SM_MODL) + (size_t)layer * 16 * 6 * D; const float* modc = (const float*)(a.ws + WS_SM + SM_MODC) + (size_t)layer * 6 * D;
    const int gw = blockIdx.x * NWAVES + wave, NGW = gridDim.x * NWAVES;
    for (int Rq = R0 + gw; Rq < R1; Rq += 2 * NGW) {
        f32x4 v[2][4], sh[2][4], sc[2][4];
#pragma unroll
        for (int u = 0; u < 2; ++u) { const int R = (Rq + u * NGW < R1) ? Rq + u * NGW : Rq;
            const bool isctx = R < NTC;
            const float* xr = isctx ? src_ctx + (size_t)R * D : src_lat + (size_t)(R - NTC) * D;
            const float* mod = isctx ? modc : modl + (size_t)((R - NTC) / SEQ) * 6 * D;
#pragma unroll
            for (int j = 0; j < 4; ++j) { v[u][j] = ((const f32x4*)xr)[64 * j + lane]; sh[u][j] = ((const f32x4*)(mod + shift_idx * D))[64 * j + lane]; sc[u][j] = ((const f32x4*)(mod + (shift_idx + 1) * D))[64 * j + lane]; } }
#pragma unroll
        for (int u = 0; u < 2; ++u) { const int R = Rq + u * NGW;
            float ss = 0.f;
#pragma unroll
            for (int j = 0; j < 4; ++j) ss += (v[u][j][0] * v[u][j][0] + v[u][j][1] * v[u][j][1]) + (v[u][j][2] * v[u][j][2] + v[u][j][3] * v[u][j][3]);
            const float rs = 1.0f / sqrtf(wave_sum(ss) * (1.0f / D) + EPS);
            if (R < R1) { v2u* o8 = (v2u*)(out + (size_t)R * D);
#pragma unroll
                for (int j = 0; j < 4; ++j) { const f32x4 y = v[u][j] * rs * sc[u][j] + sh[u][j];
                    v2u w; w.x = pk2(y[0], y[1]); w.y = pk2(y[2], y[3]); o8[64 * j + lane] = w; } } }
    }
}

__device__ __forceinline__ int seq_row(int b, int dir, int p) {
    if (p < CTX) { const int t = dir ? CTX - 1 - p : p; return b * CTX + t; }
    const int pl = p - CTX; const int t = dir ? SEQ - 1 - pl : pl; return NTC + b * SEQ + t;
}


typedef short s16x4 __attribute__((ext_vector_type(4)));
typedef float f32x16 __attribute__((ext_vector_type(16)));
__device__ __forceinline__ unsigned offb(unsigned row, unsigned ch) { return 256u * row + 16u * (ch ^ (((row & 3u) << 2) | ((row >> 2) & 3u))); }
__device__ __forceinline__ s16x4 tr16(const LAS unsigned char* p) { return __builtin_amdgcn_ds_read_tr16_b64_v4i16((LAS s16x4*)p); }
__device__ __forceinline__ bf16x8 rd_row_b(const LAS unsigned char* tile, int lane, int rb, int kk) { return *(const LAS bf16x8*)(tile + offb(32 * rb + (lane & 31), 2 * kk + (lane >> 5))); }
__device__ __forceinline__ bf16x8 rd_tr_b(const LAS unsigned char* tile, int lane, int c, int ks) {
    const unsigned h = lane >> 5, blk = (lane >> 4) & 1, q = (lane & 15) >> 2, p = lane & 3;
    const s16x4 x = tr16(tile + offb(16 * ks + 8 * h + q, 4 * c + 2 * blk + (p >> 1)) + 8 * (p & 1));
    const s16x4 y = tr16(tile + offb(16 * ks + 8 * h + 4 + q, 4 * c + 2 * blk + (p >> 1)) + 8 * (p & 1));
    return (bf16x8){x[0], x[1], x[2], x[3], y[0], y[1], y[2], y[3]};
}
__device__ __forceinline__ bf16x8 rd_row_p(const LAS unsigned char* tile, int st, int lane, int rb, int kk) { return *(const LAS bf16x8*)(tile + (32 * rb + (lane & 31)) * st + (16 * kk + 8 * (lane >> 5)) * 2); }
__device__ __forceinline__ bf16x8 rd_tr_p(const LAS unsigned char* tile, int st, int lane, int c, int ks) {
    const unsigned h = lane >> 5, blk = (lane >> 4) & 1, q = (lane & 15) >> 2, p = lane & 3;
    const LAS unsigned char* b = tile + (16 * ks + 8 * h + q) * st + (32 * c + 16 * blk + 4 * p) * 2;
    const s16x4 x = tr16(b), y = tr16(b + 4 * st);
    return (bf16x8){x[0], x[1], x[2], x[3], y[0], y[1], y[2], y[3]};
}
__device__ __forceinline__ void tri_tile(int idx, int& ti4, int& si4) {
    ti4 = idx < 1 ? 0 : idx < 3 ? 1 : idx < 6 ? 2 : 3; si4 = idx - (ti4 * (ti4 + 1)) / 2;
}

__device__ __forceinline__ void ph_hg_scan(ArgsRef a, LAS unsigned char* lds) {
    const int tid = threadIdx.x, lane = tid & 63, w = __builtin_amdgcn_readfirstlane(tid >> 6), hh = lane >> 5, r32 = lane & 31;
    const bf16* QS = (const bf16*)(a.ws + WS_BIG); const bf16* VI = QS + (size_t)NT * D; const bf16* KF = VI + (size_t)NT * D; const bf16* KB = KF + (size_t)NT * D;
    bf16* OF = (bf16*)(a.ws + WS_BIG + 5 * T72); bf16* OB = OF + (size_t)NT * D;
    constexpr int SQ = 272, SV = 320, SA = 144;
    constexpr int O_QA = 0, O_KA = 17408, O_V = 34816, O_ST = 55296, O_ATT = 90112, O_OST = 99328, O_TOT = 116736, O_FIRST = 120832, O_EB = 124928, O_EG = 125440;
    LAS unsigned char* QA = lds + O_QA; LAS unsigned char* KA = lds + O_KA; LAS unsigned char* VT = lds + O_V; LAS unsigned char* ST = lds + O_ST;
    LAS unsigned char* ATT = lds + O_ATT; LAS unsigned char* OST = lds + O_OST;
    LAS float* TOT = (LAS float*)(lds + O_TOT); LAS float* FIRST = (LAS float*)(lds + O_FIRST); LAS float* EB = (LAS float*)(lds + O_EB); LAS float* EG = (LAS float*)(lds + O_EG);
    for (int i = tid; i < 64 * SA / 4; i += NTHREADS) ((LAS unsigned*)ATT)[i] = 0u;
    const int ls = tid >> 4, lc = tid & 15;
    const int tq = (lane & 15) >> 2, tp = lane & 3, tblk = (lane >> 4) & 1;
    const LAS unsigned char* rQA = QA + r32 * SQ + hh * 16;
    const LAS unsigned char* rST = ST + r32 * SQ + hh * 16;
    const LAS unsigned char* rATT = ATT + r32 * SA + hh * 16;
    const LAS unsigned char* tV = VT + (8 * hh + tq) * SV + (16 * tblk + 4 * tp) * 2;
    const LAS unsigned char* tK = KA + (8 * hh + tq) * SQ + (16 * tblk + 4 * tp) * 2;
    const int fr = lane & 15, fq = lane >> 4;
    const int ti = w >> 2, ej = w & 3, di = w >> 1, e2 = 2 * (w & 1);
    for (int item = blockIdx.x; item < 256; item += gridDim.x) {
        const int dir = item & 1, h = (item >> 1) & 7, b = item >> 4;
        const bf16* Kd = dir ? KB : KF; bf16* Od = dir ? OB : OF;
        f32x16 S0, S1;
#pragma unroll
        for (int i = 0; i < 16; ++i) { S0[i] = 0.f; S1[i] = 0.f; }
        v4u pq[2], pk[2], pv[2];
#pragma unroll
        for (int x = 0; x < 2; ++x) { const size_t off = (size_t)seq_row(b, dir, ls + 32 * x) * D + h * 128 + lc * 8; pq[x] = *(const v4u*)(QS + off); pk[x] = *(const v4u*)(Kd + off); pv[x] = *(const v4u*)(VI + off); }
#pragma unroll
        for (int x = 0; x < 2; ++x) { *(LAS v4u*)(QA + (ls + 32 * x) * SQ + lc * 16) = pq[x]; *(LAS v4u*)(KA + (ls + 32 * x) * SQ + lc * 16) = pk[x]; *(LAS v4u*)(VT + (ls + 32 * x) * SV + lc * 16) = pv[x]; }
        for (int ch = 0; ch < (CTX + SEQ) / 64; ++ch) {
            __syncthreads();
            if (ch + 1 < (CTX + SEQ) / 64) {
#pragma unroll
                for (int x = 0; x < 2; ++x) { const size_t off = (size_t)seq_row(b, dir, (ch + 1) * 64 + ls + 32 * x) * D + h * 128 + lc * 8; pq[x] = *(const v4u*)(QS + off); pk[x] = *(const v4u*)(Kd + off); pv[x] = *(const v4u*)(VI + off); }
            }
            unsigned kwv[8], qwv[8]; float l0[8], l1[8];
#pragma unroll
            for (int i = 0; i < 8; ++i) { kwv[i] = *(const LAS unsigned*)(KA + (8 * w + i) * SQ + lane * 4); qwv[i] = *(const LAS unsigned*)(QA + (8 * w + i) * SQ + lane * 4); }
            { float r0 = 0.f, r1 = 0.f;
#pragma unroll
                for (int i = 0; i < 8; ++i) { l0[i] = __builtin_amdgcn_logf(fmaxf(1.0f - bf2f(kwv[i] & 0xffffu), 1e-30f)); l1[i] = __builtin_amdgcn_logf(fmaxf(1.0f - bf2f(kwv[i] >> 16), 1e-30f)); r0 += l0[i]; r1 += l1[i]; }
                *(LAS f32x2*)(TOT + w * 128 + 2 * lane) = (f32x2){r0, r1}; *(LAS f32x2*)(FIRST + w * 128 + 2 * lane) = (f32x2){l0[0], l1[0]}; }
            __syncthreads();
            { float p0 = 0.f, p1 = 0.f, br0 = 0.f, br1 = 0.f, be0 = 0.f, be1 = 0.f; f32x2 tt[8];
#pragma unroll
                for (int o = 0; o < 8; ++o) tt[o] = *(const LAS f32x2*)(TOT + o * 128 + 2 * lane);
                const f32x2 ff = *(const LAS f32x2*)(FIRST + 4 * 128 + 2 * lane);
#pragma unroll
                for (int o = 0; o < 8; ++o) { if (o < w) { p0 += tt[o][0]; p1 += tt[o][1]; } if (o < 4) { br0 += tt[o][0]; br1 += tt[o][1]; } be0 += tt[o][0]; be1 += tt[o][1]; }
                br0 += ff[0]; br1 += ff[1];
#pragma unroll
                for (int i = 0; i < 8; ++i) { p0 += l0[i]; p1 += l1[i];
                    const float ea0 = __builtin_amdgcn_exp2f(p0 - br0), ea1 = __builtin_amdgcn_exp2f(p1 - br1), ek0 = __builtin_amdgcn_exp2f(br0 - p0), ek1 = __builtin_amdgcn_exp2f(br1 - p1);
                    *(LAS unsigned*)(QA + (8 * w + i) * SQ + lane * 4) = pk2(bf2f(qwv[i] & 0xffffu) * ea0, bf2f(qwv[i] >> 16) * ea1);
                    *(LAS unsigned*)(KA + (8 * w + i) * SQ + lane * 4) = pk2(bf2f(kwv[i] & 0xffffu) * ek0, bf2f(kwv[i] >> 16) * ek1); }
                if (w == 0) { *(LAS f32x2*)(EB + 2 * lane) = (f32x2){__builtin_amdgcn_exp2f(br0), __builtin_amdgcn_exp2f(br1)}; *(LAS f32x2*)(EG + 2 * lane) = (f32x2){__builtin_amdgcn_exp2f(be0 - br0), __builtin_amdgcn_exp2f(be1 - br1)}; } }
            __syncthreads();
            {
                f32x4 eb[4], eg[4];
#pragma unroll
                for (int g = 0; g < 4; ++g) { eb[g] = *(const LAS f32x4*)(EB + 32 * di + 8 * g + 4 * hh); eg[g] = *(const LAS f32x4*)(EG + 32 * di + 8 * g + 4 * hh); }
                bf16x8 kA[4], vB0[4], vB1[4];
#pragma unroll
                for (int kk = 0; kk < 4; ++kk) { const LAS unsigned char* pa = tK + kk * 16 * SQ + di * 64; const s16x4 x = tr16(pa), y = tr16(pa + 4 * SQ); kA[kk] = (bf16x8){x[0], x[1], x[2], x[3], y[0], y[1], y[2], y[3]}; }
#pragma unroll
                for (int kk = 0; kk < 4; ++kk) { const LAS unsigned char* pb = tV + kk * 16 * SV + e2 * 64; const s16x4 x = tr16(pb), y = tr16(pb + 4 * SV), x2 = tr16(pb + 64), y2 = tr16(pb + 64 + 4 * SV);
                    vB0[kk] = (bf16x8){x[0], x[1], x[2], x[3], y[0], y[1], y[2], y[3]}; vB1[kk] = (bf16x8){x2[0], x2[1], x2[2], x2[3], y2[0], y2[1], y2[2], y2[3]}; }
#pragma unroll
                for (int rep = 0; rep < 2; ++rep) { const int idx = w + 8 * rep; if (idx < 10) { int ti4, si4; tri_tile(idx, ti4, si4);
                    bf16x8 A[4], Bm[4];
#pragma unroll
                    for (int kk = 0; kk < 4; ++kk) { A[kk] = *(const LAS bf16x8*)(QA + (16 * ti4 + fr) * SQ + fq * 16 + kk * 64); Bm[kk] = *(const LAS bf16x8*)(KA + (16 * si4 + fr) * SQ + fq * 16 + kk * 64); }
                    f32x4 acc = (f32x4){0.f, 0.f, 0.f, 0.f};
#pragma unroll
                    for (int kk = 0; kk < 4; ++kk) acc = __builtin_amdgcn_mfma_f32_16x16x32_bf16(A[kk], Bm[kk], acc, 0, 0, 0);
                    const int scol = 16 * si4 + fr;
#pragma unroll
                    for (int r = 0; r < 4; ++r) { const int trow = 16 * ti4 + 4 * fq + r; *(LAS unsigned short*)(ATT + trow * SA + scol * 2) = (unsigned short)f2bf(scol <= trow ? acc[r] : 0.f); } } }
#pragma unroll
                for (int g = 0; g < 4; ++g) {
#pragma unroll
                    for (int j = 0; j < 4; ++j) { S0[4 * g + j] *= eb[g][j]; S1[4 * g + j] *= eb[g][j]; }
                    v2u w0, w1; w0.x = pk2(S0[4 * g], S0[4 * g + 1]); w0.y = pk2(S0[4 * g + 2], S0[4 * g + 3]); w1.x = pk2(S1[4 * g], S1[4 * g + 1]); w1.y = pk2(S1[4 * g + 2], S1[4 * g + 3]);
                    *(LAS v2u*)(ST + (32 * e2 + r32) * SQ + (32 * di + 8 * g + 4 * hh) * 2) = w0; *(LAS v2u*)(ST + (32 * e2 + 32 + r32) * SQ + (32 * di + 8 * g + 4 * hh) * 2) = w1; }
#pragma unroll
                for (int kk = 0; kk < 4; ++kk) { S0 = __builtin_amdgcn_mfma_f32_32x32x16_bf16(kA[kk], vB0[kk], S0, 0, 0, 0); S1 = __builtin_amdgcn_mfma_f32_32x32x16_bf16(kA[kk], vB1[kk], S1, 0, 0, 0); }
#pragma unroll
                for (int g = 0; g < 4; ++g)
#pragma unroll
                    for (int j = 0; j < 4; ++j) { S0[4 * g + j] *= eg[g][j]; S1[4 * g + j] *= eg[g][j]; }
            }
            __syncthreads();
            { f32x16 o;
#pragma unroll
                for (int i = 0; i < 16; ++i) o[i] = 0.f;
                bf16x8 A[4], Bm[4];
#pragma unroll
                for (int kk = 0; kk < 4; ++kk) { A[kk] = *(const LAS bf16x8*)(rATT + ti * 32 * SA + kk * 32); const LAS unsigned char* pb = tV + kk * 16 * SV + ej * 64; const s16x4 x = tr16(pb), y = tr16(pb + 4 * SV); Bm[kk] = (bf16x8){x[0], x[1], x[2], x[3], y[0], y[1], y[2], y[3]}; }
                bf16x8 A2[4], B2[4];
#pragma unroll
                for (int kk = 0; kk < 4; ++kk) { A2[kk] = *(const LAS bf16x8*)(rQA + ti * 32 * SQ + kk * 32); B2[kk] = *(const LAS bf16x8*)(rST + ej * 32 * SQ + kk * 32); }
#pragma unroll
                for (int kk = 0; kk < 4; ++kk) o = __builtin_amdgcn_mfma_f32_32x32x16_bf16(A[kk], Bm[kk], o, 0, 0, 0);
#pragma unroll
                for (int kk = 0; kk < 4; ++kk) { A[kk] = *(const LAS bf16x8*)(rQA + ti * 32 * SQ + (kk + 4) * 32); Bm[kk] = *(const LAS bf16x8*)(rST + ej * 32 * SQ + (kk + 4) * 32); }
#pragma unroll
                for (int kk = 0; kk < 4; ++kk) o = __builtin_amdgcn_mfma_f32_32x32x16_bf16(A2[kk], B2[kk], o, 0, 0, 0);
#pragma unroll
                for (int kk = 0; kk < 4; ++kk) o = __builtin_amdgcn_mfma_f32_32x32x16_bf16(A[kk], Bm[kk], o, 0, 0, 0);
                const int ecol = 32 * ej + r32;
#pragma unroll
                for (int r = 0; r < 16; ++r) { const int trow = 32 * ti + (r & 3) + 8 * (r >> 2) + 4 * hh; *(LAS unsigned short*)(OST + trow * SQ + ecol * 2) = (unsigned short)f2bf(o[r]); } }
            __syncthreads();
            if (ch + 1 < (CTX + SEQ) / 64) {
#pragma unroll
                for (int x = 0; x < 2; ++x) { *(LAS v4u*)(QA + (ls + 32 * x) * SQ + lc * 16) = pq[x]; *(LAS v4u*)(KA + (ls + 32 * x) * SQ + lc * 16) = pk[x]; *(LAS v4u*)(VT + (ls + 32 * x) * SV + lc * 16) = pv[x]; } }
#pragma unroll
            for (int x = 0; x < 2; ++x) { const int row = ls + 32 * x; const v4u val = *(const LAS v4u*)(OST + row * SQ + lc * 16);
                *(v4u*)(Od + (size_t)seq_row(b, dir, ch * 64 + row) * D + h * 128 + lc * 8) = val; }
        }
        __syncthreads();
    }
}


__device__ __forceinline__ float wave_incl_sum(float v) {
    v += dppf<0x111, 0xf>(0.f, v); v += dppf<0x112, 0xf>(0.f, v); v += dppf<0x114, 0xf>(0.f, v); v += dppf<0x118, 0xf>(0.f, v);
    v += dppf<0x142, 0xa>(0.f, v); v += dppf<0x143, 0xc>(0.f, v); return v;
}
__device__ __forceinline__ float wave_incl_max(float v) {
    const float ninf = -3.0e38f;
    v = fmaxf(v, dppf<0x111, 0xf>(ninf, v)); v = fmaxf(v, dppf<0x112, 0xf>(ninf, v)); v = fmaxf(v, dppf<0x114, 0xf>(ninf, v)); v = fmaxf(v, dppf<0x118, 0xf>(ninf, v));
    v = fmaxf(v, dppf<0x142, 0xa>(ninf, v)); v = fmaxf(v, dppf<0x143, 0xc>(ninf, v)); return v;
}
__device__ __forceinline__ void ph_ml_scan(ArgsRef a, LAS unsigned char* lds) {
    const int tid = threadIdx.x, lane = tid & 63, w = __builtin_amdgcn_readfirstlane(tid >> 6), hh = lane >> 5, r32 = lane & 31;
    const bf16* QK = (const bf16*)(a.ws + WS_BIG + 3 * T72); const bf16* VV = (const bf16*)(a.ws + WS_BIG + 1 * T72);
    bf16* HF = (bf16*)(a.ws + WS_BIG + 4 * T72); bf16* HB = (bf16*)(a.ws + WS_BIG + 5 * T72);
    const float* Gt = (const float*)(a.ws + WS_GT);
    constexpr int SA = 144, SO = 272, SV = 320;
    constexpr int O_Q = 0, O_K = 9216, O_KW = 18432, O_SC = 27648, O_V = 36864, O_CT = 57344, O_OST = 75776, O_VEC = 93184, O_NP = 95488;
    LAS unsigned char* Qt = lds + O_Q; LAS unsigned char* Kt = lds + O_K; LAS unsigned char* KW = lds + O_KW; LAS unsigned char* SC = lds + O_SC;
    LAS unsigned char* VT = lds + O_V; LAS unsigned char* CT = lds + O_CT; LAS unsigned char* OST = lds + O_OST;
    LAS float* vA = (LAS float*)(lds + O_VEC); LAS float* vM = vA + 64; LAS float* vWI = vM + 64; LAS float* vEMM = vWI + 64; LAS float* vWK = vEMM + 64;
    LAS float* vRI = vWK + 64; LAS float* vWIRI = vRI + 64; LAS float* vN = vWIRI + 64; LAS float* vSC = vN + 64;
    LAS float* NP = (LAS float*)(lds + O_NP);
    for (int i = tid; i < 64 * SA / 4; i += NTHREADS) ((LAS unsigned*)SC)[i] = 0u;
    const int ls = tid >> 4, lc = tid & 15;
    const int qs = tid >> 3, qc = tid & 7;
    const int tq = (lane & 15) >> 2, tp = lane & 3, tblk = (lane >> 4) & 1;
    const LAS unsigned char* tV = VT + (8 * hh + tq) * SV + (16 * tblk + 4 * tp) * 2;
    const LAS unsigned char* tKW = KW + (8 * hh + tq) * SA + (16 * tblk + 4 * tp) * 2;
    const int fr = lane & 15, fq = lane >> 4;
    const int ti = w >> 2, ej = w & 3, di = w >> 2;
    for (int item = blockIdx.x; item < 256; item += gridDim.x) {
        const int dir = item & 1, h = (item >> 1) & 7, b = item >> 4;
        bf16* Hd = dir ? HB : HF;
        const int ci = dir * 8 + h, cf = 16 + dir * 8 + h;
        f32x16 Cs;
#pragma unroll
        for (int i = 0; i < 16; ++i) Cs[i] = 0.f;
        for (int i = tid; i < 128 * SA / 4; i += NTHREADS) ((LAS unsigned*)CT)[i] = 0u;
        if (tid < 64) vN[tid] = 0.f;
        NP[tid] = 0.f;
        float m0 = 0.f, m0n = 0.f, dec_prev = 0.f;
        v4u pq, pk, pv[2]; float pgi = 0.f, pgf = 0.f;
        { const size_t ro = (size_t)seq_row(b, dir, qs) * D; pq = *(const v4u*)(QK + ro + h * 64 + qc * 8); pk = *(const v4u*)(QK + ro + 512 + h * 64 + qc * 8);
#pragma unroll
            for (int x = 0; x < 2; ++x) pv[x] = *(const v4u*)(VV + (size_t)seq_row(b, dir, ls + 32 * x) * D + h * 128 + lc * 8);
            if (tid < 64) { const float* gr = Gt + (size_t)seq_row(b, dir, tid) * 32; pgi = gr[ci]; pgf = gr[cf]; } }
        __syncthreads();
#define ML_S0() do { \
            *(LAS v4u*)(Qt + qs * SA + qc * 16) = pq; *(LAS v4u*)(Kt + qs * SA + qc * 16) = pk; \
            _Pragma("unroll") for (int x = 0; x < 2; ++x) *(LAS v4u*)(VT + (ls + 32 * x) * SV + lc * 16) = pv[x]; \
            if (w == 0) { \
                float np[8]; \
                _Pragma("unroll") for (int o = 0; o < 8; ++o) np[o] = NP[o * 64 + lane]; \
                const float nold = vN[lane]; \
                const float bb = wave_incl_sum(pgf); \
                const float aa = pgi - bb; const float cm = wave_incl_max(aa); \
                const float M = fmaxf(m0, cm), M63 = __shfl(M, 63), bend = __shfl(bb, 63); \
                vA[lane] = aa; vM[lane] = M; vWI[lane] = __expf(m0 - M); vEMM[lane] = __expf(-(bb + M)); vWK[lane] = __expf(aa - M63); \
                const float dec = __expf(m0 - M63); \
                if (lane == 0) vSC[0] = dec; \
                vN[lane] = dec_prev * nold + (((np[0] + np[1]) + (np[2] + np[3])) + ((np[4] + np[5]) + (np[6] + np[7]))); \
                dec_prev = dec; m0n = bend + M63; \
            } } while (0)
        ML_S0();
        for (int ch = 0; ch < (CTX + SEQ) / 64; ++ch) {
            __syncthreads();
            if (ch + 1 < (CTX + SEQ) / 64) { const size_t ro = (size_t)seq_row(b, dir, (ch + 1) * 64 + qs) * D; pq = *(const v4u*)(QK + ro + h * 64 + qc * 8); pk = *(const v4u*)(QK + ro + 512 + h * 64 + qc * 8);
#pragma unroll
                for (int x = 0; x < 2; ++x) pv[x] = *(const v4u*)(VV + (size_t)seq_row(b, dir, (ch + 1) * 64 + ls + 32 * x) * D + h * 128 + lc * 8);
                if (tid < 64) { const float* gr = Gt + (size_t)seq_row(b, dir, (ch + 1) * 64 + tid) * 32; pgi = gr[ci]; pgf = gr[cf]; } }
            {
                const v4u kv = *(const LAS v4u*)(Kt + qs * SA + qc * 16); const float wk = vWK[qs];
#pragma unroll
                for (int rep = 0; rep < 2; ++rep) { const int idx = w + 8 * rep; if (idx < 10) { int ti4, si4; tri_tile(idx, ti4, si4);
                    const bf16x8 A0 = *(const LAS bf16x8*)(Qt + (16 * ti4 + fr) * SA + fq * 16), A1 = *(const LAS bf16x8*)(Qt + (16 * ti4 + fr) * SA + fq * 16 + 64);
                    const bf16x8 B0 = *(const LAS bf16x8*)(Kt + (16 * si4 + fr) * SA + fq * 16), B1 = *(const LAS bf16x8*)(Kt + (16 * si4 + fr) * SA + fq * 16 + 64);
                    const int scol = 16 * si4 + fr; const float as = vA[scol]; const f32x4 M4 = *(const LAS f32x4*)(vM + 16 * ti4 + 4 * fq);
                    f32x4 acc = (f32x4){0.f, 0.f, 0.f, 0.f};
                    acc = __builtin_amdgcn_mfma_f32_16x16x32_bf16(A0, B0, acc, 0, 0, 0); acc = __builtin_amdgcn_mfma_f32_16x16x32_bf16(A1, B1, acc, 0, 0, 0);
#pragma unroll
                    for (int r = 0; r < 4; ++r) { const int trow = 16 * ti4 + 4 * fq + r; *(LAS unsigned short*)(SC + trow * SA + scol * 2) = (unsigned short)f2bf(scol <= trow ? acc[r] * __expf(as - M4[r]) : 0.f); } } }
                const unsigned kx[4] = {kv.x, kv.y, kv.z, kv.w}; v4u o; float kf[8];
#pragma unroll
                for (int j = 0; j < 4; ++j) { kf[2 * j] = bf2f(kx[j] & 0xffffu) * wk; kf[2 * j + 1] = bf2f(kx[j] >> 16) * wk; }
                o.x = pk2(kf[0], kf[1]); o.y = pk2(kf[2], kf[3]); o.z = pk2(kf[4], kf[5]); o.w = pk2(kf[6], kf[7]);
                *(LAS v4u*)(KW + qs * SA + qc * 16) = o; }
            __syncthreads();
            f32x16 accA, accB;
            { const v4u sv = *(const LAS v4u*)(SC + qs * SA + qc * 16), qv = *(const LAS v4u*)(Qt + qs * SA + qc * 16); const f32x4 n0 = *(const LAS f32x4*)(vN + 8 * qc), n1 = *(const LAS f32x4*)(vN + 8 * qc + 4);
                const float wi = vWI[qs], emm = vEMM[qs], dec = vSC[0];
                unsigned short kwc[8];
#pragma unroll
                for (int i = 0; i < 8; ++i) kwc[i] = *(const LAS unsigned short*)(KW + (8 * w + i) * SA + lane * 2);
                bf16x8 A[4], Bm[4], A2[4], B2[4];
#pragma unroll
                for (int kk = 0; kk < 4; ++kk) { A[kk] = *(const LAS bf16x8*)(SC + (32 * ti + r32) * SA + hh * 16 + kk * 32); const LAS unsigned char* pb = tV + kk * 16 * SV + ej * 64; const s16x4 x = tr16(pb), y = tr16(pb + 4 * SV); Bm[kk] = (bf16x8){x[0], x[1], x[2], x[3], y[0], y[1], y[2], y[3]}; }
#pragma unroll
                for (int kk = 0; kk < 4; ++kk) { A2[kk] = *(const LAS bf16x8*)(Qt + (32 * ti + r32) * SA + hh * 16 + kk * 32); B2[kk] = *(const LAS bf16x8*)(CT + (32 * ej + r32) * SA + hh * 16 + kk * 32); }
                const unsigned sx[4] = {sv.x, sv.y, sv.z, sv.w}, qx[4] = {qv.x, qv.y, qv.z, qv.w};
                float ssum = 0.f;
#pragma unroll
                for (int j = 0; j < 4; ++j) { ssum += bf2f(sx[j] & 0xffffu) + bf2f(sx[j] >> 16); }
                const float dot = bf2f(qx[0] & 0xffffu) * n0[0] + bf2f(qx[0] >> 16) * n0[1] + bf2f(qx[1] & 0xffffu) * n0[2] + bf2f(qx[1] >> 16) * n0[3]
                    + bf2f(qx[2] & 0xffffu) * n1[0] + bf2f(qx[2] >> 16) * n1[1] + bf2f(qx[3] & 0xffffu) * n1[2] + bf2f(qx[3] >> 16) * n1[3];
                float part = ssum + wi * dot;
                part += __shfl_xor(part, 1); part += __shfl_xor(part, 2); part += __shfl_xor(part, 4);
                if (qc == 0) { const float rinv = 1.0f / fmaxf(fabsf(part), emm); vRI[qs] = rinv; vWIRI[qs] = wi * rinv; }
                { float cs = 0.f;
#pragma unroll
                    for (int i = 0; i < 8; ++i) cs += bf2f(kwc[i]);
                    NP[w * 64 + lane] = cs; }
#pragma unroll
                for (int i = 0; i < 16; ++i) { accA[i] = 0.f; accB[i] = 0.f; }
#pragma unroll
                for (int kk = 0; kk < 4; ++kk) accA = __builtin_amdgcn_mfma_f32_32x32x16_bf16(A[kk], Bm[kk], accA, 0, 0, 0);
#pragma unroll
                for (int kk = 0; kk < 4; ++kk) { const LAS unsigned char* pa = tKW + kk * 16 * SA + di * 64; const s16x4 x = tr16(pa), y = tr16(pa + 4 * SA); A[kk] = (bf16x8){x[0], x[1], x[2], x[3], y[0], y[1], y[2], y[3]}; }
#pragma unroll
                for (int kk = 0; kk < 4; ++kk) accB = __builtin_amdgcn_mfma_f32_32x32x16_bf16(A2[kk], B2[kk], accB, 0, 0, 0);
#pragma unroll
                for (int i = 0; i < 16; ++i) Cs[i] *= dec;
#pragma unroll
                for (int kk = 0; kk < 4; ++kk) Cs = __builtin_amdgcn_mfma_f32_32x32x16_bf16(A[kk], Bm[kk], Cs, 0, 0, 0); }
            __syncthreads();
            { const int ecol = 32 * ej + r32;
                f32x4 ri[4], wr[4];
#pragma unroll
                for (int g = 0; g < 4; ++g) { ri[g] = *(const LAS f32x4*)(vRI + 32 * ti + 8 * g + 4 * hh); wr[g] = *(const LAS f32x4*)(vWIRI + 32 * ti + 8 * g + 4 * hh); }
#pragma unroll
                for (int g = 0; g < 4; ++g) {
#pragma unroll
                    for (int j = 0; j < 4; ++j) { const int trow = 32 * ti + 8 * g + 4 * hh + j; *(LAS unsigned short*)(OST + trow * SO + ecol * 2) = (unsigned short)f2bf(accA[4 * g + j] * ri[g][j] + accB[4 * g + j] * wr[g][j]); }
                    v2u cw; cw.x = pk2(Cs[4 * g], Cs[4 * g + 1]); cw.y = pk2(Cs[4 * g + 2], Cs[4 * g + 3]);
                    *(LAS v2u*)(CT + ecol * SA + (32 * di + 8 * g + 4 * hh) * 2) = cw; }
                m0 = m0n; }
            __syncthreads();
            if (ch + 1 < (CTX + SEQ) / 64) ML_S0();
            if (ch >= CTX / 64) {
#pragma unroll
                for (int x = 0; x < 2; ++x) { const int row = ls + 32 * x; const v4u val = *(const LAS v4u*)(OST + row * SO + lc * 16);
                    *(v4u*)(Hd + (size_t)seq_row(b, dir, ch * 64 + row) * D + h * 128 + lc * 8) = val; } }
        }
#undef ML_S0
        __syncthreads();
    }
}

__device__ __forceinline__ void ph_readout(const bf16* Oa, const bf16* Ob, const bf16* gate, const float* g, int R0, int R1, bf16* Y) {
    const int tid = threadIdx.x, lane = tid & 63, wave = __builtin_amdgcn_readfirstlane(tid >> 6);
    const int gw = blockIdx.x * NWAVES + wave, NGW = gridDim.x * NWAVES;
    f32x4 gg[4];
#pragma unroll
    for (int j4 = 0; j4 < 4; ++j4) gg[j4] = *(const f32x4*)(g + lane * 16 + j4 * 4);
    for (int Rq = R0 + gw; Rq < R1; Rq += 2 * NGW) {
        v4u x[2][2], y[2][2], z[2][2];
#pragma unroll
        for (int u = 0; u < 2; ++u) { const int R = (Rq + u * NGW < R1) ? Rq + u * NGW : Rq; const size_t off = (size_t)R * D + lane * 16;
#pragma unroll
            for (int hh = 0; hh < 2; ++hh) { x[u][hh] = *(const v4u*)(Oa + off + hh * 8); y[u][hh] = *(const v4u*)(Ob + off + hh * 8); z[u][hh] = *(const v4u*)(gate + off + hh * 8); } }
#pragma unroll
        for (int u = 0; u < 2; ++u) { const int R = Rq + u * NGW; const size_t off = (size_t)R * D + lane * 16;
            float o[16], gt[16]; float ss = 0.f;
#pragma unroll
            for (int hh = 0; hh < 2; ++hh) {
                const unsigned xx[4] = {x[u][hh].x, x[u][hh].y, x[u][hh].z, x[u][hh].w}, yy[4] = {y[u][hh].x, y[u][hh].y, y[u][hh].z, y[u][hh].w}, zz[4] = {z[u][hh].x, z[u][hh].y, z[u][hh].z, z[u][hh].w};
#pragma unroll
                for (int j = 0; j < 4; ++j) { o[hh * 8 + 2 * j] = bf2f(xx[j] & 0xffffu) + bf2f(yy[j] & 0xffffu); o[hh * 8 + 2 * j + 1] = bf2f(xx[j] >> 16) + bf2f(yy[j] >> 16);
                    gt[hh * 8 + 2 * j] = bf2f(zz[j] & 0xffffu); gt[hh * 8 + 2 * j + 1] = bf2f(zz[j] >> 16); } }
#pragma unroll
            for (int j = 0; j < 16; ++j) ss += o[j] * o[j];
            ss += __shfl_xor(ss, 1); ss += __shfl_xor(ss, 2); ss += __shfl_xor(ss, 4);
            const float rs = 1.0f / sqrtf(ss * (1.0f / 128.0f) + EPS);
            float yv[16];
#pragma unroll
            for (int j4 = 0; j4 < 4; ++j4)
#pragma unroll
                for (int j = 0; j < 4; ++j) yv[j4 * 4 + j] = o[j4 * 4 + j] * rs * gg[j4][j] * gt[j4 * 4 + j];
            if (R < R1) { v4u w0, w1; w0.x = pk2(yv[0], yv[1]); w0.y = pk2(yv[2], yv[3]); w0.z = pk2(yv[4], yv[5]); w0.w = pk2(yv[6], yv[7]);
                w1.x = pk2(yv[8], yv[9]); w1.y = pk2(yv[10], yv[11]); w1.z = pk2(yv[12], yv[13]); w1.w = pk2(yv[14], yv[15]);
                *(v4u*)(Y + off) = w0; *(v4u*)(Y + off + 8) = w1; } }
    }
}

struct MoeTab { LAS int* pstart; LAS int* cnt; LAS int* nblk; LAS int* blkE; };
__device__ __forceinline__ MoeTab moe_tab(LAS unsigned char* lds) { MoeTab t; t.pstart = (LAS int*)(lds + LDS_TAB); t.cnt = t.pstart + 36; t.nblk = t.cnt + 32; t.blkE = t.nblk + 4; return t; }
__device__ __forceinline__ void moe_tables(ArgsRef a, int layer, LAS unsigned char* lds) {
    const MoeTab t = moe_tab(lds);
    const unsigned* cnt = (const unsigned*)(a.ws + WS_CTL) + CW_CNT + 64 * layer;
    __syncthreads();
    if (threadIdx.x < 32) t.cnt[threadIdx.x] = (int)__hip_atomic_load(cnt + threadIdx.x, __ATOMIC_RELAXED, __HIP_MEMORY_SCOPE_AGENT);
    __syncthreads();
    if (threadIdx.x < 64) { const int e = threadIdx.x & 31; const int nb = (t.cnt[e] + 255) >> 8; int incl = nb;
#pragma unroll
        for (int o = 1; o < 32; o <<= 1) { const int v = __shfl_up(incl, o, 32); if (e >= o) incl += v; }
        const int p0 = incl - nb;
        if (threadIdx.x < 32) { t.pstart[e] = p0 * 256; for (int j = 0; j < nb; ++j) t.blkE[p0 + j] = e; if (e == 31) { t.pstart[32] = incl * 256; t.nblk[0] = incl; } } }
    __syncthreads();
}

__device__ __forceinline__ void ph_router(ArgsRef a, const bf16* X, const float* g, int layer, int R0, int R1, bf16* Fout, LAS unsigned char* lds) {
    const int tid = threadIdx.x, lane = tid & 63, wave = __builtin_amdgcn_readfirstlane(tid >> 6), G = gridDim.x;
    const int fr = lane & 15, fq = lane >> 4;
    const float* modl = (const float*)(a.ws + WS_SM + SM_MODL) + (size_t)layer * 16 * 6 * D; const float* modc = (const float*)(a.ws + WS_SM + SM_MODC) + (size_t)layer * 6 * D;
    constexpr int APITCH = 2 * D + 16;
    constexpr int PPITCH = 36;
    LAS unsigned char* Ahi = lds; LAS unsigned char* Alo = lds + 16 * APITCH;
    LAS float* P = (LAS float*)(lds + 32 * APITCH);
    LAS int* cntL = (LAS int*)(lds + LDS_TAB);
    LAS int* baseL = cntL + 32;
    LAS int* infoL = baseL + 32;
    int* slot = (int*)(a.ws + WS_SLOT); float* gate = (float*)(a.ws + WS_GATE); int* rte = (int*)(a.ws + WS_RTE);
    unsigned* cntG = (unsigned*)(a.ws + WS_CTL) + CW_CNT + 64 * layer;
    const float* rw = a.in[I_RW] + (size_t)layer * D * NE; const float* rb = a.in[I_RB] + layer * NE;
    bf16x8 Bh[4][2], Bl[4][2];
#pragma unroll
    for (int kk = 0; kk < 4; ++kk)
#pragma unroll
        for (int nt = 0; nt < 2; ++nt) { v4u h, l;
#pragma unroll
            for (int j = 0; j < 4; ++j) { const float* wp = rw + (size_t)(32 * (4 * wave + kk) + 8 * fq + 2 * j) * NE + 16 * nt + fr; const float w0v = wp[0], w1v = wp[NE];
                const unsigned hh = pk2(w0v, w1v); h[j] = hh; l[j] = pk2(w0v - bf2f(hh & 0xffffu), w1v - bf2f(hh >> 16)); }
            Bh[kk][nt] = __builtin_bit_cast(bf16x8, h); Bl[kk][nt] = __builtin_bit_cast(bf16x8, l); }
    if (tid < 32) cntL[tid] = 0;
    const int nrows = R1 - R0, per = (nrows + G - 1) / G;
    const int w0 = R0 + blockIdx.x * per, w1 = (w0 + per < R1) ? w0 + per : R1;
    const int ntile = (w1 > w0) ? (w1 - w0 + 15) >> 4 : 0;
    __syncthreads();
    v2u xq[2][4]; f32x4 shq[2][4], scq[2][4];
    if (ntile > 0) {
#pragma unroll
        for (int rr = 0; rr < 2; ++rr) { const int R = (w0 + 2 * wave + rr < w1) ? w0 + 2 * wave + rr : w1 - 1;
            const float* mod = (R < NTC) ? modc : modl + (size_t)((R - NTC) / SEQ) * 6 * D;
#pragma unroll
            for (int j = 0; j < 4; ++j) { xq[rr][j] = ((const v2u*)(X + (size_t)R * D))[64 * j + lane]; shq[rr][j] = ((const f32x4*)(mod + 3 * D))[64 * j + lane]; scq[rr][j] = ((const f32x4*)(mod + 4 * D))[64 * j + lane]; } }
    }
    for (int ti = 0; ti < ntile; ++ti) {
        const int r = w0 + 16 * ti + 2 * wave;
#pragma unroll
        for (int rr = 0; rr < 2; ++rr) {
            const int R = (r + rr < w1) ? r + rr : w1 - 1;
            f32x4 v[4]; float ss = 0.f;
#pragma unroll
            for (int j = 0; j < 4; ++j) { const v2u xw = xq[rr][j]; v[j] = (f32x4){bf2f(xw.x & 0xffffu), bf2f(xw.x >> 16), bf2f(xw.y & 0xffffu), bf2f(xw.y >> 16)}; ss += (v[j][0] * v[j][0] + v[j][1] * v[j][1]) + (v[j][2] * v[j][2] + v[j][3] * v[j][3]); }
            const float rs = 1.0f / sqrtf(wave_sum(ss) * (1.0f / D) + EPS);
            unsigned* o8 = (unsigned*)((unsigned char*)Fout + (size_t)R * D);
            LAS unsigned char* ah = Ahi + (2 * wave + rr) * APITCH + 8 * lane; LAS unsigned char* al = Alo + (2 * wave + rr) * APITCH + 8 * lane;
#pragma unroll
            for (int j = 0; j < 4; ++j) { const f32x4 f = v[j] * rs * scq[rr][j] + shq[rr][j];
                if (r + rr < w1) o8[64 * j + lane] = pk4_fp8(f[0], f[1], f[2], f[3]);
                const unsigned h0 = pk2(f[0], f[1]), h1 = pk2(f[2], f[3]);
                *(LAS v2u*)(ah + 512 * j) = (v2u){h0, h1};
                *(LAS v2u*)(al + 512 * j) = (v2u){pk2(f[0] - bf2f(h0 & 0xffffu), f[1] - bf2f(h0 >> 16)), pk2(f[2] - bf2f(h1 & 0xffffu), f[3] - bf2f(h1 >> 16))}; }
            if (ti + 1 < ntile) { const int Rn = (r + 16 + rr < w1) ? r + 16 + rr : w1 - 1;
                const float* mod = (Rn < NTC) ? modc : modl + (size_t)((Rn - NTC) / SEQ) * 6 * D;
#pragma unroll
                for (int j = 0; j < 4; ++j) { xq[rr][j] = ((const v2u*)(X + (size_t)Rn * D))[64 * j + lane]; shq[rr][j] = ((const f32x4*)(mod + 3 * D))[64 * j + lane]; scq[rr][j] = ((const f32x4*)(mod + 4 * D))[64 * j + lane]; } }
        }
        __syncthreads();
        f32x4 acc[2] = {(f32x4){0.f, 0.f, 0.f, 0.f}, (f32x4){0.f, 0.f, 0.f, 0.f}};
#pragma unroll
        for (int kk = 0; kk < 4; ++kk) {
            const bf16x8 ahf = *(const LAS bf16x8*)(Ahi + fr * APITCH + 64 * (4 * wave + kk) + 16 * fq);
            const bf16x8 alf = *(const LAS bf16x8*)(Alo + fr * APITCH + 64 * (4 * wave + kk) + 16 * fq);
#pragma unroll
            for (int nt = 0; nt < 2; ++nt) {
                acc[nt] = __builtin_amdgcn_mfma_f32_16x16x32_bf16(alf, Bh[kk][nt], acc[nt], 0, 0, 0);
                acc[nt] = __builtin_amdgcn_mfma_f32_16x16x32_bf16(ahf, Bl[kk][nt], acc[nt], 0, 0, 0);
                acc[nt] = __builtin_amdgcn_mfma_f32_16x16x32_bf16(ahf, Bh[kk][nt], acc[nt], 0, 0, 0); }
        }
#pragma unroll
        for (int nt = 0; nt < 2; ++nt)
#pragma unroll
            for (int i = 0; i < 4; ++i) P[(wave * 16 + 4 * fq + i) * PPITCH + 16 * nt + fr] = acc[nt][i];
        __syncthreads();
        const int ex = lane & 31;
        float val = rb[ex];
#pragma unroll
        for (int w = 0; w < 8; ++w) val += P[(w * 16 + 2 * wave + (lane >> 5)) * PPITCH + ex];
        const unsigned bits = __float_as_uint(val);
        unsigned key = ((bits ^ ((unsigned)((int)bits >> 31) | 0x80000000u)) & ~31u) | (unsigned)(31 - ex);
        int te[4];
#pragma unroll
        for (int k = 0; k < 4; ++k) { unsigned m = key;
            m = max(m, (unsigned)__builtin_amdgcn_update_dpp((int)m, (int)m, 0x128, 0xf, 0xf, false));
            m = max(m, (unsigned)__builtin_amdgcn_update_dpp((int)m, (int)m, 0x124, 0xf, 0xf, false));
            m = max(m, (unsigned)__builtin_amdgcn_update_dpp((int)m, (int)m, 0x122, 0xf, 0xf, false));
            m = max(m, (unsigned)__builtin_amdgcn_update_dpp((int)m, (int)m, 0x121, 0xf, 0xf, false));
            const auto sw = __builtin_amdgcn_permlane16_swap(m, m, false, false); m = max((unsigned)sw[0], (unsigned)sw[1]);
            te[k] = 31 - (int)(m & 31u); if (ex == te[k]) key = 0u; }
        float tv[4];
#pragma unroll
        for (int k = 0; k < 4; ++k) tv[k] = __shfl(val, (lane & 32) | te[k]);
        const float e1 = __expf(tv[1] - tv[0]), e2 = __expf(tv[2] - tv[0]), e3 = __expf(tv[3] - tv[0]); const float inv = 1.0f / (1.0f + e1 + e2 + e3);
        const int R = r + (lane >> 5);
        if (ex < 4 && R < w1) {
            const int es = ex == 0 ? te[0] : ex == 1 ? te[1] : ex == 2 ? te[2] : te[3];
            const float gs = (ex == 0 ? 1.0f : ex == 1 ? e1 : ex == 2 ? e2 : e3) * inv;
            const int lr = __hip_atomic_fetch_add(cntL + es, 1, __ATOMIC_RELAXED, __HIP_MEMORY_SCOPE_WORKGROUP);
            infoL[(R - w0) * 4 + ex] = es | (lr << 8);
            gate[(size_t)R * 4 + ex] = gs;
        }
    }
    __syncthreads();
    if (tid < 32) baseL[tid] = (int)__hip_atomic_fetch_add(cntG + tid, (unsigned)cntL[tid], __ATOMIC_RELAXED, __HIP_MEMORY_SCOPE_AGENT);
    __syncthreads();
    for (int idx = tid; idx < (w1 - w0) * 4; idx += NTHREADS) { const int info = infoL[idx], e = info & 255, rk = baseL[e] + (info >> 8); const int R = w0 + (idx >> 2);
        slot[(size_t)R * 4 + (idx & 3)] = e | (rk << 8); rte[(size_t)e * NT + rk] = R; }
    __syncthreads();
}
constexpr int LDS_TOK = 131072;
__device__ __forceinline__ void moe_tok_table(ArgsRef a, const pg8::MoeOrder& S, LAS unsigned char* lds) {
    const MoeTab t = moe_tab(lds); LAS int* tokL = (LAS int*)(lds + LDS_TOK); const int* rte = (const int*)(a.ws + WS_RTE);
    const int tid = threadIdx.x;
    int val[14]; bool has[14];
#pragma unroll
    for (int q = 0; q < 14; ++q) { const int i = 2 * q + (tid >> 8); pg8::Unit u; has[q] = S.next(i, u); val[q] = 0;
        if (has[q]) { const int dest = u.pm * 256 + (tid & 255), e = t.blkE[u.pm], rk = dest - t.pstart[e];
            if (rk < t.cnt[e]) val[q] = rte[(size_t)e * NT + rk]; } }
#pragma unroll
    for (int q = 0; q < 14; ++q) { const int i = 2 * q + (tid >> 8); if (has[q]) tokL[i * 256 + (tid & 255)] = val[q]; }
    __syncthreads();
}

template <bool FINAL>
__device__ __forceinline__ void ph_combine(ArgsRef a, int layer, const bf16* Xin, const bf16* Ys, int R0, int R1, bf16* Xout, bf16* Hout, float* outF, LAS unsigned char* lds) {
    moe_tables(a, layer, lds); const MoeTab t = moe_tab(lds);
    const int tid = threadIdx.x, lane = tid & 63, wave = __builtin_amdgcn_readfirstlane(tid >> 6);
    const float* modl = (const float*)(a.ws + WS_SM + SM_MODL) + (size_t)layer * 16 * 6 * D; const float* modc = (const float*)(a.ws + WS_SM + SM_MODC) + (size_t)layer * 6 * D;
    const float* modl2 = (const float*)(a.ws + WS_SM + SM_MODL) + (size_t)1 * 16 * 6 * D; const float* modc2 = (const float*)(a.ws + WS_SM + SM_MODC) + (size_t)1 * 6 * D;
    const int* slot = (const int*)(a.ws + WS_SLOT); const float* gate = (const float*)(a.ws + WS_GATE);
    const int gw = blockIdx.x * NWAVES + wave, NGW = gridDim.x * NWAVES;
    for (int Rq = R0 + gw; Rq < R1; Rq += 2 * NGW) {
        unsigned yv[2][4][4]; v2u xv[2][4]; float gk[2][4];
#pragma unroll
        for (int u = 0; u < 2; ++u) { const int R = (Rq + u * NGW < R1) ? Rq + u * NGW : Rq;
#pragma unroll
            for (int k = 0; k < 4; ++k) { const int info = slot[(size_t)R * 4 + k]; gk[u][k] = gate[(size_t)R * 4 + k] * 0.0625f; const int dest = t.pstart[info & 255] + (info >> 8);
                const unsigned* yr = (const unsigned*)((const unsigned char*)Ys + (size_t)dest * D);
#pragma unroll
                for (int j = 0; j < 4; ++j) yv[u][k][j] = yr[64 * j + lane]; }
#pragma unroll
            for (int j = 0; j < 4; ++j) xv[u][j] = ((const v2u*)(Xin + (size_t)R * D))[64 * j + lane]; }
#pragma unroll
        for (int u = 0; u < 2; ++u) { const int R = Rq + u * NGW;
            const int Rc = (R < R1) ? R : Rq; const bool isctx = Rc < NTC; const int bidx = isctx ? 0 : (Rc - NTC) / SEQ;
            const float* mod = isctx ? modc : modl + (size_t)bidx * 6 * D;
            f32x4 v[4]; float ss = 0.f;
#pragma unroll
            for (int j = 0; j < 4; ++j) { f32x4 m = (f32x4){0.f, 0.f, 0.f, 0.f};
#pragma unroll
                for (int k = 0; k < 4; ++k) { const unsigned w = yv[u][k][j]; const float g = gk[u][k]; const auto lo = __builtin_amdgcn_cvt_pk_f32_fp8((int)w, false), hi = __builtin_amdgcn_cvt_pk_f32_fp8((int)w, true); m[0] += g * lo[0]; m[1] += g * lo[1]; m[2] += g * hi[0]; m[3] += g * hi[1]; }
                const v2u xw = xv[u][j]; const f32x4 xi = (f32x4){bf2f(xw.x & 0xffffu), bf2f(xw.x >> 16), bf2f(xw.y & 0xffffu), bf2f(xw.y >> 16)};
                v[j] = xi + ((const f32x4*)(mod + 5 * D))[64 * j + lane] * m; ss += (v[j][0] * v[j][0] + v[j][1] * v[j][1]) + (v[j][2] * v[j][2] + v[j][3] * v[j][3]); }
            const float rs = 1.0f / sqrtf(wave_sum(ss) * (1.0f / D) + EPS);
            if (R < R1) {
                if (FINAL) {
                    f32x4* o = (f32x4*)(outF + (size_t)(R - NTC) * D);
#pragma unroll
                    for (int j = 0; j < 4; ++j) o[64 * j + lane] = v[j] * rs * ((const f32x4*)a.in[I_FNG])[64 * j + lane];
                } else {
                    const float* mod2 = isctx ? modc2 : modl2 + (size_t)bidx * 6 * D;
                    v2u* xo = (v2u*)(Xout + (size_t)R * D); v2u* o8 = (v2u*)(Hout + (size_t)R * D);
#pragma unroll
                    for (int j = 0; j < 4; ++j) { { v2u xq; xq.x = pk2(v[j][0], v[j][1]); xq.y = pk2(v[j][2], v[j][3]); xo[64 * j + lane] = xq; }
                        const f32x4 sh = ((const f32x4*)(mod2))[64 * j + lane], sc = ((const f32x4*)(mod2 + D))[64 * j + lane];
                        const f32x4 y = v[j] * rs * sc + sh; v2u w; w.x = pk2(y[0], y[1]); w.y = pk2(y[2], y[3]); o8[64 * j + lane] = w; }
                }
            }
        }
    }
}

__device__ __forceinline__ void ph_conv(ArgsRef a, const bf16* QKR, bf16* QK) {
    const int tid = threadIdx.x;
    const float* cw = a.in[I_MLCW]; const float* cb = a.in[I_MLCB];
    const int c8 = (tid & 127) * 8;
    float w[9][8], bb[8];
#pragma unroll
    for (int t = 0; t < 9; ++t)
#pragma unroll
        for (int j = 0; j < 8; ++j) w[t][j] = cw[t * 1024 + c8 + j];
#pragma unroll
    for (int j = 0; j < 8; ++j) bb[j] = cb[c8 + j];
    const float osc = c8 < 512 ? 0.125f : 1.0f;
    constexpr int NLAT = 16 * 32 * 16, NITEM = NLAT + 16 * 64;
    for (int item = blockIdx.x * 4 + (tid >> 7); item < NITEM; item += gridDim.x * 4) {
        const bool isctx = item >= NLAT;
        int y, x0, rowbase, W;
        if (!isctx) { const int b = item >> 9; y = (item >> 4) & 31; x0 = (item & 15) * 4; rowbase = NTC + b * SEQ + y * 64; W = 64; }
        else { const int it2 = item - NLAT; y = 0; x0 = (it2 & 63) * 4; rowbase = (it2 >> 6) * CTX; W = CTX; }
        if (isctx && c8 < 512) {
#pragma unroll
            for (int pp = 0; pp < 4; ++pp) *(v4u*)(QK + (size_t)(rowbase + x0 + pp) * D + c8) = (v4u){0u, 0u, 0u, 0u};
            continue; }
        v4u win[3][6];
#pragma unroll
        for (int ky = 0; ky < 3; ++ky) { const int yy = y + ky - 1; const bool rv = isctx ? (ky == 1) : (yy >= 0 && yy < 32);
            const int yc = isctx ? 0 : (yy < 0 ? 0 : yy > 31 ? 31 : yy); const int rb = rowbase + (isctx ? 0 : (yc - y) * 64);
#pragma unroll
            for (int c = 0; c < 6; ++c) { const int xx = x0 - 1 + c; const int xc = xx < 0 ? 0 : xx >= W ? W - 1 : xx;
                const v4u x = *(const v4u*)(QKR + (size_t)(rb + xc) * D + c8);
                win[ky][c] = (rv && xx >= 0 && xx < W) ? x : (v4u){0u, 0u, 0u, 0u}; } }
#pragma unroll
        for (int pp = 0; pp < 4; ++pp) {
            float acc[8];
#pragma unroll
            for (int j = 0; j < 8; ++j) acc[j] = bb[j];
#pragma unroll
            for (int ky = 0; ky < 3; ++ky)
#pragma unroll
                for (int kx = 0; kx < 3; ++kx) { const v4u x = win[ky][pp + kx]; const unsigned xs[4] = {x.x, x.y, x.z, x.w};
#pragma unroll
                    for (int j = 0; j < 4; ++j) { acc[2 * j] += w[ky * 3 + kx][2 * j] * bf2f(xs[j] & 0xffffu); acc[2 * j + 1] += w[ky * 3 + kx][2 * j + 1] * bf2f(xs[j] >> 16); } }
            float yv[8];
#pragma unroll
            for (int j = 0; j < 8; ++j) yv[j] = siluf(acc[j]) * osc;
            v4u o; o.x = pk2(yv[0], yv[1]); o.y = pk2(yv[2], yv[3]); o.z = pk2(yv[4], yv[5]); o.w = pk2(yv[6], yv[7]);
            *(v4u*)(QK + (size_t)(rowbase + x0 + pp) * D + c8) = o; }
    }
}


constexpr int N_PHASES = 21;
__global__ void __launch_bounds__(NTHREADS, 2) fwd(Args a_unused) {
    ArgsRef a = *(const volatile __attribute__((address_space(4))) Args*)__builtin_amdgcn_kernarg_segment_ptr();
    extern __shared__ __attribute__((aligned(16))) unsigned char lds_raw[];
    LAS unsigned char* lds = (LAS unsigned char*)lds_raw;
    const int tid = threadIdx.x, G = gridDim.x;
    unsigned char* ws = a.ws;
    if (tid < 16) ((LAS unsigned*)(lds + LDS_MISC))[tid] = 0u;
    __syncthreads();
    XcdBarrier bar; bar.bar = (unsigned*)(ws + WS_CTL) + CW_BAR; bar.x = 0; bar.st = nullptr;
    const int lo = a.ph_lo, hi = a.ph_hi;
    if (hi - lo > 1) bar = xcd_barrier_post((unsigned*)(ws + WS_CTL) + CW_BAR, (volatile LAS unsigned*)(lds + LDS_MISC));
#ifndef PH_MASK
#define PH_MASK 0xFFFFFFFFu
#endif
#define IN(k) (((PH_MASK >> (k)) & 1u) && lo <= (k) && (k) < hi)
#define SEAM(k) do { if (IN(k) && IN((k) + 1)) xcd_barrier(bar); } while (0)

    bf16* ACT = (bf16*)(ws + WS_ACT);
    bf16* X1 = (bf16*)(ws + WS_X1); bf16* X2 = (bf16*)(ws + WS_X2);
    bf16* BIG = (bf16*)(ws + WS_BIG);
    const float* modl = (const float*)(ws + WS_SM + SM_MODL); const float* modc = (const float*)(ws + WS_SM + SM_MODC); const float* oml = (const float*)(ws + WS_SM + SM_OML);
    bf16* XS = BIG; bf16* HM = (bf16*)(ws + WS_BIG + 304 * MiB);

    if (IN(0)) { {  ph_prologue(a, lds);  } } SEAM(0);
    if (IN(1)) { {  ph_modulate(a, a.in[I_CTX], a.in[I_X], a.in[I_NMIXG], 0, 0, 0, NT, ACT);  } } SEAM(1);
    if (IN(2)) { {  pg8::Gemm g{ACT, (const bf16*)(ws + WS_WHGIN), D}; pg8::StaticOrder S; S.init(NT, HG_N, G, (int)blockIdx.x);
        pg8::EpiHgIn E{BIG, (size_t)NT * D, oml, oml + D}; pg8::gemm_phase<pg8::EpiHgIn, pg8::StaticOrder>(lds, g, S, E);
        if (idle_last_round(S)) expert_tiles<1>(a, lds, 2);  } } SEAM(2);
    if (IN(3)) { {  ph_hg_scan(a, lds);
          } } SEAM(3);
    if (IN(4)) { {  ph_readout(BIG + (size_t)5 * NT * D, BIG + (size_t)6 * NT * D, BIG + (size_t)4 * NT * D, a.in[I_HGNG], 0, NT, ACT);  } } SEAM(4);
    if (IN(5)) { {  pg8::Gemm g{ACT, (const bf16*)(ws + WS_WHGOUT), D}; pg8::StaticOrder S; S.init(NT, D, G, (int)blockIdx.x);
        pg8::EpiResid<false> E{a.in[I_CTX], a.in[I_X], X1, modc + 2 * D, modl + 2 * D, 0}; pg8::gemm_phase<pg8::EpiResid<false>, pg8::StaticOrder>(lds, g, S, E);
        if (idle_last_round(S)) expert_tiles<1>(a, lds, 2);  } } SEAM(5);
    if (IN(6)) { {  ph_router(a, X1, a.in[I_NFFNG], 0, 0, NT, ACT, lds);  } } SEAM(6);
    if (IN(8)) { {  moe_tables(a, 0, lds); const MoeTab t = moe_tab(lds);
        pg8::Gemm g{ACT, (const bf16*)(ws + WS_W1), D}; pg8::MoeOrder S{t.nblk[0], 8, G, (int)blockIdx.x, t.blkE}; moe_tok_table(a, S, lds);
        pg8::EpiSwiglu E{HM, a.in[I_B1]}; pg8::gemm_phase<pg8::EpiSwiglu, pg8::MoeOrder, true, true, true, true>(lds, g, S, E, (const LAS int*)(lds + LDS_TOK));
        if (idle_last_round(S)) expert_tiles<1>(a, lds, 1);  } } SEAM(8);
    if (IN(9)) { {  moe_tables(a, 0, lds); const MoeTab t = moe_tab(lds);
        pg8::Gemm g{HM, (const bf16*)(ws + WS_W2), D}; pg8::MoeOrder S{t.nblk[0], 4, G, (int)blockIdx.x, t.blkE};
        pg8::EpiW2 E{XS, a.in[I_B2]}; pg8::gemm_phase<pg8::EpiW2, pg8::MoeOrder, true, true, false, true>(lds, g, S, E);
        if (idle_last_round(S)) expert_tiles<1>(a, lds, 1);  } } SEAM(9);
    if (IN(10)) { {  ph_combine<false>(a, 0, X1, XS, 0, NT, X2, ACT, nullptr, lds);  } } SEAM(10);
    if (IN(11)) { {  pg8::Gemm g{ACT, (const bf16*)(ws + WS_WMLIN), D}; pg8::MlInOrder S; S.init(G, (int)blockIdx.x);
        pg8::EpiMlIn E{BIG, (size_t)NT * D, (float*)(ws + WS_GT), a.in[I_MLBG]}; pg8::gemm_phase<pg8::EpiMlIn, pg8::MlInOrder>(lds, g, S, E);
        expert_tiles<1>(a, lds, 1 << 30);  } } SEAM(11);
    if (IN(12)) { {  ph_conv(a, BIG, BIG + (size_t)3 * NT * D);  } } SEAM(12);
    if (IN(13)) { {  ph_ml_scan(a, lds);  } } SEAM(13);
    if (IN(14)) { {  ph_readout(BIG + (size_t)4 * NT * D, BIG + (size_t)5 * NT * D, BIG + (size_t)2 * NT * D, a.in[I_MLNG], NTC, NT, ACT);  } } SEAM(14);
    if (IN(15)) { {  pg8::Gemm g{ACT + (size_t)NTC * D, (const bf16*)(ws + WS_WMLOUT), D}; pg8::StaticOrder S; S.init(NTL, D, G, (int)blockIdx.x);
        pg8::EpiResid<true> E{X2, X2 + (size_t)NTC * D, X1, modc + 6 * D + 2 * D, modl + (size_t)16 * 6 * D + 2 * D, NTC}; pg8::gemm_phase<pg8::EpiResid<true>, pg8::StaticOrder>(lds, g, S, E);  } } SEAM(15);
    if (IN(16)) { {  ph_router(a, X1, a.in[I_NFFNG] + D, 1, NTC, NT, ACT, lds);  } } SEAM(16);
    if (IN(18)) { {  moe_tables(a, 1, lds); const MoeTab t = moe_tab(lds);
        pg8::Gemm g{ACT, (const bf16*)(ws + WS_W1 + (size_t)32 * 2048 * D), D}; pg8::MoeOrder S{t.nblk[0], 8, G, (int)blockIdx.x, t.blkE}; moe_tok_table(a, S, lds);
        pg8::EpiSwiglu E{HM, a.in[I_B1] + 32 * 2048}; pg8::gemm_phase<pg8::EpiSwiglu, pg8::MoeOrder, true, true, true, true>(lds, g, S, E, (const LAS int*)(lds + LDS_TOK));  } } SEAM(18);
    if (IN(19)) { {  moe_tables(a, 1, lds); const MoeTab t = moe_tab(lds);
        pg8::Gemm g{HM, (const bf16*)(ws + WS_W2 + (size_t)32 * D * D), D}; pg8::MoeOrder S{t.nblk[0], 4, G, (int)blockIdx.x, t.blkE};
        pg8::EpiW2 E{XS, a.in[I_B2] + 32 * D}; pg8::gemm_phase<pg8::EpiW2, pg8::MoeOrder, true, true, false, true>(lds, g, S, E);  } } SEAM(19);
    if (IN(20)) { {  ph_combine<true>(a, 1, X1, XS, NTC, NT, nullptr, nullptr, a.out, lds);  } }
#undef IN
#undef SEAM
}

extern "C" void kernel_launch(void* const* d_in, const int* in_sizes, int n_in, void* d_out, int out_size, void* d_ws, size_t ws_size, hipStream_t stream) {
    static int grid = 0;
    if (grid == 0) {
        if (n_in != 25 || out_size != NTL * D || ws_size < WS_END) { fprintf(stderr, "kernel_launch: unexpected problem (n_in %d, out %d, ws %zu < %zu)\n", n_in, out_size, ws_size, (size_t)WS_END); grid = -1; return; }
        int dev = 0, cus = 0, per_cu = 0;
        if (hipGetDevice(&dev) != hipSuccess || hipDeviceGetAttribute(&cus, hipDeviceAttributeMultiprocessorCount, dev) != hipSuccess) { grid = -1; return; }
        if (hipFuncSetAttribute((const void*)fwd, hipFuncAttributeMaxDynamicSharedMemorySize, LDS_BYTES) != hipSuccess) { fprintf(stderr, "kernel_launch: hipFuncSetAttribute failed\n"); grid = -1; return; }
        if (hipOccupancyMaxActiveBlocksPerMultiprocessor(&per_cu, (const void*)fwd, NTHREADS, LDS_BYTES) != hipSuccess || per_cu < 1) { fprintf(stderr, "kernel_launch: occupancy query says %d blocks per CU\n", per_cu); }
        (void)hipGetLastError();
        grid = cus < 256 ? cus : 256;
    }
    if (grid < 0) return;
    if (hipMemsetAsync((char*)d_ws + WS_CTL, 0, CTL_ZERO_BYTES, stream) != hipSuccess) return;
    Args a{};
    for (int i = 0; i < 25; ++i) a.in[i] = (const float*)d_in[i];
    a.out = (float*)d_out; a.ws = (unsigned char*)d_ws;
#if MK_ONE_LAUNCH
    a.ph_lo = 0; a.ph_hi = N_PHASES;
    hipLaunchKernelGGL(fwd, dim3(grid), dim3(NTHREADS), LDS_BYTES, stream, a);
#else
    for (int p = 0; p < N_PHASES; ++p) { a.ph_lo = p; a.ph_hi = p + 1; hipLaunchKernelGGL(fwd, dim3(grid), dim3(NTHREADS), LDS_BYTES, stream, a); }
#endif
}
```

```cpp
#include <hip/hip_runtime.h>
#include <cstdio>
#include <cstdint>

#ifndef MK_ONE_LAUNCH
#define MK_ONE_LAUNCH 1
#endif

#define LAS __attribute__((address_space(3)))
#define GAS __attribute__((address_space(1)))
typedef unsigned short bf16;
typedef unsigned v4u __attribute__((ext_vector_type(4)));
typedef unsigned v2u __attribute__((ext_vector_type(2)));
typedef float f32x4 __attribute__((ext_vector_type(4)));
typedef float f32x2 __attribute__((ext_vector_type(2)));
typedef short bf16x8 __attribute__((ext_vector_type(8)));

constexpr int NB = 16, SEQ = 2048, D = 1024, CTX = 256;
constexpr int NTC = NB * CTX, NTL = NB * SEQ, NT = NTC + NTL;
constexpr int NE = 32, TOPK = 4;
constexpr int HG_N = 5 * D;
constexpr int ML_N = 3104, ML_NP = 3328;
constexpr int NPADMAX = 155648;
constexpr float EPS = 1e-6f;
constexpr int NWAVES = 8, NTHREADS = 512;

constexpr size_t MiB = 1u << 20;
constexpr size_t WS_CTL = 0, CTL_ZERO_BYTES = 1 * MiB;
constexpr size_t WS_SM = 1 * MiB;
constexpr size_t SM_MODL = 0, SM_MODC = 786432, SM_OML = 835584;
constexpr size_t WS_SLOT = 2 * MiB;
constexpr size_t WS_GATE = 3 * MiB;
constexpr size_t WS_RTE = 4 * MiB;
constexpr size_t WS_GT = 10 * MiB;
constexpr size_t WS_WHGIN = 16 * MiB, WS_WHGOUT = 26 * MiB, WS_WMLIN = 28 * MiB, WS_WMLOUT = 35 * MiB;
constexpr size_t WS_W1 = 40 * MiB, WS_W2 = 296 * MiB;
constexpr size_t WS_X1 = 424 * MiB, WS_X2 = 568 * MiB, WS_ACT = 712 * MiB, WS_BIG = 784 * MiB;
constexpr size_t T72 = 72 * MiB;
constexpr size_t WS_END = WS_BIG + 608 * MiB;
constexpr int CW_CNT = 1024;
constexpr int CW_TILE = 2048, CW_BAR = 4096;

constexpr int LDS_BYTES = 160 * 1024;
constexpr int LDS_MISC = LDS_BYTES - 4096;
constexpr int LDS_TAB = LDS_MISC + 64;

__device__ __forceinline__ float bf2f(unsigned v) { return __uint_as_float(v << 16); }
typedef __bf16 bf2_t __attribute__((ext_vector_type(2)));
__device__ __forceinline__ unsigned pk2(float lo, float hi) { bf2_t v; v[0] = (__bf16)lo; v[1] = (__bf16)hi; return __builtin_bit_cast(unsigned, v); }
__device__ __forceinline__ unsigned f2bf(float f) { return pk2(f, f) & 0xffffu; }
__device__ __forceinline__ float fexp(float x) { return __builtin_amdgcn_exp2f(x * 1.44269504089f); }
__device__ __forceinline__ float frcp(float x) { return __builtin_amdgcn_rcpf(x); }
__device__ __forceinline__ float siluf(float v) { return v * frcp(1.0f + fexp(-v)); }
#define LDS_WAIT() asm volatile("s_waitcnt lgkmcnt(0)" ::: "memory")
__device__ __forceinline__ unsigned pk4_fp8(float a, float b, float c, float d) { int w = 0; w = __builtin_amdgcn_cvt_pk_fp8_f32(a, b, w, false); w = __builtin_amdgcn_cvt_pk_fp8_f32(c, d, w, true); return (unsigned)w; }
template <int CTRL, int RMASK> __device__ __forceinline__ float dppf(float old, float src) { return __int_as_float(__builtin_amdgcn_update_dpp(__float_as_int(old), __float_as_int(src), CTRL, RMASK, 0xf, false)); }

namespace pg8 {
#define PG8_LAS __attribute__((address_space(3)))
typedef unsigned short bf16_t;
typedef unsigned u32x4 __attribute__((ext_vector_type(4)));
constexpr int BM = 256, BK = 64, HALF = 128, HTB = HALF * BK * 2, STAGE_BYTES = 8 * HTB, NXCD = 8, WGM = 8;
__host__ __device__ __forceinline__ int lds_byte(int r, int c) { const int st = (r >> 4) * 2 + (c >> 5), rr = r & 15, cc = c & 31, ob = rr * 64 + cc * 2; return st * 1024 + (ob ^ (((ob >> 9) & 1) << 5)); }
__host__ __device__ __forceinline__ void stage_rc(int b, int& R, int& C) { const int st = b / 1024, sb = b % 1024, swz = sb ^ (((sb >> 9) & 1) << 5); R = (st >> 1) * 16 + swz / 64; C = (st & 1) * 32 + (swz % 64) / 2; }
__host__ __device__ __forceinline__ int perm32(int rho) { const int n = rho >> 4, i = rho & 15; return 8 * (i >> 2) + 4 * n + (i & 3); }

__device__ __forceinline__ int lane_now() { int l; asm volatile("v_mbcnt_lo_u32_b32 %0, -1, 0\n\tv_mbcnt_hi_u32_b32 %0, -1, %0" : "=v"(l)); return l; }
struct Unit { int pm, pn, bt; };
struct Gemm { const bf16_t* A; const bf16_t* Bt; int K; };

struct StaticOrder {
    int nM, nN, nwg, G, c;
    __device__ void init(int M, int N, int G_, int c_) { nM = M / BM; nN = N / BM; nwg = nM * nN; G = G_; c = c_; }
    __device__ bool next(int i, Unit& u) const {
        const long L = (long)i * G + c; if (L >= nwg) return false;
        int wgid = (int)L; { const int q = nwg / NXCD, r = nwg % NXCD, xcd = wgid % NXCD, off = wgid / NXCD; wgid = (xcd < r ? xcd * (q + 1) : r * (q + 1) + (xcd - r) * q) + off; }
        const int nig = WGM * nN, gid = wgid / nig, fm = gid * WGM, gsz = (nM - fm) < WGM ? (nM - fm) : WGM;
        u.pm = fm + ((wgid % nig) % gsz); u.pn = (wgid % nig) / gsz; u.bt = u.pn; return true;
    }
};
struct MlInOrder {
    StaticOrder lat; int G, c;
    __device__ void init(int G_, int c_) { lat.init(NTL, ML_NP, G_, 0); G = G_; c = c_; }
    __device__ bool next(int i, Unit& u) const {
        const long L = (long)i * G + c;
        if (L < lat.nwg) { StaticOrder t = lat; t.G = 1; t.c = 0; t.next((int)L, u); u.pm += NTC / BM; return true; }
        const int r = (int)(L - lat.nwg); if (r >= 16 * 7) return false;
        const int j = r % 7; u.pm = r / 7; u.pn = j < 2 ? 2 + j : j < 6 ? 2 + j : 12; u.bt = u.pn; return true;
    }
};
struct MoeOrder {
    int nblk, tilesN, G, c; const LAS int* blkE;
    __device__ bool next(int i, Unit& u) const {
        int pm, pn;
        const int J = G / 8;
        if ((G % 8) == 0 && (J % tilesN) == 0) { const int x = c % 8, j = c / 8, RB = J / tilesN; pm = (i * 8 + x) * RB + j / tilesN; pn = j % tilesN; }
        else { const long L = (long)i * G + c; pm = (int)(L / tilesN); pn = (int)(L % tilesN); }
        if (pm >= nblk) return false;
        u.pm = pm; u.pn = pn; u.bt = blkE[pm] * tilesN + pn; return true;
    }
};

__device__ __forceinline__ unsigned cvt_pk_bf16(float lo, float hi) { return pk2(lo, hi); }

__device__ __forceinline__ __attribute__((ext_vector_type(8))) int pk8(bf16x8 lo, bf16x8 hi) { typedef int v4i __attribute__((ext_vector_type(4))); const v4i a = __builtin_bit_cast(v4i, lo), b = __builtin_bit_cast(v4i, hi);
    return (__attribute__((ext_vector_type(8))) int){a[0], a[1], a[2], a[3], b[0], b[1], b[2], b[3]}; }
typedef int v8i_t __attribute__((ext_vector_type(8)));
typedef int v4i_q __attribute__((ext_vector_type(4)));
__device__ __forceinline__ int pg8_x16(int v) { int r; asm volatile("v_xor_b32 %0, 16, %1" : "=v"(r) : "v"(v)); return r; }
__device__ __forceinline__ v8i_t pk8q(v4i_q a, v4i_q b) { return __builtin_shufflevector(a, b, 0, 1, 2, 3, 4, 5, 6, 7); }
template <class Epi, class Sched, bool ALIGN_EPI = true, bool SP2 = true, bool GATHER = false, bool FP8 = false>
__device__ __forceinline__ void gemm_phase(PG8_LAS unsigned char* lds, const Gemm g, const Sched& S, const Epi& E, const PG8_LAS int* tokL = nullptr) {
    const int tid = threadIdx.x, wid = __builtin_amdgcn_readfirstlane(tid >> 6), lane = tid & 63, wr = wid >> 2, wc = wid & 3, fr = lane & 15, fq = lane >> 4;
    const int K = FP8 ? g.K / 2 : g.K, nt = K / BK;
    unsigned voffA[2], voffB[2];
#pragma unroll
    for (int i = 0; i < 2; ++i) { int R, C; stage_rc(tid * 16 + i * 8192, R, C); const int Rb = Epi::PERM ? ((R & ~31) + perm32(R & 31)) : R;
        voffA[i] = (unsigned)(R * K + C) * 2u; voffB[i] = (unsigned)(Rb * K + C) * 2u; }
    unsigned gA[2][2], gU[2][2];
#define PG8_GTOK(dst, uidx) do { const int _t = wid * 64 + lane_now(); _Pragma("unroll") for (int _i = 0; _i < 2; ++_i) { int _R, _C; stage_rc(_t * 16 + _i * 8192, _R, _C); _Pragma("unroll") for (int _h = 0; _h < 2; ++_h) dst[_h][_i] = (unsigned)tokL[(uidx) * 256 + _h * HALF + _R] * (unsigned)(K * 2) + (unsigned)(_C * 2); } } while (0)
    const unsigned kstep = (unsigned)(BK * 2);
    const unsigned hstep = (unsigned)HALF * K * 2;
    const unsigned tstep = 2 * hstep;
    const __amdgpu_buffer_rsrc_t rsA = __builtin_amdgcn_make_buffer_rsrc((void*)g.A, 0, -1, 0x00020000), rsB = __builtin_amdgcn_make_buffer_rsrc((void*)g.Bt, 0, -1, 0x00020000);
    const unsigned ldsw = (unsigned)wid * 1024u;
    const int aoff = FP8 ? (lds_byte(wr * 64 + fr, fq * 16) | ((fq & 1) << 4)) : lds_byte(wr * 64 + fr, fq * 8), boff = FP8 ? (lds_byte(wc * 32 + fr, fq * 16) | ((fq & 1) << 4)) : lds_byte(wc * 32 + fr, fq * 8);
#define aoffH pg8_x16(aoff)
#define boffH pg8_x16(boff)
    constexpr int aoff1 = FP8 ? 16 : 1024, boff1 = FP8 ? 16 : 1024;
#define PG8_SA(b, h) (((b) * 2 + (h)) * HTB)
#define PG8_SB(b, h) ((4 + (b) * 2 + (h)) * HTB)
#define PG8_STAGE_R(bufoff, rs, soff, voff) do { _Pragma("unroll") for (int _i = 0; _i < 2; ++_i) \
        __builtin_amdgcn_raw_ptr_buffer_load_lds(rs, (PG8_LAS void*)(lds + (bufoff) + ldsw + _i * 8192), 16, (int)(voff)[_i], (int)(soff), 0, 0); } while (0)
#define PG8_STAGE_B(bufoff, soff) PG8_STAGE_R(bufoff, rsB, soff, voffB)
#define PG8_STAGE_A1(b, h, ptr) do { if constexpr (GATHER) { PG8_STAGE_R(PG8_SA(b, h), rsA, ptr, gA[h]); } else { PG8_STAGE_R(PG8_SA(b, h), rsA, (ptr) + (h) * hstep, voffA); } } while (0)
#define PG8_STAGE_A2(b, h, ptr) do { if constexpr (GATHER) { PG8_STAGE_R(PG8_SA(b, h), rsA, ptr, gU[h]); } else { PG8_STAGE_R(PG8_SA(b, h), rsA, (ptr) + (h) * hstep, voffA); } } while (0)
#define PG8_LDA(dst, b, h) do { if constexpr (FP8) { _Pragma("unroll") for (int m = 0; m < 4; ++m) dst##8[m] = pk8q(*(const PG8_LAS v4i_q*)(lds + PG8_SA(b, h) + aoff + m * 2048), *(const PG8_LAS v4i_q*)(lds + PG8_SA(b, h) + aoffH + m * 2048)); } else { _Pragma("unroll") for (int m = 0; m < 4; ++m) _Pragma("unroll") for (int k = 0; k < 2; ++k) dst[m][k] = *(const PG8_LAS bf16x8*)(lds + PG8_SA(b, h) + aoff + m * 2048 + k * aoff1); } } while (0)
#define PG8_LDB(dst, b, h) do { if constexpr (FP8) { _Pragma("unroll") for (int n = 0; n < 2; ++n) dst##8[n] = pk8q(*(const PG8_LAS v4i_q*)(lds + PG8_SB(b, h) + boff + n * 2048), *(const PG8_LAS v4i_q*)(lds + PG8_SB(b, h) + boffH + n * 2048)); } else { _Pragma("unroll") for (int n = 0; n < 2; ++n) _Pragma("unroll") for (int k = 0; k < 2; ++k) dst[n][k] = *(const PG8_LAS bf16x8*)(lds + PG8_SB(b, h) + boff + n * 2048 + k * boff1); } } while (0)
#define PG8_MMA(ai, bj, At, Bt) do { __builtin_amdgcn_s_setprio(1); if constexpr (FP8) { _Pragma("unroll") for (int m = 0; m < 4; ++m) _Pragma("unroll") for (int n = 0; n < 2; ++n) \
        acc[ai][bj][m][n] = __builtin_amdgcn_mfma_scale_f32_16x16x128_f8f6f4(Bt##8[n], At##8[m], acc[ai][bj][m][n], 0, 0, 0, 0, 0, 0); } \
        else { _Pragma("unroll") for (int m = 0; m < 4; ++m) _Pragma("unroll") for (int n = 0; n < 2; ++n) _Pragma("unroll") for (int k = 0; k < 2; ++k) \
        acc[ai][bj][m][n] = __builtin_amdgcn_mfma_f32_16x16x32_bf16(Bt[n][k], At[m][k], acc[ai][bj][m][n], 0, 0, 0); } __builtin_amdgcn_s_setprio(0); } while (0)
#define PG8_WAIT_V(n) asm volatile("s_waitcnt vmcnt(" #n ")" ::: "memory")
#define PG8_WAIT_L(n) asm volatile("s_waitcnt lgkmcnt(" #n ")" ::: "memory")
#define PG8_BAR __builtin_amdgcn_s_barrier()
#define PG8_SCHED __builtin_amdgcn_sched_barrier(0)
    Unit cur, nxt; int ui = 0;
    if (!S.next(0, cur)) return;
    f32x4 acc[2][2][4][2];
#pragma unroll
    for (int a = 0; a < 2; ++a)
#pragma unroll
        for (int b = 0; b < 2; ++b)
#pragma unroll
            for (int m = 0; m < 4; ++m)
#pragma unroll
                for (int n = 0; n < 2; ++n) acc[a][b][m][n] = (f32x4){0.f, 0.f, 0.f, 0.f};
    bf16x8 At[4][2], B0[2][2], B1[2][2]; v8i_t At8[4], B08[2], B18[2];
    unsigned cA = GATHER ? 0u : (unsigned)cur.pm * tstep, cB = (unsigned)cur.bt * tstep;
    if constexpr (GATHER) { PG8_GTOK(gA, 0); }
    if constexpr (SP2) {
        PG8_STAGE_B(PG8_SB(0, 0), cB); PG8_STAGE_B(PG8_SB(0, 1), cB + hstep); PG8_STAGE_A1(0, 0, cA); PG8_STAGE_A1(0, 1, cA);
        if (wr == 1) PG8_BAR;
        PG8_WAIT_V(2); PG8_BAR;
        PG8_STAGE_B(PG8_SB(1, 0), cB + kstep); PG8_STAGE_A1(1, 0, cA + kstep); PG8_STAGE_B(PG8_SB(1, 1), cB + hstep + kstep);
        PG8_WAIT_V(6); PG8_BAR;
    } else {
        static_assert(SP2 || !GATHER, "gathered A rows: SP2 loop only");
        PG8_STAGE_B(PG8_SB(0, 0), cB); PG8_STAGE_R(PG8_SA(0, 0), rsA, cA, voffA); PG8_STAGE_B(PG8_SB(0, 1), cB + hstep); PG8_STAGE_R(PG8_SA(0, 1), rsA, cA + hstep, voffA);
        if (wr == 1) PG8_BAR;
        PG8_WAIT_V(4); PG8_BAR;
        PG8_STAGE_B(PG8_SB(1, 0), cB + kstep); PG8_STAGE_R(PG8_SA(1, 0), rsA, cA + kstep, voffA); PG8_STAGE_B(PG8_SB(1, 1), cB + hstep + kstep);
        PG8_WAIT_V(6); PG8_BAR;
    }
    for (;;) {
        const bool has_next = S.next(ui + 1, nxt);
        const unsigned nA = GATHER ? cA : (has_next ? (unsigned)nxt.pm * tstep : cA), nB = has_next ? (unsigned)nxt.bt * tstep : cB;
#pragma unroll 1
        for (int t = 0; t < nt; t += 2) {
            const bool last = (t == nt - 2);
            if constexpr (GATHER) {
#pragma unroll
                for (int _h = 0; _h < 2; ++_h)
#pragma unroll
                    for (int _i = 0; _i < 2; ++_i) gU[_h][_i] = gA[_h][_i];
                if (last && has_next) { PG8_GTOK(gU, ui + 1); } }

            const unsigned a1 = cA + (unsigned)(t + 1) * kstep;
            const unsigned a2 = last ? nA : cA + (unsigned)(t + 2) * kstep, b2 = last ? nB : cB + (unsigned)(t + 2) * kstep;
            const unsigned a3 = a2 + kstep, b3 = b2 + kstep;
            if constexpr (SP2) {
            PG8_LDB(B0, 0, 0); PG8_LDB(B1, 0, 1); PG8_SCHED; PG8_LDA(At, 0, 0); PG8_STAGE_A1(1, 1, a1);
            PG8_WAIT_V(8); PG8_WAIT_L(0); PG8_BAR; PG8_MMA(0, 0, At, B0); PG8_MMA(0, 1, At, B1); PG8_BAR; PG8_SCHED;
            PG8_LDA(At, 0, 1); PG8_STAGE_B(PG8_SB(0, 0), b2); PG8_STAGE_B(PG8_SB(0, 1), b2 + hstep); PG8_STAGE_A2(0, 0, a2);
            PG8_WAIT_V(8); PG8_WAIT_L(0); PG8_BAR; PG8_MMA(1, 0, At, B0); PG8_MMA(1, 1, At, B1); PG8_BAR; PG8_SCHED;
            PG8_LDB(B0, 1, 0); PG8_LDB(B1, 1, 1); PG8_SCHED; PG8_LDA(At, 1, 0); PG8_STAGE_A2(0, 1, a2);
            PG8_WAIT_V(8); PG8_WAIT_L(0); PG8_BAR; PG8_MMA(0, 0, At, B0); PG8_MMA(0, 1, At, B1); PG8_BAR; PG8_SCHED;
            PG8_LDA(At, 1, 1); PG8_STAGE_B(PG8_SB(1, 0), b3); PG8_STAGE_B(PG8_SB(1, 1), b3 + hstep); PG8_STAGE_A2(1, 0, a3);
            PG8_WAIT_V(8); PG8_WAIT_L(0); PG8_BAR; PG8_MMA(1, 0, At, B0); PG8_MMA(1, 1, At, B1); PG8_BAR; PG8_SCHED;
            } else {
            PG8_LDB(B0, 0, 0); PG8_SCHED; PG8_LDA(At, 0, 0); PG8_STAGE_R(PG8_SA(1, 1), rsA, a1 + hstep, voffA);
            PG8_WAIT_L(8); PG8_BAR; PG8_WAIT_L(0); PG8_MMA(0, 0, At, B0); PG8_BAR; PG8_SCHED;
            PG8_LDB(B1, 0, 1); PG8_STAGE_B(PG8_SB(0, 0), b2);
            PG8_BAR; PG8_WAIT_L(0); PG8_MMA(0, 1, At, B1); PG8_BAR;
            PG8_LDA(At, 0, 1); PG8_STAGE_R(PG8_SA(0, 0), rsA, a2, voffA);
            PG8_BAR; PG8_WAIT_L(0); PG8_MMA(1, 0, At, B0); PG8_BAR; PG8_SCHED;
            PG8_STAGE_B(PG8_SB(0, 1), b2 + hstep);
            PG8_WAIT_V(6); PG8_BAR; PG8_MMA(1, 1, At, B1); PG8_BAR;
            PG8_LDB(B0, 1, 0); PG8_SCHED; PG8_LDA(At, 1, 0); PG8_STAGE_R(PG8_SA(0, 1), rsA, a2 + hstep, voffA);
            PG8_WAIT_L(8); PG8_BAR; PG8_WAIT_L(0); PG8_MMA(0, 0, At, B0); PG8_BAR; PG8_SCHED;
            PG8_LDB(B1, 1, 1); PG8_STAGE_B(PG8_SB(1, 0), b3);
            PG8_BAR; PG8_WAIT_L(0); PG8_MMA(0, 1, At, B1); PG8_BAR;
            PG8_LDA(At, 1, 1); PG8_STAGE_R(PG8_SA(1, 0), rsA, a3, voffA);
            PG8_BAR; PG8_WAIT_L(0); PG8_MMA(1, 0, At, B0); PG8_BAR; PG8_SCHED;
            PG8_STAGE_B(PG8_SB(1, 1), b3 + hstep);
            PG8_WAIT_V(6); PG8_BAR; PG8_MMA(1, 1, At, B1); PG8_BAR;
            }
        }
        if constexpr (ALIGN_EPI) { if (wr == 0) PG8_BAR; }
        E(acc, cur, wr, wc, fr, fq);
        if (!has_next) break;
#pragma unroll
        for (int a = 0; a < 2; ++a)
#pragma unroll
            for (int b = 0; b < 2; ++b)
#pragma unroll
                for (int m = 0; m < 4; ++m)
#pragma unroll
                    for (int n = 0; n < 2; ++n) { f32x2 z0, z1; asm volatile("v_mov_b64 %0, 0\n\tv_mov_b64 %1, 0" : "=v"(z0), "=v"(z1)); acc[a][b][m][n] = (f32x4){z0[0], z0[1], z1[0], z1[1]}; }
        cur = nxt; cA = nA; cB = nB; ++ui;
        if constexpr (GATHER) { PG8_GTOK(gA, ui); }
        if constexpr (ALIGN_EPI) { if (wr == 1) PG8_BAR; }
    }
    PG8_WAIT_V(0);
    if constexpr (!ALIGN_EPI) { if (wr == 0) PG8_BAR; }
    PG8_BAR;
#undef PG8_SA
#undef PG8_SB
#undef PG8_STAGE_R
#undef PG8_STAGE_B
#undef PG8_LDA
#undef PG8_STAGE_A1
#undef PG8_STAGE_A2
#undef PG8_GTOK
#undef PG8_LDB
#undef PG8_MMA
#undef PG8_WAIT_V
#undef PG8_WAIT_L
#undef PG8_BAR
#undef PG8_SCHED
}

struct EpiHgIn {
    static constexpr bool PERM = true;
    bf16_t* out0; size_t seg_stride; const float* omlF; const float* omlB;
    __device__ __forceinline__ void operator()(const f32x4 (&acc)[2][2][4][2], const Unit& u, int wr, int wc, int fr, int fq) const {
        const int seg = u.pn >> 2, colt = (u.pn & 3) * BM;
        bf16_t* base = out0 + (size_t)seg * seg_stride;
        const int row0 = u.pm * BM + wr * 64 + fr, col0 = colt + wc * 32 + 8 * fq;
        f32x4 ov[2][2];
        const float* oml = (seg == 2) ? omlF : omlB;
#pragma unroll
        for (int bj = 0; bj < 2; ++bj)
#pragma unroll
            for (int n = 0; n < 2; ++n) ov[bj][n] = (seg == 2 || seg == 3) ? *(const f32x4*)(oml + col0 + bj * HALF + 4 * n) : (f32x4){1.f, 1.f, 1.f, 1.f};
        auto body = [&](auto act) {
#pragma unroll
            for (int ai = 0; ai < 2; ++ai)
#pragma unroll
                for (int m = 0; m < 4; ++m) { bf16_t* rowp = base + (size_t)(row0 + ai * HALF + m * 16) * D + col0;
#pragma unroll
                    for (int bj = 0; bj < 2; ++bj) { f32x4 v[2] = {acc[ai][bj][m][0], acc[ai][bj][m][1]};
#pragma unroll
                        for (int n = 0; n < 2; ++n)
#pragma unroll
                            for (int j = 0; j < 4; ++j) v[n][j] = act(v[n][j], ov[bj][n][j]);
                        u32x4 w; w.x = cvt_pk_bf16(v[0][0], v[0][1]); w.y = cvt_pk_bf16(v[0][2], v[0][3]); w.z = cvt_pk_bf16(v[1][0], v[1][1]); w.w = cvt_pk_bf16(v[1][2], v[1][3]);
                        *(u32x4*)(rowp + bj * HALF) = w; } } };
        if (seg == 0 || seg == 4) body([](float x, float) { return siluf(x); });
        else if (seg == 1) body([](float x, float) { return x; });
        else body([](float x, float o) { return o * frcp(1.0f + fexp(x)); });
    }
};
struct EpiMlIn {
    static constexpr bool PERM = true;
    bf16_t* out0; size_t seg_stride; float* gt; const float* bgate;
    __device__ __forceinline__ void operator()(const f32x4 (&acc)[2][2][4][2], const Unit& u, int wr, int wc, int fr, int fq) const {
        const int seg = u.pn >> 2, colt = (u.pn & 3) * BM;
        const int row0 = u.pm * BM + wr * 64 + fr, col0 = colt + wc * 32 + 8 * fq;
        if (seg == 3) {
            if (wc == 0) {
                const f32x4 b0 = *(const f32x4*)(bgate + 8 * fq), b1 = *(const f32x4*)(bgate + 8 * fq + 4);
#pragma unroll
                for (int ai = 0; ai < 2; ++ai)
#pragma unroll
                    for (int m = 0; m < 4; ++m) { float* rowp = gt + (size_t)(row0 + ai * HALF + m * 16) * 32 + 8 * fq; f32x4 v[2] = {acc[ai][0][m][0] + b0, acc[ai][0][m][1] + b1};
#pragma unroll
                        for (int n = 0; n < 2; ++n)
#pragma unroll
                            for (int j = 0; j < 4; ++j) { const float y = v[n][j] * (1.0f / 15.0f); float t = 15.0f * (1.0f - 2.0f * frcp(1.0f + fexp(2.0f * y)));
                                if (fq >= 2) t = fminf(t, 0.f) - __logf(1.0f + fexp(-fabsf(t)));
                                v[n][j] = t; }
                        *(f32x4*)(rowp) = v[0]; *(f32x4*)(rowp + 4) = v[1]; }
            }
            return;
        }
        bf16_t* base = out0 + (size_t)seg * seg_stride;
#pragma unroll
        for (int ai = 0; ai < 2; ++ai)
#pragma unroll
            for (int m = 0; m < 4; ++m) { bf16_t* rowp = base + (size_t)(row0 + ai * HALF + m * 16) * D + col0;
#pragma unroll
                for (int bj = 0; bj < 2; ++bj) { f32x4 v[2] = {acc[ai][bj][m][0], acc[ai][bj][m][1]};
                    if (seg == 2) {
#pragma unroll
                        for (int n = 0; n < 2; ++n)
#pragma unroll
                            for (int j = 0; j < 4; ++j) v[n][j] = frcp(1.0f + fexp(-v[n][j])); }
                    u32x4 w; w.x = cvt_pk_bf16(v[0][0], v[0][1]); w.y = cvt_pk_bf16(v[0][2], v[0][3]); w.z = cvt_pk_bf16(v[1][0], v[1][1]); w.w = cvt_pk_bf16(v[1][2], v[1][3]);
                    *(u32x4*)(rowp + bj * HALF) = w; } }
    }
};
template <bool IN_BF16> struct EpiResid {
    static constexpr bool PERM = true;
    const void* in_ctx; const void* in_lat; bf16_t* out; const float* mod_ctx; const float* mod_lat; int row_off;
    __device__ __forceinline__ void operator()(const f32x4 (&acc)[2][2][4][2], const Unit& u, int wr, int wc, int fr, int fq) const {
        const int R0 = u.pm * BM + row_off;
        const bool isctx = R0 < NTC;
        const float* mod = isctx ? mod_ctx : mod_lat + (size_t)((R0 - NTC) / SEQ) * (6 * D);
        const size_t inrow0 = isctx ? (size_t)R0 : (size_t)(R0 - NTC);
        const int rl0 = wr * 64 + fr, col0 = u.pn * BM + wc * 32 + 8 * fq;
        const unsigned long long inb = (isctx ? (unsigned long long)in_ctx : (unsigned long long)in_lat) + (unsigned long long)(inrow0 * D) * (IN_BF16 ? 2u : 4u);
        f32x4 mv[2][2];
#pragma unroll
        for (int bj = 0; bj < 2; ++bj)
#pragma unroll
            for (int n = 0; n < 2; ++n) mv[bj][n] = *(const f32x4*)(mod + col0 + bj * HALF + 4 * n);
#pragma unroll
        for (int ai = 0; ai < 2; ++ai) {
            if constexpr (IN_BF16) {
                u32x4 rb[4][2];
#pragma unroll
                for (int m = 0; m < 4; ++m)
#pragma unroll
                    for (int bj = 0; bj < 2; ++bj) rb[m][bj] = *(const __attribute__((address_space(1))) u32x4*)(inb + ((unsigned long long)(rl0 + ai * HALF + m * 16) * D + col0 + bj * HALF) * 2u);
                __builtin_amdgcn_sched_barrier(0);
#pragma unroll
                for (int m = 0; m < 4; ++m)
#pragma unroll
                    for (int bj = 0; bj < 2; ++bj) { const u32x4 w = rb[m][bj];
                        const f32x4 x0 = (f32x4){__uint_as_float(w.x << 16), __uint_as_float(w.x & 0xffff0000u), __uint_as_float(w.y << 16), __uint_as_float(w.y & 0xffff0000u)};
                        const f32x4 x1 = (f32x4){__uint_as_float(w.z << 16), __uint_as_float(w.z & 0xffff0000u), __uint_as_float(w.w << 16), __uint_as_float(w.w & 0xffff0000u)};
                        const f32x4 v0 = x0 + mv[bj][0] * acc[ai][bj][m][0], v1 = x1 + mv[bj][1] * acc[ai][bj][m][1];
                        u32x4 o; o.x = cvt_pk_bf16(v0[0], v0[1]); o.y = cvt_pk_bf16(v0[2], v0[3]); o.z = cvt_pk_bf16(v1[0], v1[1]); o.w = cvt_pk_bf16(v1[2], v1[3]);
                        *(u32x4*)(out + (size_t)(R0 + rl0 + ai * HALF + m * 16) * D + col0 + bj * HALF) = o; }
            } else {
                f32x4 rf[4][2][2];
#pragma unroll
                for (int m = 0; m < 4; ++m)
#pragma unroll
                    for (int bj = 0; bj < 2; ++bj) { const __attribute__((address_space(1))) f32x4* ip = (const __attribute__((address_space(1))) f32x4*)(inb + ((unsigned long long)(rl0 + ai * HALF + m * 16) * D + col0 + bj * HALF) * 4u); rf[m][bj][0] = ip[0]; rf[m][bj][1] = ip[1]; }
                __builtin_amdgcn_sched_barrier(0);
#pragma unroll
                for (int m = 0; m < 4; ++m)
#pragma unroll
                    for (int bj = 0; bj < 2; ++bj) { const f32x4 v0 = rf[m][bj][0] + mv[bj][0] * acc[ai][bj][m][0], v1 = rf[m][bj][1] + mv[bj][1] * acc[ai][bj][m][1];
                        u32x4 o; o.x = cvt_pk_bf16(v0[0], v0[1]); o.y = cvt_pk_bf16(v0[2], v0[3]); o.z = cvt_pk_bf16(v1[0], v1[1]); o.w = cvt_pk_bf16(v1[2], v1[3]);
                        *(u32x4*)(out + (size_t)(R0 + rl0 + ai * HALF + m * 16) * D + col0 + bj * HALF) = o; }
            }
            __builtin_amdgcn_sched_barrier(0);
        }
    }
};
struct EpiSwiglu {
    static constexpr bool PERM = true;
    bf16_t* H; const float* b1;
    __device__ __forceinline__ void operator()(const f32x4 (&acc)[2][2][4][2], const Unit& u, int wr, int wc, int, int) const {
        const int e = u.bt >> 3; const int ln = lane_now(), fr = ln & 15, fq = ln >> 4;
        const int row0 = u.pm * BM + wr * 64 + fr, col0 = u.pn * HALF + wc * 32 + 8 * fq;
        const float* bb = b1 + (size_t)e * 2048 + col0;
        f32x4 bg[2], bl[2];
#pragma unroll
        for (int n = 0; n < 2; ++n) { bg[n] = *(const f32x4*)(bb + 4 * n); bl[n] = *(const f32x4*)(bb + 1024 + 4 * n) + 1.0f; }
#pragma unroll
        for (int ai = 0; ai < 2; ++ai)
#pragma unroll
            for (int m = 0; m < 4; ++m) { unsigned char* rowp = (unsigned char*)H + (size_t)(row0 + ai * HALF + m * 16) * D + col0;
                f32x2 v[2][2];
#pragma unroll
                for (int n = 0; n < 2; ++n)
#pragma unroll
                    for (int jp = 0; jp < 2; ++jp) {
                        const f32x2 ag = (f32x2){acc[ai][0][m][n][2 * jp], acc[ai][0][m][n][2 * jp + 1]}, al = (f32x2){acc[ai][1][m][n][2 * jp], acc[ai][1][m][n][2 * jp + 1]};
                        const f32x2 g2 = __builtin_elementwise_fma(ag, (f32x2){0.0625f, 0.0625f}, (f32x2){bg[n][2 * jp], bg[n][2 * jp + 1]});
                        const f32x2 l2 = __builtin_elementwise_fma(al, (f32x2){0.0625f, 0.0625f}, (f32x2){bl[n][2 * jp], bl[n][2 * jp + 1]});
                        const f32x2 gl = (f32x2){fminf(g2[0], 7.0f), fminf(g2[1], 7.0f)};
                        const f32x2 lc = (f32x2){__builtin_amdgcn_fmed3f(l2[0], -6.0f, 8.0f), __builtin_amdgcn_fmed3f(l2[1], -6.0f, 8.0f)};
                        const f32x2 t2 = gl * (f32x2){-1.702f * 1.44269504089f, -1.702f * 1.44269504089f};
                        const f32x2 d2 = (f32x2){__builtin_amdgcn_exp2f(t2[0]), __builtin_amdgcn_exp2f(t2[1])} + (f32x2){1.0f, 1.0f};
                        const f32x2 r2 = (f32x2){frcp(d2[0]), frcp(d2[1])};
                        v[n][jp] = (gl * lc) * r2; }
                v2u w; w.x = pk4_fp8(v[0][0][0], v[0][0][1], v[0][1][0], v[0][1][1]); w.y = pk4_fp8(v[1][0][0], v[1][0][1], v[1][1][0], v[1][1][1]);
                *(v2u*)(rowp) = w; }
    }
};
struct EpiW2 {
    static constexpr bool PERM = true;
    bf16_t* Y; const float* b2;
    __device__ __forceinline__ void operator()(const f32x4 (&acc)[2][2][4][2], const Unit& u, int wr, int wc, int fr, int fq) const {
        const int e = u.bt >> 2;
        const int row0 = u.pm * BM + wr * 64 + fr, col0 = u.pn * BM + wc * 32 + 8 * fq;
        const float* bb = b2 + (size_t)e * 1024 + col0;
        f32x4 bv[2][2];
#pragma unroll
        for (int bj = 0; bj < 2; ++bj)
#pragma unroll
            for (int n = 0; n < 2; ++n) bv[bj][n] = *(const f32x4*)(bb + bj * HALF + 4 * n) * 16.0f;
#pragma unroll
        for (int ai = 0; ai < 2; ++ai)
#pragma unroll
            for (int m = 0; m < 4; ++m) { unsigned char* rowp = (unsigned char*)Y + (size_t)(row0 + ai * HALF + m * 16) * D + col0;
#pragma unroll
                for (int bj = 0; bj < 2; ++bj) { f32x4 v0 = acc[ai][bj][m][0] + bv[bj][0], v1 = acc[ai][bj][m][1] + bv[bj][1];
#pragma unroll
                    for (int j = 0; j < 4; ++j) { v0[j] = __builtin_amdgcn_fmed3f(v0[j], -448.0f, 448.0f); v1[j] = __builtin_amdgcn_fmed3f(v1[j], -448.0f, 448.0f); }
                    v2u w; w.x = pk4_fp8(v0[0], v0[1], v0[2], v0[3]); w.y = pk4_fp8(v1[0], v1[1], v1[2], v1[3]);
                    *(v2u*)(rowp + bj * HALF) = w; } }
    }
};
}

#define XB_TMO      128
#define XB_XCNT(j)  (256  + 64 * (j))
#define XB_XSUB(j)  (1280 + 64 * (j))
#define XB_XGEN(j)  (2304 + 64 * (j))
#define XB_TOP      3328
#define XB_TOPGEN   3392
#define XCD_BAR_WORDS 3456
#define XB_SPIN_CAP (1u << 18)
__device__ __forceinline__ unsigned xb_ld(unsigned* p)              { return __hip_atomic_load(p, __ATOMIC_RELAXED, __HIP_MEMORY_SCOPE_AGENT); }
__device__ __forceinline__ unsigned xb_add(unsigned* p, unsigned v) { return __hip_atomic_fetch_add(p, v, __ATOMIC_RELAXED, __HIP_MEMORY_SCOPE_AGENT); }
__device__ __forceinline__ unsigned xb_xcc_id() { return (unsigned)__builtin_amdgcn_s_getreg((3 << 11) | 20) & 0xFu; }
#define XB_SPIN(cond, bar) do { unsigned _sp = 0; while (cond) { __builtin_amdgcn_s_sleep(1); \
    if ((++_sp & 255u) == 0u) { if (xb_ld(&(bar)[XB_TMO])) break; if (_sp > XB_SPIN_CAP) { atomicAdd(&(bar)[XB_TMO], 1u); break; } } } } while (0)
struct XcdBarrier { unsigned* bar; unsigned x; volatile LAS unsigned* st; };
__device__ __forceinline__ XcdBarrier xcd_barrier_post(unsigned* bar, volatile LAS unsigned* st) {
    XcdBarrier b; b.bar = bar; b.x = xb_xcc_id(); b.st = st;
    if (threadIdx.x == 0) (void)xb_add(&bar[XB_XCNT(b.x)], 1u);
    return b;
}
__device__ __forceinline__ void xcd_barrier_complete(unsigned* bar, unsigned x, unsigned& nloc, unsigned& nx) {
    const unsigned G = gridDim.x * gridDim.y * gridDim.z;
    unsigned sum, cnt, mine, sp = 0u;
    for (;;) {
        sum = 0u; cnt = 0u; mine = 0u;
#pragma unroll
        for (unsigned j = 0; j < 16; ++j) { const unsigned c = xb_ld(&bar[XB_XCNT(j)]); sum += c; cnt += (c > 0u) ? 1u : 0u; mine = (j == x) ? c : mine; }
        if (sum == G) break;
        __builtin_amdgcn_s_sleep(1);
        if ((++sp & 255u) == 0u) { if (xb_ld(&bar[XB_TMO])) break; if (sp > XB_SPIN_CAP) { atomicAdd(&bar[XB_TMO], 1u); break; } }
    }
    nloc = mine > 0u ? mine : 1u; nx = cnt > 0u ? cnt : 1u;
}
__device__ __forceinline__ void xcd_barrier(const XcdBarrier& b) {
    asm volatile("s_waitcnt vmcnt(0)" ::: "memory");
    __syncthreads();
    if (threadIdx.x == 0) {
        unsigned* bar = b.bar;
        __builtin_amdgcn_s_waitcnt(0);
        unsigned nloc = b.st[0], nx = b.st[1];
        if (nloc == 0u) { xcd_barrier_complete(bar, b.x, nloc, nx); b.st[0] = nloc; b.st[1] = nx; }
        const unsigned old = xb_add(&bar[XB_XSUB(b.x)], 1u);
        const unsigned gen = old / nloc;
        if (old + 1u == (gen + 1u) * nloc) {
            __builtin_amdgcn_fence(__ATOMIC_RELEASE, "agent");
            asm volatile("s_waitcnt vmcnt(0)" ::: "memory");
            const unsigned og = xb_add(&bar[XB_TOP], 1u);
            const unsigned tg = og / nx;
            if (og + 1u == (tg + 1u) * nx) xb_add(&bar[XB_TOPGEN], 1u);
            else XB_SPIN(xb_ld(&bar[XB_TOPGEN]) == tg, bar);
            __builtin_amdgcn_fence(__ATOMIC_ACQUIRE, "agent");
            xb_add(&bar[XB_XGEN(b.x)], 1u);
            asm volatile("s_waitcnt vmcnt(0)" ::: "memory");
        } else {
            XB_SPIN(xb_ld(&bar[XB_XGEN(b.x)]) == gen, bar);
            __builtin_amdgcn_fence(__ATOMIC_ACQUIRE, "agent");
            asm volatile("s_waitcnt vmcnt(0)" ::: "memory");
        }
    }
    __syncthreads();
}

struct Args { const float* in[25]; float* out; unsigned char* ws; int ph_lo, ph_hi; };
typedef const volatile __attribute__((address_space(4))) Args& ArgsRef;
enum { I_X = 0, I_C, I_CTX, I_CCTX, I_ADAW, I_ADAB, I_NMIXG, I_NFFNG, I_HGWIN, I_HGLB, I_HGNG, I_HGWOUT, I_MLWIN, I_MLBG, I_MLCW, I_MLCB, I_MLNG, I_MLWOUT, I_RW, I_RB, I_W1, I_B1, I_W2, I_B2, I_FNG };

__device__ __forceinline__ float wave_sum(float v) {
#pragma unroll
    for (int o = 1; o < 64; o <<= 1) v += __shfl_xor(v, o);
    return v;
}

struct TItem { const float* W; bf16* WT; int N, drow, k0, n0, f8; };
__device__ __forceinline__ void titem_load(const TItem& t, float (&tv)[32], int lane) {
#pragma unroll
    for (int i = 0; i < 32; ++i) tv[i] = t.W[(size_t)(t.k0 + 2 * i + (lane >> 5)) * t.N + t.n0 + (lane & 31)];
}

template <int LAYER> __device__ __forceinline__ void expert_tiles(ArgsRef a, LAS unsigned char* lds, int max_tiles) {
    const int tid = threadIdx.x, lane = tid & 63, wave = __builtin_amdgcn_readfirstlane(tid >> 6);
    constexpr int TP = 260;
    LAS float* T = (LAS float*)lds;
    const float* W1 = a.in[I_W1] + (size_t)LAYER * 32 * D * 2048; const float* W2 = a.in[I_W2] + (size_t)LAYER * 32 * D * D;
    unsigned char* W1T = a.ws + WS_W1 + (size_t)LAYER * 32 * 2048 * D; unsigned char* W2T = a.ws + WS_W2 + (size_t)LAYER * 32 * D * D;
    constexpr int NT1 = 32 * 64, NL = NT1 + 32 * 32;
    auto tsrc = [&](int t, int& N) -> const float* { if (t < NT1) { const int mat = t >> 6, r = t & 63; N = 2048; return W1 + ((size_t)mat * D + 128 * (r >> 3)) * 2048 + 256 * (r & 7); }
        const int t2 = t - NT1, mat = t2 >> 5, r = t2 & 31; N = D; return W2 + ((size_t)mat * D + 128 * (r >> 2)) * D + 256 * (r & 3); };
    unsigned* tcnt = (unsigned*)(a.ws + WS_CTL) + CW_TILE + LAYER; LAS int* tq = (LAS int*)(lds + LDS_MISC + 16);
    __syncthreads();
    if (tid == 0) { tq[1] = max_tiles >= 1 ? (int)__hip_atomic_fetch_add(tcnt, 1u, __ATOMIC_RELAXED, __HIP_MEMORY_SCOPE_AGENT) : NL;
                    tq[0] = max_tiles >= 2 ? (int)__hip_atomic_fetch_add(tcnt, 1u, __ATOMIC_RELAXED, __HIP_MEMORY_SCOPE_AGENT) : NL; }
    __syncthreads();
    int t = tq[1];
    if (t < NL) {
        f32x4 v[16]; { int N; const float* sp = tsrc(t, N) + (size_t)(16 * wave) * N + 4 * lane;
#pragma unroll
            for (int i = 0; i < 16; ++i) v[i] = *(const f32x4*)(sp + (size_t)i * N); }
        for (int k = 1; ; ++k) {
#pragma unroll
            for (int i = 0; i < 16; ++i) *(LAS f32x4*)(T + (16 * wave + i) * TP + ((4 * lane + 8 * wave) & 255)) = v[i];
            __syncthreads();
            const int tn = tq[(k + 1) & 1]; unsigned tnn = 0u; const bool want = (k + 2 <= max_tiles) && tn < NL;
            if (tid == 0 && want) tnn = __hip_atomic_fetch_add(tcnt, 1u, __ATOMIC_RELAXED, __HIP_MEMORY_SCOPE_AGENT);
            if (tn < NL) { int N2; const float* sp = tsrc(tn, N2) + (size_t)(16 * wave) * N2 + 4 * lane;
#pragma unroll
                for (int i = 0; i < 16; ++i) v[i] = *(const f32x4*)(sp + (size_t)i * N2); }
            __builtin_amdgcn_sched_barrier(0);
            const int ks = lane & 7, nl = lane >> 3;
#pragma unroll
            for (int q = 0; q < 4; ++q) { const int n = 32 * wave + 8 * q + nl; unsigned char* dp;
                if (t < NT1) { const int mat = t >> 6, r = t & 63, ng = 256 * (r & 7) + n, cc = ng & 1023, bj = ng >> 10; dp = W1T + ((size_t)mat * 2048 + 256 * (cc >> 7) + 128 * bj + (cc & 127)) * D + 128 * (r >> 3); }
                else { const int t2 = t - NT1, mat = t2 >> 5, r = t2 & 31; dp = W2T + ((size_t)mat * D + 256 * (r & 3) + n) * D + 128 * (r >> 2); }
                const LAS float* tp = T + (16 * ks) * TP + ((n + 8 * ks) & 255); float x[16];
#pragma unroll
                for (int i = 0; i < 16; ++i) x[i] = 16.f * tp[i * TP];
                v4u o; o.x = pk4_fp8(x[0], x[1], x[2], x[3]); o.y = pk4_fp8(x[4], x[5], x[6], x[7]); o.z = pk4_fp8(x[8], x[9], x[10], x[11]); o.w = pk4_fp8(x[12], x[13], x[14], x[15]);
                *(v4u*)(dp + 16 * ks) = o; }
            if (tid == 0) tq[k & 1] = want ? (int)tnn : NL;
            __syncthreads();
            if (tn >= NL) break;
            t = tn;
        }
    }
}
template <class Sched> __device__ __forceinline__ bool idle_last_round(const Sched& S) { pg8::Unit u; Sched S0 = S; S0.c = 0; int n = 0, n0 = 0; while (S.next(n, u)) ++n; while (S0.next(n0, u)) ++n0; return n < n0; }

__device__ __forceinline__ void ph_prologue(ArgsRef a, LAS unsigned char* lds) {
    const int tid = threadIdx.x, lane = tid & 63, wave = __builtin_amdgcn_readfirstlane(tid >> 6), G = gridDim.x;
    unsigned char* ws = a.ws;
    float* modl = (float*)(ws + WS_SM + SM_MODL); float* modc = (float*)(ws + WS_SM + SM_MODC); float* oml = (float*)(ws + WS_SM + SM_OML);
    {
        LAS float* actT = (LAS float*)lds;
        LAS float* red = (LAS float*)(lds + 81920);
        bool staged = false;
        for (int it = blockIdx.x; it < 192; it += G) {
            if (!staged) {
                { float cv[34];
#pragma unroll
                    for (int i = 0; i < 34; ++i) { const int r = i >> 1, k = tid + 512 * (i & 1); cv[i] = r < 16 ? a.in[I_C][r * 1024 + k] : a.in[I_CCTX][k]; }
#pragma unroll
                    for (int i = 0; i < 34; ++i) { const int r = i >> 1, k = tid + 512 * (i & 1); actT[k * 20 + r] = siluf(cv[i]); } }
                __syncthreads(); staged = true;
            }
            const int layer = it / 96, n0 = (it % 96) * 64;
            const float* W = a.in[I_ADAW] + (size_t)layer * D * 6 * D + n0 + lane;
            float acc[17];
#pragma unroll
            for (int r = 0; r < 17; ++r) acc[r] = 0.f;
#pragma unroll 1
            for (int kb = wave * 128; kb < wave * 128 + 128; kb += 32) {
              float wv[32];
#pragma unroll
              for (int i = 0; i < 32; ++i) wv[i] = W[(size_t)(kb + i) * (6 * D)];
              __builtin_amdgcn_sched_barrier(0);
#pragma unroll
              for (int i = 0; i < 32; ++i) { const int k = kb + i; const float w = wv[i];
                const LAS f32x4* ap = (const LAS f32x4*)(actT + k * 20);
                const f32x4 a0 = ap[0], a1 = ap[1], a2 = ap[2], a3 = ap[3]; const float a16 = actT[k * 20 + 16];
                acc[0] += a0[0] * w; acc[1] += a0[1] * w; acc[2] += a0[2] * w; acc[3] += a0[3] * w;
                acc[4] += a1[0] * w; acc[5] += a1[1] * w; acc[6] += a1[2] * w; acc[7] += a1[3] * w;
                acc[8] += a2[0] * w; acc[9] += a2[1] * w; acc[10] += a2[2] * w; acc[11] += a2[3] * w;
                acc[12] += a3[0] * w; acc[13] += a3[1] * w; acc[14] += a3[2] * w; acc[15] += a3[3] * w;
                acc[16] += a16 * w;
              }
            }
#pragma unroll
            for (int r = 0; r < 17; ++r) red[(wave * 17 + r) * 64 + lane] = acc[r];
            __syncthreads();
            for (int idx = tid; idx < 17 * 64; idx += NTHREADS) { const int r = idx >> 6, l = idx & 63; float s = a.in[I_ADAB][layer * 6 * D + n0 + l];
#pragma unroll
                for (int w = 0; w < 8; ++w) s += red[(w * 17 + r) * 64 + l];
                const int sl = (n0 + l) >> 10, dcol = (n0 + l) & 1023;
                if (sl == 1) s = a.in[I_NMIXG][layer * D + dcol] * (1.0f + s); else if (sl == 4) s = a.in[I_NFFNG][layer * D + dcol] * (1.0f + s);
                if (r < 16) modl[((size_t)layer * 16 + r) * (6 * D) + n0 + l] = s; else modc[(size_t)layer * (6 * D) + n0 + l] = s; }
            __syncthreads();
        }
        __syncthreads();
    }
    {
        const int gt = blockIdx.x * NTHREADS + tid;
        if (gt < 2 * D) { const int dir = gt >> 10, c = gt & 1023; const float* lg = a.in[I_HGLB] + (size_t)dir * 3 * D + c;
            const float l0 = lg[0], l1 = lg[D], l2 = lg[2 * D]; const float mx = fmaxf(l0, fmaxf(l1, l2));
            const float e0 = __expf(l0 - mx), e1 = __expf(l1 - mx), e2 = __expf(l2 - mx);
            oml[gt] = (e1 + e2) / (e0 + e1 + e2); }
    }
    {
        LAS float* scr = (LAS float*)(lds + wave * 16384);
        const int gw = blockIdx.x * NWAVES + wave, NGW = G * NWAVES;
        bf16* WHGIN = (bf16*)(ws + WS_WHGIN); bf16* WHGOUT = (bf16*)(ws + WS_WHGOUT); bf16* WMLIN = (bf16*)(ws + WS_WMLIN); bf16* WMLOUT = (bf16*)(ws + WS_WMLOUT);
        bf16* W1T = (bf16*)(ws + WS_W1); bf16* W2T = (bf16*)(ws + WS_W2);
        constexpr int S0 = 16 * 160, S1 = 16 * 32, S2 = 16 * 97, S3 = 16 * 32, S4 = 64 * 16 * 64, S5 = 64 * 16 * 32;
        constexpr int NITEMS = S0 + S1 + S2 + S3;
        auto decode = [&](int it) -> TItem { int r = it; TItem t;
            if (r < S0) { t.f8 = 0; t.W = a.in[I_HGWIN]; t.N = HG_N; t.WT = WHGIN; t.drow = (r % 160) * 32; t.k0 = (r / 160) * 64; t.n0 = (r % 160) * 32; return t; } r -= S0;
            if (r < S1) { t.f8 = 0; t.W = a.in[I_HGWOUT]; t.N = D; t.WT = WHGOUT; t.drow = (r % 32) * 32; t.k0 = (r / 32) * 64; t.n0 = (r % 32) * 32; return t; } r -= S1;
            if (r < S2) { t.f8 = 0; t.W = a.in[I_MLWIN]; t.N = ML_N; t.WT = WMLIN; t.drow = (r % 97) * 32; t.k0 = (r / 97) * 64; t.n0 = (r % 97) * 32; return t; } r -= S2;
            if (r < S3) { t.f8 = 0; t.W = a.in[I_MLWOUT]; t.N = D; t.WT = WMLOUT; t.drow = (r % 32) * 32; t.k0 = (r / 32) * 64; t.n0 = (r % 32) * 32; return t; } r -= S3;
            if (r < S4) { const int mat = r >> 10, q = r & 1023, nb = q & 63, kb = q >> 6; const int n0 = nb * 32, cc = n0 & 1023, bj = n0 >> 10;
                t.f8 = 1; t.W = a.in[I_W1] + (size_t)mat * D * 2048; t.N = 2048; t.WT = (bf16*)((unsigned char*)W1T + (size_t)mat * 2048 * D); t.drow = 256 * (cc >> 7) + 128 * bj + (cc & 127); t.k0 = kb * 64; t.n0 = n0; return t; } r -= S4;
            { const int mat = r >> 9, q = r & 511, nb = q & 31, kb = q >> 5;
                t.f8 = 1; t.W = a.in[I_W2] + (size_t)mat * D * D; t.N = D; t.WT = (bf16*)((unsigned char*)W2T + (size_t)mat * D * D); t.drow = nb * 32; t.k0 = kb * 64; t.n0 = nb * 32; return t; } };
        float tv[32]; TItem cur = decode(gw < NITEMS ? gw : 0);
        titem_load(cur, tv, lane);
        for (int it = gw; it < NITEMS; it += NGW) {
#pragma unroll
            for (int i = 0; i < 32; ++i) scr[(2 * i + (lane >> 5)) * 33 + (lane & 31)] = tv[i];
            LDS_WAIT(); asm volatile("" ::: "memory");
            const TItem nxt = decode(it + NGW < NITEMS ? it + NGW : it);
            if (it + NGW < NITEMS) titem_load(nxt, tv, lane);
            const int c = lane & 7;
#pragma unroll
            for (int j = 0; j < 4; ++j) { const int n = (lane >> 3) + 8 * j; const LAS float* sp = scr + (8 * c) * 33 + n;
                if (cur.f8) { v2u o8; o8.x = pk4_fp8(16.f * sp[0 * 33], 16.f * sp[1 * 33], 16.f * sp[2 * 33], 16.f * sp[3 * 33]); o8.y = pk4_fp8(16.f * sp[4 * 33], 16.f * sp[5 * 33], 16.f * sp[6 * 33], 16.f * sp[7 * 33]);
                    *(v2u*)((unsigned char*)cur.WT + (size_t)(cur.drow + n) * D + cur.k0 + 8 * c) = o8; }
                else { v4u o; o.x = pk2(sp[0 * 33], sp[1 * 33]); o.y = pk2(sp[2 * 33], sp[3 * 33]); o.z = pk2(sp[4 * 33], sp[5 * 33]); o.w = pk2(sp[6 * 33], sp[7 * 33]);
                    *(v4u*)(cur.WT + (size_t)(cur.drow + n) * D + cur.k0 + 8 * c) = o; } }
            LDS_WAIT(); asm volatile("" ::: "memory");
            cur = nxt;
        }
        for (size_t i = (size_t)blockIdx.x * NTHREADS + tid; i < (size_t)(ML_NP - ML_N) * D / 8; i += (size_t)G * NTHREADS) ((v4u*)(WMLIN + (size_t)ML_N * D))[i] = (v4u){0u, 0u, 0u, 0u};
    }
    expert_tiles<0>(a, lds, 1 << 30);
}

__device__ __forceinline__ void ph_modulate(ArgsRef a, const float* src_ctx, const float* src_lat, const float* g, int layer, int shift_idx, int R0, int R1, bf16* out) {
    const int tid = threadIdx.x, lane = tid & 63, wave = __builtin_amdgcn_readfirstlane(tid >> 6);
    const float* modl = (const float*)(a.ws + WS_SM + SM_MODL) + (size_t)layer * 16 * 6 * D; const float* modc = (const float*)(a.ws + WS_SM + SM_MODC) + (size_t)layer * 6 * D;
    const int gw = blockIdx.x * NWAVES + wave, NGW = gridDim.x * NWAVES;
    for (int Rq = R0 + gw; Rq < R1; Rq += 2 * NGW) {
        f32x4 v[2][4], sh[2][4], sc[2][4];
#pragma unroll
        for (int u = 0; u < 2; ++u) { const int R = (Rq + u * NGW < R1) ? Rq + u * NGW : Rq;
            const bool isctx = R < NTC;
            const float* xr = isctx ? src_ctx + (size_t)R * D : src_lat + (size_t)(R - NTC) * D;
            const float* mod = isctx ? modc : modl + (size_t)((R - NTC) / SEQ) * 6 * D;
#pragma unroll
            for (int j = 0; j < 4; ++j) { v[u][j] = ((const f32x4*)xr)[64 * j + lane]; sh[u][j] = ((const f32x4*)(mod + shift_idx * D))[64 * j + lane]; sc[u][j] = ((const f32x4*)(mod + (shift_idx + 1) * D))[64 * j + lane]; } }
        __builtin_amdgcn_sched_barrier(0);
#pragma unroll
        for (int u = 0; u < 2; ++u) { const int R = Rq + u * NGW;
            float ss = 0.f;
#pragma unroll
            for (int j = 0; j < 4; ++j) ss += (v[u][j][0] * v[u][j][0] + v[u][j][1] * v[u][j][1]) + (v[u][j][2] * v[u][j][2] + v[u][j][3] * v[u][j][3]);
            const float rs = 1.0f / sqrtf(wave_sum(ss) * (1.0f / D) + EPS);
            if (R < R1) { v2u* o8 = (v2u*)(out + (size_t)R * D);
#pragma unroll
                for (int j = 0; j < 4; ++j) { const f32x4 y = v[u][j] * rs * sc[u][j] + sh[u][j];
                    v2u w; w.x = pk2(y[0], y[1]); w.y = pk2(y[2], y[3]); o8[64 * j + lane] = w; } } }
    }
}

__device__ __forceinline__ int seq_row(int b, int dir, int p) {
    if (p < CTX) { const int t = dir ? CTX - 1 - p : p; return b * CTX + t; }
    const int pl = p - CTX; const int t = dir ? SEQ - 1 - pl : pl; return NTC + b * SEQ + t;
}


typedef short s16x4 __attribute__((ext_vector_type(4)));
typedef float f32x16 __attribute__((ext_vector_type(16)));
__device__ __forceinline__ unsigned offb(unsigned row, unsigned ch) { return 256u * row + 16u * (ch ^ (((row & 3u) << 2) | ((row >> 2) & 3u))); }
__device__ __forceinline__ s16x4 tr16(const LAS unsigned char* p) { return __builtin_amdgcn_ds_read_tr16_b64_v4i16((LAS s16x4*)p); }
__device__ __forceinline__ bf16x8 rd_row_b(const LAS unsigned char* tile, int lane, int rb, int kk) { return *(const LAS bf16x8*)(tile + offb(32 * rb + (lane & 31), 2 * kk + (lane >> 5))); }
__device__ __forceinline__ bf16x8 rd_tr_b(const LAS unsigned char* tile, int lane, int c, int ks) {
    const unsigned h = lane >> 5, blk = (lane >> 4) & 1, q = (lane & 15) >> 2, p = lane & 3;
    const s16x4 x = tr16(tile + offb(16 * ks + 8 * h + q, 4 * c + 2 * blk + (p >> 1)) + 8 * (p & 1));
    const s16x4 y = tr16(tile + offb(16 * ks + 8 * h + 4 + q, 4 * c + 2 * blk + (p >> 1)) + 8 * (p & 1));
    return (bf16x8){x[0], x[1], x[2], x[3], y[0], y[1], y[2], y[3]};
}
__device__ __forceinline__ bf16x8 rd_row_p(const LAS unsigned char* tile, int st, int lane, int rb, int kk) { return *(const LAS bf16x8*)(tile + (32 * rb + (lane & 31)) * st + (16 * kk + 8 * (lane >> 5)) * 2); }
__device__ __forceinline__ bf16x8 rd_tr_p(const LAS unsigned char* tile, int st, int lane, int c, int ks) {
    const unsigned h = lane >> 5, blk = (lane >> 4) & 1, q = (lane & 15) >> 2, p = lane & 3;
    const LAS unsigned char* b = tile + (16 * ks + 8 * h + q) * st + (32 * c + 16 * blk + 4 * p) * 2;
    const s16x4 x = tr16(b), y = tr16(b + 4 * st);
    return (bf16x8){x[0], x[1], x[2], x[3], y[0], y[1], y[2], y[3]};
}
__device__ __forceinline__ void tri_tile(int idx, int& ti4, int& si4) {
    ti4 = idx < 1 ? 0 : idx < 3 ? 1 : idx < 6 ? 2 : 3; si4 = idx - (ti4 * (ti4 + 1)) / 2;
}

__device__ __forceinline__ void ph_hg_scan(ArgsRef a, LAS unsigned char* lds) {
    const int tid = threadIdx.x, lane = tid & 63, w = __builtin_amdgcn_readfirstlane(tid >> 6), hh = lane >> 5, r32 = lane & 31;
    const bf16* QS = (const bf16*)(a.ws + WS_BIG); const bf16* VI = QS + (size_t)NT * D; const bf16* KF = VI + (size_t)NT * D; const bf16* KB = KF + (size_t)NT * D;
    bf16* OF = (bf16*)(a.ws + WS_BIG + 5 * T72); bf16* OB = OF + (size_t)NT * D;
    constexpr int SQ = 272, SV = 320, SA = 144;
    constexpr int O_QA = 0, O_KA = 17408, O_V = 34816, O_ST = 55296, O_ATT = 90112, O_OST = 99328, O_TOT = 116736, O_FIRST = 120832, O_EB = 124928, O_EG = 125440;
    LAS unsigned char* QA = lds + O_QA; LAS unsigned char* KA = lds + O_KA; LAS unsigned char* VT = lds + O_V; LAS unsigned char* ST = lds + O_ST;
    LAS unsigned char* ATT = lds + O_ATT; LAS unsigned char* OST = lds + O_OST;
    LAS float* TOT = (LAS float*)(lds + O_TOT); LAS float* FIRST = (LAS float*)(lds + O_FIRST); LAS float* EB = (LAS float*)(lds + O_EB); LAS float* EG = (LAS float*)(lds + O_EG);
    for (int i = tid; i < 64 * SA / 4; i += NTHREADS) ((LAS unsigned*)ATT)[i] = 0u;
    const int ls = tid >> 4, lc = tid & 15;
    const int tq = (lane & 15) >> 2, tp = lane & 3, tblk = (lane >> 4) & 1;
    const LAS unsigned char* rQA = QA + r32 * SQ + hh * 16;
    const LAS unsigned char* rST = ST + r32 * SQ + hh * 16;
    const LAS unsigned char* rATT = ATT + r32 * SA + hh * 16;
    const LAS unsigned char* tV = VT + (8 * hh + tq) * SV + (16 * tblk + 4 * tp) * 2;
    const LAS unsigned char* tK = KA + (8 * hh + tq) * SQ + (16 * tblk + 4 * tp) * 2;
    const int fr = lane & 15, fq = lane >> 4;
    const int ti = w >> 2, ej = w & 3, di = w >> 1, e2 = 2 * (w & 1);
    for (int item = blockIdx.x; item < 256; item += gridDim.x) {
        const int dir = item & 1, h = (item >> 1) & 7, b = item >> 4;
        const bf16* Kd = dir ? KB : KF; bf16* Od = dir ? OB : OF;
        f32x16 S0, S1;
#pragma unroll
        for (int i = 0; i < 16; ++i) { S0[i] = 0.f; S1[i] = 0.f; }
        v4u pq[2], pk[2], pv[2];
#pragma unroll
        for (int x = 0; x < 2; ++x) { const size_t off = (size_t)seq_row(b, dir, ls + 32 * x) * D + h * 128 + lc * 8; pq[x] = *(const v4u*)(QS + off); pk[x] = *(const v4u*)(Kd + off); pv[x] = *(const v4u*)(VI + off); }
#pragma unroll
        for (int x = 0; x < 2; ++x) { *(LAS v4u*)(QA + (ls + 32 * x) * SQ + lc * 16) = pq[x]; *(LAS v4u*)(KA + (ls + 32 * x) * SQ + lc * 16) = pk[x]; *(LAS v4u*)(VT + (ls + 32 * x) * SV + lc * 16) = pv[x]; }
        for (int ch = 0; ch < (CTX + SEQ) / 64; ++ch) {
            __syncthreads();
            if (ch + 1 < (CTX + SEQ) / 64) {
#pragma unroll
                for (int x = 0; x < 2; ++x) { const size_t off = (size_t)seq_row(b, dir, (ch + 1) * 64 + ls + 32 * x) * D + h * 128 + lc * 8; pq[x] = *(const v4u*)(QS + off); pk[x] = *(const v4u*)(Kd + off); pv[x] = *(const v4u*)(VI + off); }
            }
            unsigned kwv[8], qwv[8]; float l0[8], l1[8];
#pragma unroll
            for (int i = 0; i < 8; ++i) { kwv[i] = *(const LAS unsigned*)(KA + (8 * w + i) * SQ + lane * 4); qwv[i] = *(const LAS unsigned*)(QA + (8 * w + i) * SQ + lane * 4); }
            { float r0 = 0.f, r1 = 0.f;
#pragma unroll
                for (int i = 0; i < 8; ++i) { l0[i] = __builtin_amdgcn_logf(fmaxf(1.0f - bf2f(kwv[i] & 0xffffu), 1e-30f)); l1[i] = __builtin_amdgcn_logf(fmaxf(1.0f - bf2f(kwv[i] >> 16), 1e-30f)); r0 += l0[i]; r1 += l1[i]; }
                *(LAS f32x2*)(TOT + w * 128 + 2 * lane) = (f32x2){r0, r1}; *(LAS f32x2*)(FIRST + w * 128 + 2 * lane) = (f32x2){l0[0], l1[0]}; }
            __syncthreads();
            { float p0 = 0.f, p1 = 0.f, br0 = 0.f, br1 = 0.f, be0 = 0.f, be1 = 0.f; f32x2 tt[8];
#pragma unroll
                for (int o = 0; o < 8; ++o) tt[o] = *(const LAS f32x2*)(TOT + o * 128 + 2 * lane);
                const f32x2 ff = *(const LAS f32x2*)(FIRST + 4 * 128 + 2 * lane);
#pragma unroll
                for (int o = 0; o < 8; ++o) { if (o < w) { p0 += tt[o][0]; p1 += tt[o][1]; } if (o < 4) { br0 += tt[o][0]; br1 += tt[o][1]; } be0 += tt[o][0]; be1 += tt[o][1]; }
                br0 += ff[0]; br1 += ff[1];
#pragma unroll
                for (int i = 0; i < 8; ++i) { p0 += l0[i]; p1 += l1[i];
                    const float ea0 = __builtin_amdgcn_exp2f(p0 - br0), ea1 = __builtin_amdgcn_exp2f(p1 - br1), ek0 = __builtin_amdgcn_exp2f(br0 - p0), ek1 = __builtin_amdgcn_exp2f(br1 - p1);
                    *(LAS unsigned*)(QA + (8 * w + i) * SQ + lane * 4) = pk2(bf2f(qwv[i] & 0xffffu) * ea0, bf2f(qwv[i] >> 16) * ea1);
                    *(LAS unsigned*)(KA + (8 * w + i) * SQ + lane * 4) = pk2(bf2f(kwv[i] & 0xffffu) * ek0, bf2f(kwv[i] >> 16) * ek1); }
                if (w == 0) { *(LAS f32x2*)(EB + 2 * lane) = (f32x2){__builtin_amdgcn_exp2f(br0), __builtin_amdgcn_exp2f(br1)}; *(LAS f32x2*)(EG + 2 * lane) = (f32x2){__builtin_amdgcn_exp2f(be0 - br0), __builtin_amdgcn_exp2f(be1 - br1)}; } }
            __syncthreads();
            {
                f32x4 eb[4], eg[4];
#pragma unroll
                for (int g = 0; g < 4; ++g) { eb[g] = *(const LAS f32x4*)(EB + 32 * di + 8 * g + 4 * hh); eg[g] = *(const LAS f32x4*)(EG + 32 * di + 8 * g + 4 * hh); }
                bf16x8 kA[4], vB0[4], vB1[4];
#pragma unroll
                for (int kk = 0; kk < 4; ++kk) { const LAS unsigned char* pa = tK + kk * 16 * SQ + di * 64; const s16x4 x = tr16(pa), y = tr16(pa + 4 * SQ); kA[kk] = (bf16x8){x[0], x[1], x[2], x[3], y[0], y[1], y[2], y[3]}; }
#pragma unroll
                for (int kk = 0; kk < 4; ++kk) { const LAS unsigned char* pb = tV + kk * 16 * SV + e2 * 64; const s16x4 x = tr16(pb), y = tr16(pb + 4 * SV), x2 = tr16(pb + 64), y2 = tr16(pb + 64 + 4 * SV);
                    vB0[kk] = (bf16x8){x[0], x[1], x[2], x[3], y[0], y[1], y[2], y[3]}; vB1[kk] = (bf16x8){x2[0], x2[1], x2[2], x2[3], y2[0], y2[1], y2[2], y2[3]}; }
#pragma unroll
                for (int rep = 0; rep < 2; ++rep) { const int idx = w + 8 * rep; if (idx < 10) { int ti4, si4; tri_tile(idx, ti4, si4);
                    bf16x8 A[4], Bm[4];
#pragma unroll
                    for (int kk = 0; kk < 4; ++kk) { A[kk] = *(const LAS bf16x8*)(QA + (16 * ti4 + fr) * SQ + fq * 16 + kk * 64); Bm[kk] = *(const LAS bf16x8*)(KA + (16 * si4 + fr) * SQ + fq * 16 + kk * 64); }
                    f32x4 acc = (f32x4){0.f, 0.f, 0.f, 0.f};
#pragma unroll
                    for (int kk = 0; kk < 4; ++kk) acc = __builtin_amdgcn_mfma_f32_16x16x32_bf16(A[kk], Bm[kk], acc, 0, 0, 0);
                    const int scol = 16 * si4 + fr;
#pragma unroll
                    for (int r = 0; r < 4; ++r) { const int trow = 16 * ti4 + 4 * fq + r; *(LAS unsigned short*)(ATT + trow * SA + scol * 2) = (unsigned short)f2bf(scol <= trow ? acc[r] : 0.f); } } }
#pragma unroll
                for (int g = 0; g < 4; ++g) {
#pragma unroll
                    for (int j = 0; j < 4; ++j) { S0[4 * g + j] *= eb[g][j]; S1[4 * g + j] *= eb[g][j]; }
                    v2u w0, w1; w0.x = pk2(S0[4 * g], S0[4 * g + 1]); w0.y = pk2(S0[4 * g + 2], S0[4 * g + 3]); w1.x = pk2(S1[4 * g], S1[4 * g + 1]); w1.y = pk2(S1[4 * g + 2], S1[4 * g + 3]);
                    *(LAS v2u*)(ST + (32 * e2 + r32) * SQ + (32 * di + 8 * g + 4 * hh) * 2) = w0; *(LAS v2u*)(ST + (32 * e2 + 32 + r32) * SQ + (32 * di + 8 * g + 4 * hh) * 2) = w1; }
#pragma unroll
                for (int kk = 0; kk < 4; ++kk) { S0 = __builtin_amdgcn_mfma_f32_32x32x16_bf16(kA[kk], vB0[kk], S0, 0, 0, 0); S1 = __builtin_amdgcn_mfma_f32_32x32x16_bf16(kA[kk], vB1[kk], S1, 0, 0, 0); }
#pragma unroll
                for (int g = 0; g < 4; ++g)
#pragma unroll
                    for (int j = 0; j < 4; ++j) { S0[4 * g + j] *= eg[g][j]; S1[4 * g + j] *= eg[g][j]; }
            }
            __syncthreads();
            { f32x16 o;
#pragma unroll
                for (int i = 0; i < 16; ++i) o[i] = 0.f;
                bf16x8 A[4], Bm[4];
#pragma unroll
                for (int kk = 0; kk < 4; ++kk) { A[kk] = *(const LAS bf16x8*)(rATT + ti * 32 * SA + kk * 32); const LAS unsigned char* pb = tV + kk * 16 * SV + ej * 64; const s16x4 x = tr16(pb), y = tr16(pb + 4 * SV); Bm[kk] = (bf16x8){x[0], x[1], x[2], x[3], y[0], y[1], y[2], y[3]}; }
                bf16x8 A2[4], B2[4];
#pragma unroll
                for (int kk = 0; kk < 4; ++kk) { A2[kk] = *(const LAS bf16x8*)(rQA + ti * 32 * SQ + kk * 32); B2[kk] = *(const LAS bf16x8*)(rST + ej * 32 * SQ + kk * 32); }
#pragma unroll
                for (int kk = 0; kk < 4; ++kk) o = __builtin_amdgcn_mfma_f32_32x32x16_bf16(A[kk], Bm[kk], o, 0, 0, 0);
#pragma unroll
                for (int kk = 0; kk < 4; ++kk) { A[kk] = *(const LAS bf16x8*)(rQA + ti * 32 * SQ + (kk + 4) * 32); Bm[kk] = *(const LAS bf16x8*)(rST + ej * 32 * SQ + (kk + 4) * 32); }
#pragma unroll
                for (int kk = 0; kk < 4; ++kk) o = __builtin_amdgcn_mfma_f32_32x32x16_bf16(A2[kk], B2[kk], o, 0, 0, 0);
#pragma unroll
                for (int kk = 0; kk < 4; ++kk) o = __builtin_amdgcn_mfma_f32_32x32x16_bf16(A[kk], Bm[kk], o, 0, 0, 0);
                const int ecol = 32 * ej + r32;
#pragma unroll
                for (int r = 0; r < 16; ++r) { const int trow = 32 * ti + (r & 3) + 8 * (r >> 2) + 4 * hh; *(LAS unsigned short*)(OST + trow * SQ + ecol * 2) = (unsigned short)f2bf(o[r]); } }
            __syncthreads();
            if (ch + 1 < (CTX + SEQ) / 64) {
#pragma unroll
                for (int x = 0; x < 2; ++x) { *(LAS v4u*)(QA + (ls + 32 * x) * SQ + lc * 16) = pq[x]; *(LAS v4u*)(KA + (ls + 32 * x) * SQ + lc * 16) = pk[x]; *(LAS v4u*)(VT + (ls + 32 * x) * SV + lc * 16) = pv[x]; } }
#pragma unroll
            for (int x = 0; x < 2; ++x) { const int row = ls + 32 * x; const v4u val = *(const LAS v4u*)(OST + row * SQ + lc * 16);
                *(v4u*)(Od + (size_t)seq_row(b, dir, ch * 64 + row) * D + h * 128 + lc * 8) = val; }
        }
        __syncthreads();
    }
}


__device__ __forceinline__ float wave_incl_sum(float v) {
    v += dppf<0x111, 0xf>(0.f, v); v += dppf<0x112, 0xf>(0.f, v); v += dppf<0x114, 0xf>(0.f, v); v += dppf<0x118, 0xf>(0.f, v);
    v += dppf<0x142, 0xa>(0.f, v); v += dppf<0x143, 0xc>(0.f, v); return v;
}
__device__ __forceinline__ float wave_incl_max(float v) {
    const float ninf = -3.0e38f;
    v = fmaxf(v, dppf<0x111, 0xf>(ninf, v)); v = fmaxf(v, dppf<0x112, 0xf>(ninf, v)); v = fmaxf(v, dppf<0x114, 0xf>(ninf, v)); v = fmaxf(v, dppf<0x118, 0xf>(ninf, v));
    v = fmaxf(v, dppf<0x142, 0xa>(ninf, v)); v = fmaxf(v, dppf<0x143, 0xc>(ninf, v)); return v;
}
__device__ __forceinline__ void ph_ml_scan(ArgsRef a, LAS unsigned char* lds) {
    const int tid = threadIdx.x, lane = tid & 63, w = __builtin_amdgcn_readfirstlane(tid >> 6), hh = lane >> 5, r32 = lane & 31;
    const bf16* QK = (const bf16*)(a.ws + WS_BIG + 3 * T72); const bf16* VV = (const bf16*)(a.ws + WS_BIG + 1 * T72);
    bf16* HF = (bf16*)(a.ws + WS_BIG + 4 * T72); bf16* HB = (bf16*)(a.ws + WS_BIG + 5 * T72);
    const float* Gt = (const float*)(a.ws + WS_GT);
    constexpr int SA = 144, SO = 272, SV = 320;
    constexpr int O_Q = 0, O_K = 9216, O_KW = 18432, O_SC = 27648, O_V = 36864, O_CT = 57344, O_OST = 75776, O_VEC = 93184, O_NP = 95488;
    LAS unsigned char* Qt = lds + O_Q; LAS unsigned char* Kt = lds + O_K; LAS unsigned char* KW = lds + O_KW; LAS unsigned char* SC = lds + O_SC;
    LAS unsigned char* VT = lds + O_V; LAS unsigned char* CT = lds + O_CT; LAS unsigned char* OST = lds + O_OST;
    LAS float* vA = (LAS float*)(lds + O_VEC); LAS float* vM = vA + 64; LAS float* vWI = vM + 64; LAS float* vEMM = vWI + 64; LAS float* vWK = vEMM + 64;
    LAS float* vRI = vWK + 64; LAS float* vWIRI = vRI + 64; LAS float* vN = vWIRI + 64; LAS float* vSC = vN + 64;
    LAS float* NP = (LAS float*)(lds + O_NP);
    for (int i = tid; i < 64 * SA / 4; i += NTHREADS) ((LAS unsigned*)SC)[i] = 0u;
    const int ls = tid >> 4, lc = tid & 15;
    const int qs = tid >> 3, qc = tid & 7;
    const int tq = (lane & 15) >> 2, tp = lane & 3, tblk = (lane >> 4) & 1;
    const LAS unsigned char* tV = VT + (8 * hh + tq) * SV + (16 * tblk + 4 * tp) * 2;
    const LAS unsigned char* tKW = KW + (8 * hh + tq) * SA + (16 * tblk + 4 * tp) * 2;
    const int fr = lane & 15, fq = lane >> 4;
    const int ti = w >> 2, ej = w & 3, di = w >> 2;
    for (int item = blockIdx.x; item < 256; item += gridDim.x) {
        const int dir = item & 1, h = (item >> 1) & 7, b = item >> 4;
        bf16* Hd = dir ? HB : HF;
        const int ci = dir * 8 + h, cf = 16 + dir * 8 + h;
        f32x16 Cs;
#pragma unroll
        for (int i = 0; i < 16; ++i) Cs[i] = 0.f;
        for (int i = tid; i < 128 * SA / 4; i += NTHREADS) ((LAS unsigned*)CT)[i] = 0u;
        if (tid < 64) vN[tid] = 0.f;
        NP[tid] = 0.f;
        float m0 = 0.f, m0n = 0.f, dec_prev = 0.f;
        v4u pq, pk, pv[2]; float pgi = 0.f, pgf = 0.f;
        { const size_t ro = (size_t)seq_row(b, dir, qs) * D; pq = *(const v4u*)(QK + ro + h * 64 + qc * 8); pk = *(const v4u*)(QK + ro + 512 + h * 64 + qc * 8);
#pragma unroll
            for (int x = 0; x < 2; ++x) pv[x] = *(const v4u*)(VV + (size_t)seq_row(b, dir, ls + 32 * x) * D + h * 128 + lc * 8);
            if (tid < 64) { const float* gr = Gt + (size_t)seq_row(b, dir, tid) * 32; pgi = gr[ci]; pgf = gr[cf]; } }
        __syncthreads();
#define ML_S0() do { \
            *(LAS v4u*)(Qt + qs * SA + qc * 16) = pq; *(LAS v4u*)(Kt + qs * SA + qc * 16) = pk; \
            _Pragma("unroll") for (int x = 0; x < 2; ++x) *(LAS v4u*)(VT + (ls + 32 * x) * SV + lc * 16) = pv[x]; \
            if (w == 0) { \
                float np[8]; \
                _Pragma("unroll") for (int o = 0; o < 8; ++o) np[o] = NP[o * 64 + lane]; \
                const float nold = vN[lane]; \
                const float bb = wave_incl_sum(pgf); \
                const float aa = pgi - bb; const float cm = wave_incl_max(aa); \
                const float M = fmaxf(m0, cm), M63 = __shfl(M, 63), bend = __shfl(bb, 63); \
                vA[lane] = aa; vM[lane] = M; vWI[lane] = __expf(m0 - M); vEMM[lane] = __expf(-(bb + M)); vWK[lane] = __expf(aa - M63); \
                const float dec = __expf(m0 - M63); \
                if (lane == 0) vSC[0] = dec; \
                vN[lane] = dec_prev * nold + (((np[0] + np[1]) + (np[2] + np[3])) + ((np[4] + np[5]) + (np[6] + np[7]))); \
                dec_prev = dec; m0n = bend + M63; \
            } } while (0)
        ML_S0();
        for (int ch = 0; ch < (CTX + SEQ) / 64; ++ch) {
            __syncthreads();
            if (ch + 1 < (CTX + SEQ) / 64) { const size_t ro = (size_t)seq_row(b, dir, (ch + 1) * 64 + qs) * D; pq = *(const v4u*)(QK + ro + h * 64 + qc * 8); pk = *(const v4u*)(QK + ro + 512 + h * 64 + qc * 8);
#pragma unroll
                for (int x = 0; x < 2; ++x) pv[x] = *(const v4u*)(VV + (size_t)seq_row(b, dir, (ch + 1) * 64 + ls + 32 * x) * D + h * 128 + lc * 8);
                if (tid < 64) { const float* gr = Gt + (size_t)seq_row(b, dir, (ch + 1) * 64 + tid) * 32; pgi = gr[ci]; pgf = gr[cf]; } }
            {
                const v4u kv = *(const LAS v4u*)(Kt + qs * SA + qc * 16); const float wk = vWK[qs];
#pragma unroll
                for (int rep = 0; rep < 2; ++rep) { const int idx = w + 8 * rep; if (idx < 10) { int ti4, si4; tri_tile(idx, ti4, si4);
                    const bf16x8 A0 = *(const LAS bf16x8*)(Qt + (16 * ti4 + fr) * SA + fq * 16), A1 = *(const LAS bf16x8*)(Qt + (16 * ti4 + fr) * SA + fq * 16 + 64);
                    const bf16x8 B0 = *(const LAS bf16x8*)(Kt + (16 * si4 + fr) * SA + fq * 16), B1 = *(const LAS bf16x8*)(Kt + (16 * si4 + fr) * SA + fq * 16 + 64);
                    const int scol = 16 * si4 + fr; const float as = vA[scol]; const f32x4 M4 = *(const LAS f32x4*)(vM + 16 * ti4 + 4 * fq);
                    f32x4 acc = (f32x4){0.f, 0.f, 0.f, 0.f};
                    acc = __builtin_amdgcn_mfma_f32_16x16x32_bf16(A0, B0, acc, 0, 0, 0); acc = __builtin_amdgcn_mfma_f32_16x16x32_bf16(A1, B1, acc, 0, 0, 0);
#pragma unroll
                    for (int r = 0; r < 4; ++r) { const int trow = 16 * ti4 + 4 * fq + r; *(LAS unsigned short*)(SC + trow * SA + scol * 2) = (unsigned short)f2bf(scol <= trow ? acc[r] * __expf(as - M4[r]) : 0.f); } } }
                const unsigned kx[4] = {kv.x, kv.y, kv.z, kv.w}; v4u o; float kf[8];
#pragma unroll
                for (int j = 0; j < 4; ++j) { kf[2 * j] = bf2f(kx[j] & 0xffffu) * wk; kf[2 * j + 1] = bf2f(kx[j] >> 16) * wk; }
                o.x = pk2(kf[0], kf[1]); o.y = pk2(kf[2], kf[3]); o.z = pk2(kf[4], kf[5]); o.w = pk2(kf[6], kf[7]);
                *(LAS v4u*)(KW + qs * SA + qc * 16) = o; }
            __syncthreads();
            f32x16 accA, accB;
            { const v4u sv = *(const LAS v4u*)(SC + qs * SA + qc * 16), qv = *(const LAS v4u*)(Qt + qs * SA + qc * 16); const f32x4 n0 = *(const LAS f32x4*)(vN + 8 * qc), n1 = *(const LAS f32x4*)(vN + 8 * qc + 4);
                const float wi = vWI[qs], emm = vEMM[qs], dec = vSC[0];
                unsigned short kwc[8];
#pragma unroll
                for (int i = 0; i < 8; ++i) kwc[i] = *(const LAS unsigned short*)(KW + (8 * w + i) * SA + lane * 2);
                bf16x8 A[4], Bm[4], A2[4], B2[4];
#pragma unroll
                for (int kk = 0; kk < 4; ++kk) { A[kk] = *(const LAS bf16x8*)(SC + (32 * ti + r32) * SA + hh * 16 + kk * 32); const LAS unsigned char* pb = tV + kk * 16 * SV + ej * 64; const s16x4 x = tr16(pb), y = tr16(pb + 4 * SV); Bm[kk] = (bf16x8){x[0], x[1], x[2], x[3], y[0], y[1], y[2], y[3]}; }
#pragma unroll
                for (int kk = 0; kk < 4; ++kk) { A2[kk] = *(const LAS bf16x8*)(Qt + (32 * ti + r32) * SA + hh * 16 + kk * 32); B2[kk] = *(const LAS bf16x8*)(CT + (32 * ej + r32) * SA + hh * 16 + kk * 32); }
                const unsigned sx[4] = {sv.x, sv.y, sv.z, sv.w}, qx[4] = {qv.x, qv.y, qv.z, qv.w};
                float ssum = 0.f;
#pragma unroll
                for (int j = 0; j < 4; ++j) { ssum += bf2f(sx[j] & 0xffffu) + bf2f(sx[j] >> 16); }
                const float dot = bf2f(qx[0] & 0xffffu) * n0[0] + bf2f(qx[0] >> 16) * n0[1] + bf2f(qx[1] & 0xffffu) * n0[2] + bf2f(qx[1] >> 16) * n0[3]
                    + bf2f(qx[2] & 0xffffu) * n1[0] + bf2f(qx[2] >> 16) * n1[1] + bf2f(qx[3] & 0xffffu) * n1[2] + bf2f(qx[3] >> 16) * n1[3];
                float part = ssum + wi * dot;
                part += __shfl_xor(part, 1); part += __shfl_xor(part, 2); part += __shfl_xor(part, 4);
                if (qc == 0) { const float rinv = 1.0f / fmaxf(fabsf(part), emm); vRI[qs] = rinv; vWIRI[qs] = wi * rinv; }
                { float cs = 0.f;
#pragma unroll
                    for (int i = 0; i < 8; ++i) cs += bf2f(kwc[i]);
                    NP[w * 64 + lane] = cs; }
#pragma unroll
                for (int i = 0; i < 16; ++i) { accA[i] = 0.f; accB[i] = 0.f; }
#pragma unroll
                for (int kk = 0; kk < 4; ++kk) accA = __builtin_amdgcn_mfma_f32_32x32x16_bf16(A[kk], Bm[kk], accA, 0, 0, 0);
#pragma unroll
                for (int kk = 0; kk < 4; ++kk) { const LAS unsigned char* pa = tKW + kk * 16 * SA + di * 64; const s16x4 x = tr16(pa), y = tr16(pa + 4 * SA); A[kk] = (bf16x8){x[0], x[1], x[2], x[3], y[0], y[1], y[2], y[3]}; }
#pragma unroll
                for (int kk = 0; kk < 4; ++kk) accB = __builtin_amdgcn_mfma_f32_32x32x16_bf16(A2[kk], B2[kk], accB, 0, 0, 0);
#pragma unroll
                for (int i = 0; i < 16; ++i) Cs[i] *= dec;
#pragma unroll
                for (int kk = 0; kk < 4; ++kk) Cs = __builtin_amdgcn_mfma_f32_32x32x16_bf16(A[kk], Bm[kk], Cs, 0, 0, 0); }
            __syncthreads();
            { const int ecol = 32 * ej + r32;
                f32x4 ri[4], wr[4];
#pragma unroll
                for (int g = 0; g < 4; ++g) { ri[g] = *(const LAS f32x4*)(vRI + 32 * ti + 8 * g + 4 * hh); wr[g] = *(const LAS f32x4*)(vWIRI + 32 * ti + 8 * g + 4 * hh); }
#pragma unroll
                for (int g = 0; g < 4; ++g) {
#pragma unroll
                    for (int j = 0; j < 4; ++j) { const int trow = 32 * ti + 8 * g + 4 * hh + j; *(LAS unsigned short*)(OST + trow * SO + ecol * 2) = (unsigned short)f2bf(accA[4 * g + j] * ri[g][j] + accB[4 * g + j] * wr[g][j]); }
                    v2u cw; cw.x = pk2(Cs[4 * g], Cs[4 * g + 1]); cw.y = pk2(Cs[4 * g + 2], Cs[4 * g + 3]);
                    *(LAS v2u*)(CT + ecol * SA + (32 * di + 8 * g + 4 * hh) * 2) = cw; }
                m0 = m0n; }
            __syncthreads();
            if (ch + 1 < (CTX + SEQ) / 64) ML_S0();
            if (ch >= CTX / 64) {
#pragma unroll
                for (int x = 0; x < 2; ++x) { const int row = ls + 32 * x; const v4u val = *(const LAS v4u*)(OST + row * SO + lc * 16);
                    *(v4u*)(Hd + (size_t)seq_row(b, dir, ch * 64 + row) * D + h * 128 + lc * 8) = val; } }
        }
#undef ML_S0
        __syncthreads();
    }
}

__device__ __forceinline__ void ph_readout(const bf16* Oa, const bf16* Ob, const bf16* gate, const float* g, int R0, int R1, bf16* Y) {
    const int tid = threadIdx.x, lane = tid & 63, wave = __builtin_amdgcn_readfirstlane(tid >> 6);
    const int gw = blockIdx.x * NWAVES + wave, NGW = gridDim.x * NWAVES;
    f32x4 gg[4];
#pragma unroll
    for (int j4 = 0; j4 < 4; ++j4) gg[j4] = *(const f32x4*)(g + lane * 16 + j4 * 4);
    for (int Rq = R0 + gw; Rq < R1; Rq += 2 * NGW) {
        v4u x[2][2], y[2][2], z[2][2];
#pragma unroll
        for (int u = 0; u < 2; ++u) { const int R = (Rq + u * NGW < R1) ? Rq + u * NGW : Rq; const size_t off = (size_t)R * D + lane * 16;
#pragma unroll
            for (int hh = 0; hh < 2; ++hh) { x[u][hh] = *(const v4u*)(Oa + off + hh * 8); y[u][hh] = *(const v4u*)(Ob + off + hh * 8); z[u][hh] = *(const v4u*)(gate + off + hh * 8); } }
        __builtin_amdgcn_sched_barrier(0);
#pragma unroll
        for (int u = 0; u < 2; ++u) { const int R = Rq + u * NGW; const size_t off = (size_t)R * D + lane * 16;
            float o[16], gt[16]; float ss = 0.f;
#pragma unroll
            for (int hh = 0; hh < 2; ++hh) {
                const unsigned xx[4] = {x[u][hh].x, x[u][hh].y, x[u][hh].z, x[u][hh].w}, yy[4] = {y[u][hh].x, y[u][hh].y, y[u][hh].z, y[u][hh].w}, zz[4] = {z[u][hh].x, z[u][hh].y, z[u][hh].z, z[u][hh].w};
#pragma unroll
                for (int j = 0; j < 4; ++j) { o[hh * 8 + 2 * j] = bf2f(xx[j] & 0xffffu) + bf2f(yy[j] & 0xffffu); o[hh * 8 + 2 * j + 1] = bf2f(xx[j] >> 16) + bf2f(yy[j] >> 16);
                    gt[hh * 8 + 2 * j] = bf2f(zz[j] & 0xffffu); gt[hh * 8 + 2 * j + 1] = bf2f(zz[j] >> 16); } }
#pragma unroll
            for (int j = 0; j < 16; ++j) ss += o[j] * o[j];
            ss += __shfl_xor(ss, 1); ss += __shfl_xor(ss, 2); ss += __shfl_xor(ss, 4);
            const float rs = 1.0f / sqrtf(ss * (1.0f / 128.0f) + EPS);
            float yv[16];
#pragma unroll
            for (int j4 = 0; j4 < 4; ++j4)
#pragma unroll
                for (int j = 0; j < 4; ++j) yv[j4 * 4 + j] = o[j4 * 4 + j] * rs * gg[j4][j] * gt[j4 * 4 + j];
            if (R < R1) { v4u w0, w1; w0.x = pk2(yv[0], yv[1]); w0.y = pk2(yv[2], yv[3]); w0.z = pk2(yv[4], yv[5]); w0.w = pk2(yv[6], yv[7]);
                w1.x = pk2(yv[8], yv[9]); w1.y = pk2(yv[10], yv[11]); w1.z = pk2(yv[12], yv[13]); w1.w = pk2(yv[14], yv[15]);
                *(v4u*)(Y + off) = w0; *(v4u*)(Y + off + 8) = w1; } }
    }
}

struct MoeTab { LAS int* pstart; LAS int* cnt; LAS int* nblk; LAS int* blkE; };
__device__ __forceinline__ MoeTab moe_tab(LAS unsigned char* lds) { MoeTab t; t.pstart = (LAS int*)(lds + LDS_TAB); t.cnt = t.pstart + 36; t.nblk = t.cnt + 32; t.blkE = t.nblk + 4; return t; }
__device__ __forceinline__ void moe_tables(ArgsRef a, int layer, LAS unsigned char* lds) {
    const MoeTab t = moe_tab(lds);
    const unsigned* cnt = (const unsigned*)(a.ws + WS_CTL) + CW_CNT + 64 * layer;
    __syncthreads();
    if (threadIdx.x < 32) t.cnt[threadIdx.x] = (int)__hip_atomic_load(cnt + threadIdx.x, __ATOMIC_RELAXED, __HIP_MEMORY_SCOPE_AGENT);
    __syncthreads();
    if (threadIdx.x < 64) { const int e = threadIdx.x & 31; const int nb = (t.cnt[e] + 255) >> 8; int incl = nb;
#pragma unroll
        for (int o = 1; o < 32; o <<= 1) { const int v = __shfl_up(incl, o, 32); if (e >= o) incl += v; }
        const int p0 = incl - nb;
        if (threadIdx.x < 32) { t.pstart[e] = p0 * 256; for (int j = 0; j < nb; ++j) t.blkE[p0 + j] = e; if (e == 31) { t.pstart[32] = incl * 256; t.nblk[0] = incl; } } }
    __syncthreads();
}

__device__ __forceinline__ void ph_router(ArgsRef a, const bf16* X, const float* g, int layer, int R0, int R1, bf16* Fout, LAS unsigned char* lds) {
    const int tid = threadIdx.x, lane = tid & 63, wave = __builtin_amdgcn_readfirstlane(tid >> 6), G = gridDim.x;
    const int fr = lane & 15, fq = lane >> 4;
    const float* modl = (const float*)(a.ws + WS_SM + SM_MODL) + (size_t)layer * 16 * 6 * D; const float* modc = (const float*)(a.ws + WS_SM + SM_MODC) + (size_t)layer * 6 * D;
    constexpr int APITCH = 2 * D + 16;
    constexpr int PPITCH = 36;
    LAS unsigned char* Ahi = lds; LAS unsigned char* Alo = lds + 16 * APITCH;
    LAS float* P = (LAS float*)(lds + 32 * APITCH);
    LAS int* cntL = (LAS int*)(lds + LDS_TAB);
    LAS int* baseL = cntL + 32;
    LAS int* infoL = baseL + 32;
    int* slot = (int*)(a.ws + WS_SLOT); float* gate = (float*)(a.ws + WS_GATE); int* rte = (int*)(a.ws + WS_RTE);
    unsigned* cntG = (unsigned*)(a.ws + WS_CTL) + CW_CNT + 64 * layer;
    const float* rw = a.in[I_RW] + (size_t)layer * D * NE; const float* rb = a.in[I_RB] + layer * NE;
    bf16x8 Bh[4][2], Bl[4][2];
#pragma unroll
    for (int kk = 0; kk < 4; ++kk)
#pragma unroll
        for (int nt = 0; nt < 2; ++nt) { v4u h, l;
#pragma unroll
            for (int j = 0; j < 4; ++j) { const float* wp = rw + (size_t)(32 * (4 * wave + kk) + 8 * fq + 2 * j) * NE + 16 * nt + fr; const float w0v = wp[0], w1v = wp[NE];
                const unsigned hh = pk2(w0v, w1v); h[j] = hh; l[j] = pk2(w0v - bf2f(hh & 0xffffu), w1v - bf2f(hh >> 16)); }
            Bh[kk][nt] = __builtin_bit_cast(bf16x8, h); Bl[kk][nt] = __builtin_bit_cast(bf16x8, l); }
    if (tid < 32) cntL[tid] = 0;
    const int nrows = R1 - R0, per = (nrows + G - 1) / G;
    const int w0 = R0 + blockIdx.x * per, w1 = (w0 + per < R1) ? w0 + per : R1;
    const int ntile = (w1 > w0) ? (w1 - w0 + 15) >> 4 : 0;
    __syncthreads();
    v2u xq[2][4]; f32x4 shq[2][4], scq[2][4];
    if (ntile > 0) {
#pragma unroll
        for (int rr = 0; rr < 2; ++rr) { const int R = (w0 + 2 * wave + rr < w1) ? w0 + 2 * wave + rr : w1 - 1;
            const float* mod = (R < NTC) ? modc : modl + (size_t)((R - NTC) / SEQ) * 6 * D;
#pragma unroll
            for (int j = 0; j < 4; ++j) { xq[rr][j] = ((const v2u*)(X + (size_t)R * D))[64 * j + lane]; shq[rr][j] = ((const f32x4*)(mod + 3 * D))[64 * j + lane]; scq[rr][j] = ((const f32x4*)(mod + 4 * D))[64 * j + lane]; } }
    }
    for (int ti = 0; ti < ntile; ++ti) {
        const int r = w0 + 16 * ti + 2 * wave;
#pragma unroll
        for (int rr = 0; rr < 2; ++rr) {
            const int R = (r + rr < w1) ? r + rr : w1 - 1;
            f32x4 v[4]; float ss = 0.f;
#pragma unroll
            for (int j = 0; j < 4; ++j) { const v2u xw = xq[rr][j]; v[j] = (f32x4){bf2f(xw.x & 0xffffu), bf2f(xw.x >> 16), bf2f(xw.y & 0xffffu), bf2f(xw.y >> 16)}; ss += (v[j][0] * v[j][0] + v[j][1] * v[j][1]) + (v[j][2] * v[j][2] + v[j][3] * v[j][3]); }
            const float rs = 1.0f / sqrtf(wave_sum(ss) * (1.0f / D) + EPS);
            unsigned* o8 = (unsigned*)((unsigned char*)Fout + (size_t)R * D);
            LAS unsigned char* ah = Ahi + (2 * wave + rr) * APITCH + 8 * lane; LAS unsigned char* al = Alo + (2 * wave + rr) * APITCH + 8 * lane;
#pragma unroll
            for (int j = 0; j < 4; ++j) { const f32x4 f = v[j] * rs * scq[rr][j] + shq[rr][j];
                if (r + rr < w1) o8[64 * j + lane] = pk4_fp8(f[0], f[1], f[2], f[3]);
                const unsigned h0 = pk2(f[0], f[1]), h1 = pk2(f[2], f[3]);
                *(LAS v2u*)(ah + 512 * j) = (v2u){h0, h1};
                *(LAS v2u*)(al + 512 * j) = (v2u){pk2(f[0] - bf2f(h0 & 0xffffu), f[1] - bf2f(h0 >> 16)), pk2(f[2] - bf2f(h1 & 0xffffu), f[3] - bf2f(h1 >> 16))}; }
            if (ti + 1 < ntile) { const int Rn = (r + 16 + rr < w1) ? r + 16 + rr : w1 - 1;
                const float* mod = (Rn < NTC) ? modc : modl + (size_t)((Rn - NTC) / SEQ) * 6 * D;
#pragma unroll
                for (int j = 0; j < 4; ++j) { xq[rr][j] = ((const v2u*)(X + (size_t)Rn * D))[64 * j + lane]; shq[rr][j] = ((const f32x4*)(mod + 3 * D))[64 * j + lane]; scq[rr][j] = ((const f32x4*)(mod + 4 * D))[64 * j + lane]; } }
        }
        __syncthreads();
        f32x4 acc[2] = {(f32x4){0.f, 0.f, 0.f, 0.f}, (f32x4){0.f, 0.f, 0.f, 0.f}};
#pragma unroll
        for (int kk = 0; kk < 4; ++kk) {
            const bf16x8 ahf = *(const LAS bf16x8*)(Ahi + fr * APITCH + 64 * (4 * wave + kk) + 16 * fq);
            const bf16x8 alf = *(const LAS bf16x8*)(Alo + fr * APITCH + 64 * (4 * wave + kk) + 16 * fq);
#pragma unroll
            for (int nt = 0; nt < 2; ++nt) {
                acc[nt] = __builtin_amdgcn_mfma_f32_16x16x32_bf16(alf, Bh[kk][nt], acc[nt], 0, 0, 0);
                acc[nt] = __builtin_amdgcn_mfma_f32_16x16x32_bf16(ahf, Bl[kk][nt], acc[nt], 0, 0, 0);
                acc[nt] = __builtin_amdgcn_mfma_f32_16x16x32_bf16(ahf, Bh[kk][nt], acc[nt], 0, 0, 0); }
        }
#pragma unroll
        for (int nt = 0; nt < 2; ++nt)
#pragma unroll
            for (int i = 0; i < 4; ++i) P[(wave * 16 + 4 * fq + i) * PPITCH + 16 * nt + fr] = acc[nt][i];
        __syncthreads();
        const int ex = lane & 31;
        float val = rb[ex];
#pragma unroll
        for (int w = 0; w < 8; ++w) val += P[(w * 16 + 2 * wave + (lane >> 5)) * PPITCH + ex];
        const unsigned bits = __float_as_uint(val);
        unsigned key = ((bits ^ ((unsigned)((int)bits >> 31) | 0x80000000u)) & ~31u) | (unsigned)(31 - ex);
        int te[4];
#pragma unroll
        for (int k = 0; k < 4; ++k) { unsigned m = key;
            m = max(m, (unsigned)__builtin_amdgcn_update_dpp((int)m, (int)m, 0x128, 0xf, 0xf, false));
            m = max(m, (unsigned)__builtin_amdgcn_update_dpp((int)m, (int)m, 0x124, 0xf, 0xf, false));
            m = max(m, (unsigned)__builtin_amdgcn_update_dpp((int)m, (int)m, 0x122, 0xf, 0xf, false));
            m = max(m, (unsigned)__builtin_amdgcn_update_dpp((int)m, (int)m, 0x121, 0xf, 0xf, false));
            const auto sw = __builtin_amdgcn_permlane16_swap(m, m, false, false); m = max((unsigned)sw[0], (unsigned)sw[1]);
            te[k] = 31 - (int)(m & 31u); if (ex == te[k]) key = 0u; }
        float tv[4];
#pragma unroll
        for (int k = 0; k < 4; ++k) tv[k] = __shfl(val, (lane & 32) | te[k]);
        const float e1 = __expf(tv[1] - tv[0]), e2 = __expf(tv[2] - tv[0]), e3 = __expf(tv[3] - tv[0]); const float inv = 1.0f / (1.0f + e1 + e2 + e3);
        const int R = r + (lane >> 5);
        if (ex < 4 && R < w1) {
            const int es = ex == 0 ? te[0] : ex == 1 ? te[1] : ex == 2 ? te[2] : te[3];
            const float gs = (ex == 0 ? 1.0f : ex == 1 ? e1 : ex == 2 ? e2 : e3) * inv;
            const int lr = __hip_atomic_fetch_add(cntL + es, 1, __ATOMIC_RELAXED, __HIP_MEMORY_SCOPE_WORKGROUP);
            infoL[(R - w0) * 4 + ex] = es | (lr << 8);
            gate[(size_t)R * 4 + ex] = gs;
        }
    }
    __syncthreads();
    if (tid < 32) baseL[tid] = (int)__hip_atomic_fetch_add(cntG + tid, (unsigned)cntL[tid], __ATOMIC_RELAXED, __HIP_MEMORY_SCOPE_AGENT);
    __syncthreads();
    for (int idx = tid; idx < (w1 - w0) * 4; idx += NTHREADS) { const int info = infoL[idx], e = info & 255, rk = baseL[e] + (info >> 8); const int R = w0 + (idx >> 2);
        slot[(size_t)R * 4 + (idx & 3)] = e | (rk << 8); rte[(size_t)e * NT + rk] = R; }
    __syncthreads();
}
constexpr int LDS_TOK = 131072;
__device__ __forceinline__ void moe_tok_table(ArgsRef a, const pg8::MoeOrder& S, LAS unsigned char* lds) {
    const MoeTab t = moe_tab(lds); LAS int* tokL = (LAS int*)(lds + LDS_TOK); const int* rte = (const int*)(a.ws + WS_RTE);
    const int tid = threadIdx.x;
    int val[14]; bool has[14];
#pragma unroll
    for (int q = 0; q < 14; ++q) { const int i = 2 * q + (tid >> 8); pg8::Unit u; has[q] = S.next(i, u); val[q] = 0;
        if (has[q]) { const int dest = u.pm * 256 + (tid & 255), e = t.blkE[u.pm], rk = dest - t.pstart[e];
            if (rk < t.cnt[e]) val[q] = rte[(size_t)e * NT + rk]; } }
#pragma unroll
    for (int q = 0; q < 14; ++q) { const int i = 2 * q + (tid >> 8); if (has[q]) tokL[i * 256 + (tid & 255)] = val[q]; }
    __syncthreads();
}

template <bool FINAL>
__device__ __forceinline__ void ph_combine(ArgsRef a, int layer, const bf16* Xin, const bf16* Ys, int R0, int R1, bf16* Xout, bf16* Hout, float* outF, LAS unsigned char* lds) {
    moe_tables(a, layer, lds); const MoeTab t = moe_tab(lds);
    const int tid = threadIdx.x, lane = tid & 63, wave = __builtin_amdgcn_readfirstlane(tid >> 6);
    const float* modl = (const float*)(a.ws + WS_SM + SM_MODL) + (size_t)layer * 16 * 6 * D; const float* modc = (const float*)(a.ws + WS_SM + SM_MODC) + (size_t)layer * 6 * D;
    const float* modl2 = (const float*)(a.ws + WS_SM + SM_MODL) + (size_t)1 * 16 * 6 * D; const float* modc2 = (const float*)(a.ws + WS_SM + SM_MODC) + (size_t)1 * 6 * D;
    const int* slot = (const int*)(a.ws + WS_SLOT); const float* gate = (const float*)(a.ws + WS_GATE);
    const int gw = blockIdx.x * NWAVES + wave, NGW = gridDim.x * NWAVES;
    for (int Rq = R0 + gw; Rq < R1; Rq += 2 * NGW) {
        unsigned yv[2][4][4]; v2u xv[2][4]; float gk[2][4];
#pragma unroll
        for (int u = 0; u < 2; ++u) { const int R = (Rq + u * NGW < R1) ? Rq + u * NGW : Rq;
#pragma unroll
            for (int k = 0; k < 4; ++k) { const int info = slot[(size_t)R * 4 + k]; gk[u][k] = gate[(size_t)R * 4 + k] * 0.0625f; const int dest = t.pstart[info & 255] + (info >> 8);
                const unsigned* yr = (const unsigned*)((const unsigned char*)Ys + (size_t)dest * D);
#pragma unroll
                for (int j = 0; j < 4; ++j) yv[u][k][j] = yr[64 * j + lane]; }
#pragma unroll
            for (int j = 0; j < 4; ++j) xv[u][j] = ((const v2u*)(Xin + (size_t)R * D))[64 * j + lane]; }
        __builtin_amdgcn_sched_barrier(0);
#pragma unroll
        for (int u = 0; u < 2; ++u) { const int R = Rq + u * NGW;
            const int Rc = (R < R1) ? R : Rq; const bool isctx = Rc < NTC; const int bidx = isctx ? 0 : (Rc - NTC) / SEQ;
            const float* mod = isctx ? modc : modl + (size_t)bidx * 6 * D;
            f32x4 v[4]; float ss = 0.f;
#pragma unroll
            for (int j = 0; j < 4; ++j) { f32x4 m = (f32x4){0.f, 0.f, 0.f, 0.f};
#pragma unroll
                for (int k = 0; k < 4; ++k) { const unsigned w = yv[u][k][j]; const float g = gk[u][k]; const auto lo = __builtin_amdgcn_cvt_pk_f32_fp8((int)w, false), hi = __builtin_amdgcn_cvt_pk_f32_fp8((int)w, true); m[0] += g * lo[0]; m[1] += g * lo[1]; m[2] += g * hi[0]; m[3] += g * hi[1]; }
                const v2u xw = xv[u][j]; const f32x4 xi = (f32x4){bf2f(xw.x & 0xffffu), bf2f(xw.x >> 16), bf2f(xw.y & 0xffffu), bf2f(xw.y >> 16)};
                v[j] = xi + ((const f32x4*)(mod + 5 * D))[64 * j + lane] * m; ss += (v[j][0] * v[j][0] + v[j][1] * v[j][1]) + (v[j][2] * v[j][2] + v[j][3] * v[j][3]); }
            const float rs = 1.0f / sqrtf(wave_sum(ss) * (1.0f / D) + EPS);
            if (R < R1) {
                if (FINAL) {
                    f32x4* o = (f32x4*)(outF + (size_t)(R - NTC) * D);
#pragma unroll
                    for (int j = 0; j < 4; ++j) o[64 * j + lane] = v[j] * rs * ((const f32x4*)a.in[I_FNG])[64 * j + lane];
                } else {
                    const float* mod2 = isctx ? modc2 : modl2 + (size_t)bidx * 6 * D;
                    v2u* xo = (v2u*)(Xout + (size_t)R * D); v2u* o8 = (v2u*)(Hout + (size_t)R * D);
#pragma unroll
                    for (int j = 0; j < 4; ++j) { { v2u xq; xq.x = pk2(v[j][0], v[j][1]); xq.y = pk2(v[j][2], v[j][3]); xo[64 * j + lane] = xq; }
                        const f32x4 sh = ((const f32x4*)(mod2))[64 * j + lane], sc = ((const f32x4*)(mod2 + D))[64 * j + lane];
                        const f32x4 y = v[j] * rs * sc + sh; v2u w; w.x = pk2(y[0], y[1]); w.y = pk2(y[2], y[3]); o8[64 * j + lane] = w; }
                }
            }
        }
    }
}

__device__ __forceinline__ void ph_conv(ArgsRef a, const bf16* QKR, bf16* QK) {
    const int tid = threadIdx.x;
    const float* cw = a.in[I_MLCW]; const float* cb = a.in[I_MLCB];
    const int c8 = (tid & 127) * 8;
    float w[9][8], bb[8];
#pragma unroll
    for (int t = 0; t < 9; ++t)
#pragma unroll
        for (int j = 0; j < 8; ++j) w[t][j] = cw[t * 1024 + c8 + j];
#pragma unroll
    for (int j = 0; j < 8; ++j) bb[j] = cb[c8 + j];
    const float osc = c8 < 512 ? 0.125f : 1.0f;
    constexpr int NLAT = 16 * 32 * 16, NITEM = NLAT + 16 * 64;
    for (int item = blockIdx.x * 4 + (tid >> 7); item < NITEM; item += gridDim.x * 4) {
        const bool isctx = item >= NLAT;
        int y, x0, rowbase, W;
        if (!isctx) { const int b = item >> 9; y = (item >> 4) & 31; x0 = (item & 15) * 4; rowbase = NTC + b * SEQ + y * 64; W = 64; }
        else { const int it2 = item - NLAT; y = 0; x0 = (it2 & 63) * 4; rowbase = (it2 >> 6) * CTX; W = CTX; }
        if (isctx && c8 < 512) {
#pragma unroll
            for (int pp = 0; pp < 4; ++pp) *(v4u*)(QK + (size_t)(rowbase + x0 + pp) * D + c8) = (v4u){0u, 0u, 0u, 0u};
            continue; }
        v4u win[3][6];
#pragma unroll
        for (int ky = 0; ky < 3; ++ky) { const int yy = y + ky - 1; const bool rv = isctx ? (ky == 1) : (yy >= 0 && yy < 32);
            const int yc = isctx ? 0 : (yy < 0 ? 0 : yy > 31 ? 31 : yy); const int rb = rowbase + (isctx ? 0 : (yc - y) * 64);
#pragma unroll
            for (int c = 0; c < 6; ++c) { const int xx = x0 - 1 + c; const int xc = xx < 0 ? 0 : xx >= W ? W - 1 : xx;
                const v4u x = *(const v4u*)(QKR + (size_t)(rb + xc) * D + c8);
                win[ky][c] = (rv && xx >= 0 && xx < W) ? x : (v4u){0u, 0u, 0u, 0u}; } }
        __builtin_amdgcn_sched_barrier(0);
#pragma unroll
        for (int pp = 0; pp < 4; ++pp) {
            float acc[8];
#pragma unroll
            for (int j = 0; j < 8; ++j) acc[j] = bb[j];
#pragma unroll
            for (int ky = 0; ky < 3; ++ky)
#pragma unroll
                for (int kx = 0; kx < 3; ++kx) { const v4u x = win[ky][pp + kx]; const unsigned xs[4] = {x.x, x.y, x.z, x.w};
#pragma unroll
                    for (int j = 0; j < 4; ++j) { acc[2 * j] += w[ky * 3 + kx][2 * j] * bf2f(xs[j] & 0xffffu); acc[2 * j + 1] += w[ky * 3 + kx][2 * j + 1] * bf2f(xs[j] >> 16); } }
            float yv[8];
#pragma unroll
            for (int j = 0; j < 8; ++j) yv[j] = siluf(acc[j]) * osc;
            v4u o; o.x = pk2(yv[0], yv[1]); o.y = pk2(yv[2], yv[3]); o.z = pk2(yv[4], yv[5]); o.w = pk2(yv[6], yv[7]);
            *(v4u*)(QK + (size_t)(rowbase + x0 + pp) * D + c8) = o; }
    }
}


constexpr int N_PHASES = 21;
__global__ void __launch_bounds__(NTHREADS, 2) fwd(Args a_unused) {
    ArgsRef a = *(const volatile __attribute__((address_space(4))) Args*)__builtin_amdgcn_kernarg_segment_ptr();
    extern __shared__ __attribute__((aligned(16))) unsigned char lds_raw[];
    LAS unsigned char* lds = (LAS unsigned char*)lds_raw;
    const int tid = threadIdx.x, G = gridDim.x;
    unsigned char* ws = a.ws;
    if (tid < 16) ((LAS unsigned*)(lds + LDS_MISC))[tid] = 0u;
    __syncthreads();
    XcdBarrier bar; bar.bar = (unsigned*)(ws + WS_CTL) + CW_BAR; bar.x = 0; bar.st = nullptr;
    const int lo = a.ph_lo, hi = a.ph_hi;
    if (hi - lo > 1) bar = xcd_barrier_post((unsigned*)(ws + WS_CTL) + CW_BAR, (volatile LAS unsigned*)(lds + LDS_MISC));
#ifndef PH_MASK
#define PH_MASK 0xFFFFFFFFu
#endif
#define IN(k) (((PH_MASK >> (k)) & 1u) && lo <= (k) && (k) < hi)
#define SEAM(k) do { if (IN(k) && IN((k) + 1)) xcd_barrier(bar); } while (0)

    bf16* ACT = (bf16*)(ws + WS_ACT);
    bf16* X1 = (bf16*)(ws + WS_X1); bf16* X2 = (bf16*)(ws + WS_X2);
    bf16* BIG = (bf16*)(ws + WS_BIG);
    const float* modl = (const float*)(ws + WS_SM + SM_MODL); const float* modc = (const float*)(ws + WS_SM + SM_MODC); const float* oml = (const float*)(ws + WS_SM + SM_OML);
    bf16* XS = BIG; bf16* HM = (bf16*)(ws + WS_BIG + 304 * MiB);

    if (IN(0)) { {  ph_prologue(a, lds);  } } SEAM(0);
    if (IN(1)) { {  ph_modulate(a, a.in[I_CTX], a.in[I_X], a.in[I_NMIXG], 0, 0, 0, NT, ACT);  } } SEAM(1);
    if (IN(2)) { {  pg8::Gemm g{ACT, (const bf16*)(ws + WS_WHGIN), D}; pg8::StaticOrder S; S.init(NT, HG_N, G, (int)blockIdx.x);
        pg8::EpiHgIn E{BIG, (size_t)NT * D, oml, oml + D}; pg8::gemm_phase<pg8::EpiHgIn, pg8::StaticOrder>(lds, g, S, E);
        if (idle_last_round(S)) expert_tiles<1>(a, lds, 2);  } } SEAM(2);
    if (IN(3)) { {  ph_hg_scan(a, lds);
          } } SEAM(3);
    if (IN(4)) { {  ph_readout(BIG + (size_t)5 * NT * D, BIG + (size_t)6 * NT * D, BIG + (size_t)4 * NT * D, a.in[I_HGNG], 0, NT, ACT);  } } SEAM(4);
    if (IN(5)) { {  pg8::Gemm g{ACT, (const bf16*)(ws + WS_WHGOUT), D}; pg8::StaticOrder S; S.init(NT, D, G, (int)blockIdx.x);
        pg8::EpiResid<false> E{a.in[I_CTX], a.in[I_X], X1, modc + 2 * D, modl + 2 * D, 0}; pg8::gemm_phase<pg8::EpiResid<false>, pg8::StaticOrder>(lds, g, S, E);
        if (idle_last_round(S)) expert_tiles<1>(a, lds, 2);  } } SEAM(5);
    if (IN(6)) { {  ph_router(a, X1, a.in[I_NFFNG], 0, 0, NT, ACT, lds);  } } SEAM(6);
    if (IN(8)) { {  moe_tables(a, 0, lds); const MoeTab t = moe_tab(lds);
        pg8::Gemm g{ACT, (const bf16*)(ws + WS_W1), D}; pg8::MoeOrder S{t.nblk[0], 8, G, (int)blockIdx.x, t.blkE}; moe_tok_table(a, S, lds);
        pg8::EpiSwiglu E{HM, a.in[I_B1]}; pg8::gemm_phase<pg8::EpiSwiglu, pg8::MoeOrder, true, true, true, true>(lds, g, S, E, (const LAS int*)(lds + LDS_TOK));
        if (idle_last_round(S)) expert_tiles<1>(a, lds, 1);  } } SEAM(8);
    if (IN(9)) { {  moe_tables(a, 0, lds); const MoeTab t = moe_tab(lds);
        pg8::Gemm g{HM, (const bf16*)(ws + WS_W2), D}; pg8::MoeOrder S{t.nblk[0], 4, G, (int)blockIdx.x, t.blkE};
        pg8::EpiW2 E{XS, a.in[I_B2]}; pg8::gemm_phase<pg8::EpiW2, pg8::MoeOrder, true, true, false, true>(lds, g, S, E);
        if (idle_last_round(S)) expert_tiles<1>(a, lds, 1);  } } SEAM(9);
    if (IN(10)) { {  ph_combine<false>(a, 0, X1, XS, 0, NT, X2, ACT, nullptr, lds);  } } SEAM(10);
    if (IN(11)) { {  pg8::Gemm g{ACT, (const bf16*)(ws + WS_WMLIN), D}; pg8::MlInOrder S; S.init(G, (int)blockIdx.x);
        pg8::EpiMlIn E{BIG, (size_t)NT * D, (float*)(ws + WS_GT), a.in[I_MLBG]}; pg8::gemm_phase<pg8::EpiMlIn, pg8::MlInOrder>(lds, g, S, E);
        expert_tiles<1>(a, lds, 1 << 30);  } } SEAM(11);
    if (IN(12)) { {  ph_conv(a, BIG, BIG + (size_t)3 * NT * D);  } } SEAM(12);
    if (IN(13)) { {  ph_ml_scan(a, lds);  } } SEAM(13);
    if (IN(14)) { {  ph_readout(BIG + (size_t)4 * NT * D, BIG + (size_t)5 * NT * D, BIG + (size_t)2 * NT * D, a.in[I_MLNG], NTC, NT, ACT);  } } SEAM(14);
    if (IN(15)) { {  pg8::Gemm g{ACT + (size_t)NTC * D, (const bf16*)(ws + WS_WMLOUT), D}; pg8::StaticOrder S; S.init(NTL, D, G, (int)blockIdx.x);
        pg8::EpiResid<true> E{X2, X2 + (size_t)NTC * D, X1, modc + 6 * D + 2 * D, modl + (size_t)16 * 6 * D + 2 * D, NTC}; pg8::gemm_phase<pg8::EpiResid<true>, pg8::StaticOrder>(lds, g, S, E);  } } SEAM(15);
    if (IN(16)) { {  ph_router(a, X1, a.in[I_NFFNG] + D, 1, NTC, NT, ACT, lds);  } } SEAM(16);
    if (IN(18)) { {  moe_tables(a, 1, lds); const MoeTab t = moe_tab(lds);
        pg8::Gemm g{ACT, (const bf16*)(ws + WS_W1 + (size_t)32 * 2048 * D), D}; pg8::MoeOrder S{t.nblk[0], 8, G, (int)blockIdx.x, t.blkE}; moe_tok_table(a, S, lds);
        pg8::EpiSwiglu E{HM, a.in[I_B1] + 32 * 2048}; pg8::gemm_phase<pg8::EpiSwiglu, pg8::MoeOrder, true, true, true, true>(lds, g, S, E, (const LAS int*)(lds + LDS_TOK));  } } SEAM(18);
    if (IN(19)) { {  moe_tables(a, 1, lds); const MoeTab t = moe_tab(lds);
        pg8::Gemm g{HM, (const bf16*)(ws + WS_W2 + (size_t)32 * D * D), D}; pg8::MoeOrder S{t.nblk[0], 4, G, (int)blockIdx.x, t.blkE};
        pg8::EpiW2 E{XS, a.in[I_B2] + 32 * D}; pg8::gemm_phase<pg8::EpiW2, pg8::MoeOrder, true, true, false, true>(lds, g, S, E);  } } SEAM(19);
    if (IN(20)) { {  ph_combine<true>(a, 1, X1, XS, NTC, NT, nullptr, nullptr, a.out, lds);  } }
#undef IN
#undef SEAM
}

extern "C" void kernel_launch(void* const* d_in, const int* in_sizes, int n_in, void* d_out, int out_size, void* d_ws, size_t ws_size, hipStream_t stream) {
    static int grid = 0;
    if (grid == 0) {
        if (n_in != 25 || out_size != NTL * D || ws_size < WS_END) { fprintf(stderr, "kernel_launch: unexpected problem (n_in %d, out %d, ws %zu < %zu)\n", n_in, out_size, ws_size, (size_t)WS_END); grid = -1; return; }
        int dev = 0, cus = 0, per_cu = 0;
        if (hipGetDevice(&dev) != hipSuccess || hipDeviceGetAttribute(&cus, hipDeviceAttributeMultiprocessorCount, dev) != hipSuccess) { grid = -1; return; }
        if (hipFuncSetAttribute((const void*)fwd, hipFuncAttributeMaxDynamicSharedMemorySize, LDS_BYTES) != hipSuccess) { fprintf(stderr, "kernel_launch: hipFuncSetAttribute failed\n"); grid = -1; return; }
        if (hipOccupancyMaxActiveBlocksPerMultiprocessor(&per_cu, (const void*)fwd, NTHREADS, LDS_BYTES) != hipSuccess || per_cu < 1) { fprintf(stderr, "kernel_launch: occupancy query says %d blocks per CU\n", per_cu); }
        (void)hipGetLastError();
        grid = cus < 256 ? cus : 256;
    }
    if (grid < 0) return;
    if (hipMemsetAsync((char*)d_ws + WS_CTL, 0, CTL_ZERO_BYTES, stream) != hipSuccess) return;
    Args a{};
    for (int i = 0; i < 25; ++i) a.in[i] = (const float*)d_in[i];
    a.out = (float*)d_out; a.ws = (unsigned char*)d_ws;
#if MK_ONE_LAUNCH
    a.ph_lo = 0; a.ph_hi = N_PHASES;
    hipLaunchKernelGGL(fwd, dim3(grid), dim3(NTHREADS), LDS_BYTES, stream, a);
#else
    for (int p = 0; p < N_PHASES; ++p) { a.ph_lo = p; a.ph_hi = p + 1; hipLaunchKernelGGL(fwd, dim3(grid), dim3(NTHREADS), LDS_BYTES, stream, a); }
#endif
}
```

```cpp
#include <hip/hip_runtime.h>
#include <cstdio>
#include <cstdint>

#ifndef OUTPROJ_FP8
#define OUTPROJ_FP8 1
#endif
#ifndef MK_ONE_LAUNCH
#define MK_ONE_LAUNCH 1
#endif

#define LAS __attribute__((address_space(3)))
#define GAS __attribute__((address_space(1)))
typedef unsigned short bf16;
typedef unsigned v4u __attribute__((ext_vector_type(4)));
typedef unsigned v2u __attribute__((ext_vector_type(2)));
typedef float f32x4 __attribute__((ext_vector_type(4)));
typedef float f32x2 __attribute__((ext_vector_type(2)));
typedef short bf16x8 __attribute__((ext_vector_type(8)));

constexpr int NB = 16, SEQ = 2048, D = 1024, CTX = 256;
constexpr int NTC = NB * CTX, NTL = NB * SEQ, NT = NTC + NTL;
constexpr int NE = 32, TOPK = 4;
constexpr int HG_N = 5 * D;
constexpr int ML_N = 3104, ML_NP = 3328;
constexpr int NPADMAX = 155648;
constexpr float EPS = 1e-6f;
constexpr int NWAVES = 8, NTHREADS = 512;

constexpr size_t MiB = 1u << 20;
constexpr size_t WS_CTL = 0, CTL_ZERO_BYTES = 1 * MiB;
constexpr size_t WS_SM = 1 * MiB;
constexpr size_t SM_MODL = 0, SM_MODC = 786432, SM_OML = 835584;
constexpr size_t WS_SLOT = 2 * MiB;
constexpr size_t WS_GATE = 3 * MiB;
constexpr size_t WS_RTE = 4 * MiB;
constexpr size_t WS_GT = 10 * MiB;
constexpr size_t WS_WHGIN = 16 * MiB, WS_WHGOUT = 26 * MiB, WS_WMLIN = 28 * MiB, WS_WMLOUT = 35 * MiB;
constexpr size_t WS_W1 = 40 * MiB, WS_W2 = 296 * MiB;
constexpr size_t WS_X1 = 424 * MiB, WS_X2 = 568 * MiB, WS_ACT = 712 * MiB, WS_BIG = 784 * MiB;
constexpr size_t T72 = 72 * MiB;
constexpr size_t WS_END = WS_BIG + 608 * MiB;
constexpr int CW_CNT = 1024;
constexpr int CW_TILE = 2048, CW_BAR = 4096;

constexpr int LDS_BYTES = 160 * 1024;
constexpr int LDS_MISC = LDS_BYTES - 4096;
constexpr int LDS_TAB = LDS_MISC + 64;

__device__ __forceinline__ float bf2f(unsigned v) { return __uint_as_float(v << 16); }
typedef __bf16 bf2_t __attribute__((ext_vector_type(2)));
__device__ __forceinline__ unsigned pk2(float lo, float hi) { bf2_t v; v[0] = (__bf16)lo; v[1] = (__bf16)hi; return __builtin_bit_cast(unsigned, v); }
__device__ __forceinline__ unsigned f2bf(float f) { return pk2(f, f) & 0xffffu; }
__device__ __forceinline__ float fexp(float x) { return __builtin_amdgcn_exp2f(x * 1.44269504089f); }
__device__ __forceinline__ float frcp(float x) { return __builtin_amdgcn_rcpf(x); }
__device__ __forceinline__ float siluf(float v) { return v * frcp(1.0f + fexp(-v)); }
#define LDS_WAIT() asm volatile("s_waitcnt lgkmcnt(0)" ::: "memory")
__device__ __forceinline__ unsigned pk4_fp8(float a, float b, float c, float d) { int w = 0; w = __builtin_amdgcn_cvt_pk_fp8_f32(a, b, w, false); w = __builtin_amdgcn_cvt_pk_fp8_f32(c, d, w, true); return (unsigned)w; }
template <int CTRL, int RMASK> __device__ __forceinline__ float dppf(float old, float src) { return __int_as_float(__builtin_amdgcn_update_dpp(__float_as_int(old), __float_as_int(src), CTRL, RMASK, 0xf, false)); }

namespace pg8 {
#define PG8_LAS __attribute__((address_space(3)))
typedef unsigned short bf16_t;
typedef unsigned u32x4 __attribute__((ext_vector_type(4)));
constexpr int BM = 256, BK = 64, HALF = 128, HTB = HALF * BK * 2, STAGE_BYTES = 8 * HTB, NXCD = 8, WGM = 8;
__host__ __device__ __forceinline__ int lds_byte(int r, int c) { const int st = (r >> 4) * 2 + (c >> 5), rr = r & 15, cc = c & 31, ob = rr * 64 + cc * 2; return st * 1024 + (ob ^ (((ob >> 9) & 1) << 5)); }
__host__ __device__ __forceinline__ void stage_rc(int b, int& R, int& C) { const int st = b / 1024, sb = b % 1024, swz = sb ^ (((sb >> 9) & 1) << 5); R = (st >> 1) * 16 + swz / 64; C = (st & 1) * 32 + (swz % 64) / 2; }
__host__ __device__ __forceinline__ int perm32(int rho) { const int n = rho >> 4, i = rho & 15; return 8 * (i >> 2) + 4 * n + (i & 3); }

__device__ __forceinline__ int lane_now() { int l; asm volatile("v_mbcnt_lo_u32_b32 %0, -1, 0\n\tv_mbcnt_hi_u32_b32 %0, -1, %0" : "=v"(l)); return l; }
struct Unit { int pm, pn, bt; };
struct Gemm { const bf16_t* A; const bf16_t* Bt; int K; };

struct StaticOrder {
    int nM, nN, nwg, G, c;
    __device__ void init(int M, int N, int G_, int c_) { nM = M / BM; nN = N / BM; nwg = nM * nN; G = G_; c = c_; }
    __device__ bool next(int i, Unit& u) const {
        const long L = (long)i * G + c; if (L >= nwg) return false;
        int wgid = (int)L; { const int q = nwg / NXCD, r = nwg % NXCD, xcd = wgid % NXCD, off = wgid / NXCD; wgid = (xcd < r ? xcd * (q + 1) : r * (q + 1) + (xcd - r) * q) + off; }
        const int nig = WGM * nN, gid = wgid / nig, fm = gid * WGM, gsz = (nM - fm) < WGM ? (nM - fm) : WGM;
        u.pm = fm + ((wgid % nig) % gsz); u.pn = (wgid % nig) / gsz; u.bt = u.pn; return true;
    }
};
struct MlInOrder {
    StaticOrder lat; int G, c;
    __device__ void init(int G_, int c_) { lat.init(NTL, ML_NP, G_, 0); G = G_; c = c_; }
    __device__ bool next(int i, Unit& u) const {
        const long L = (long)i * G + c;
        if (L < lat.nwg) { StaticOrder t = lat; t.G = 1; t.c = 0; t.next((int)L, u); u.pm += NTC / BM; return true; }
        const int r = (int)(L - lat.nwg); if (r >= 16 * 7) return false;
        const int j = r % 7; u.pm = r / 7; u.pn = j < 2 ? 2 + j : j < 6 ? 2 + j : 12; u.bt = u.pn; return true;
    }
};
struct MoeOrder {
    int nblk, tilesN, G, c; const LAS int* blkE;
    __device__ bool next(int i, Unit& u) const {
        int pm, pn;
        const int J = G / 8;
        if ((G % 8) == 0 && (J % tilesN) == 0) { const int x = c % 8, j = c / 8, RB = J / tilesN; pm = (i * 8 + x) * RB + j / tilesN; pn = j % tilesN; }
        else { const long L = (long)i * G + c; pm = (int)(L / tilesN); pn = (int)(L % tilesN); }
        if (pm >= nblk) return false;
        u.pm = pm; u.pn = pn; u.bt = blkE[pm] * tilesN + pn; return true;
    }
};

__device__ __forceinline__ unsigned cvt_pk_bf16(float lo, float hi) { return pk2(lo, hi); }

__device__ __forceinline__ __attribute__((ext_vector_type(8))) int pk8(bf16x8 lo, bf16x8 hi) { typedef int v4i __attribute__((ext_vector_type(4))); const v4i a = __builtin_bit_cast(v4i, lo), b = __builtin_bit_cast(v4i, hi);
    return (__attribute__((ext_vector_type(8))) int){a[0], a[1], a[2], a[3], b[0], b[1], b[2], b[3]}; }
typedef int v8i_t __attribute__((ext_vector_type(8)));
typedef int v4i_q __attribute__((ext_vector_type(4)));
__device__ __forceinline__ int pg8_x16(int v) { int r; asm volatile("v_xor_b32 %0, 16, %1" : "=v"(r) : "v"(v)); return r; }
__device__ __forceinline__ v8i_t pk8q(v4i_q a, v4i_q b) { return __builtin_shufflevector(a, b, 0, 1, 2, 3, 4, 5, 6, 7); }
template <class Epi, class Sched, bool ALIGN_EPI = true, bool SP2 = true, bool GATHER = false, bool FP8 = false>
__device__ __forceinline__ void gemm_phase(PG8_LAS unsigned char* lds, const Gemm g, const Sched& S, const Epi& E, const PG8_LAS int* tokL = nullptr) {
    const int tid = threadIdx.x, wid = __builtin_amdgcn_readfirstlane(tid >> 6), lane = tid & 63, wr = wid >> 2, wc = wid & 3, fr = lane & 15, fq = lane >> 4;
    const int K = FP8 ? g.K / 2 : g.K, nt = K / BK;
    unsigned voffA[2], voffB[2];
#pragma unroll
    for (int i = 0; i < 2; ++i) { int R, C; stage_rc(tid * 16 + i * 8192, R, C); const int Rb = Epi::PERM ? ((R & ~31) + perm32(R & 31)) : R;
        voffA[i] = (unsigned)(R * K + C) * 2u; voffB[i] = (unsigned)(Rb * K + C) * 2u; }
    unsigned gA[2][2], gU[2][2];
#define PG8_GTOK(dst, uidx) do { const int _t = wid * 64 + lane_now(); _Pragma("unroll") for (int _i = 0; _i < 2; ++_i) { int _R, _C; stage_rc(_t * 16 + _i * 8192, _R, _C); _Pragma("unroll") for (int _h = 0; _h < 2; ++_h) dst[_h][_i] = (unsigned)tokL[(uidx) * 256 + _h * HALF + _R] * (unsigned)(K * 2) + (unsigned)(_C * 2); } } while (0)
    const unsigned kstep = (unsigned)(BK * 2);
    const unsigned hstep = (unsigned)HALF * K * 2;
    const unsigned tstep = 2 * hstep;
    const __amdgpu_buffer_rsrc_t rsA = __builtin_amdgcn_make_buffer_rsrc((void*)g.A, 0, -1, 0x00020000), rsB = __builtin_amdgcn_make_buffer_rsrc((void*)g.Bt, 0, -1, 0x00020000);
    const unsigned ldsw = (unsigned)wid * 1024u;
    const int aoff = FP8 ? (lds_byte(wr * 64 + fr, fq * 16) | ((fq & 1) << 4)) : lds_byte(wr * 64 + fr, fq * 8), boff = FP8 ? (lds_byte(wc * 32 + fr, fq * 16) | ((fq & 1) << 4)) : lds_byte(wc * 32 + fr, fq * 8);
#define aoffH pg8_x16(aoff)
#define boffH pg8_x16(boff)
    constexpr int aoff1 = FP8 ? 16 : 1024, boff1 = FP8 ? 16 : 1024;
#define PG8_SA(b, h) (((b) * 2 + (h)) * HTB)
#define PG8_SB(b, h) ((4 + (b) * 2 + (h)) * HTB)
#define PG8_STAGE_R(bufoff, rs, soff, voff) do { _Pragma("unroll") for (int _i = 0; _i < 2; ++_i) \
        __builtin_amdgcn_raw_ptr_buffer_load_lds(rs, (PG8_LAS void*)(lds + (bufoff) + ldsw + _i * 8192), 16, (int)(voff)[_i], (int)(soff), 0, 0); } while (0)
#define PG8_STAGE_B(bufoff, soff) PG8_STAGE_R(bufoff, rsB, soff, voffB)
#define PG8_STAGE_A1(b, h, ptr) do { if constexpr (GATHER) { PG8_STAGE_R(PG8_SA(b, h), rsA, ptr, gA[h]); } else { PG8_STAGE_R(PG8_SA(b, h), rsA, (ptr) + (h) * hstep, voffA); } } while (0)
#define PG8_STAGE_A2(b, h, ptr) do { if constexpr (GATHER) { PG8_STAGE_R(PG8_SA(b, h), rsA, ptr, gU[h]); } else { PG8_STAGE_R(PG8_SA(b, h), rsA, (ptr) + (h) * hstep, voffA); } } while (0)
#define PG8_LDA(dst, b, h) do { if constexpr (FP8) { _Pragma("unroll") for (int m = 0; m < 4; ++m) dst##8[m] = pk8q(*(const PG8_LAS v4i_q*)(lds + PG8_SA(b, h) + aoff + m * 2048), *(const PG8_LAS v4i_q*)(lds + PG8_SA(b, h) + aoffH + m * 2048)); } else { _Pragma("unroll") for (int m = 0; m < 4; ++m) _Pragma("unroll") for (int k = 0; k < 2; ++k) dst[m][k] = *(const PG8_LAS bf16x8*)(lds + PG8_SA(b, h) + aoff + m * 2048 + k * aoff1); } } while (0)
#define PG8_LDB(dst, b, h) do { if constexpr (FP8) { _Pragma("unroll") for (int n = 0; n < 2; ++n) dst##8[n] = pk8q(*(const PG8_LAS v4i_q*)(lds + PG8_SB(b, h) + boff + n * 2048), *(const PG8_LAS v4i_q*)(lds + PG8_SB(b, h) + boffH + n * 2048)); } else { _Pragma("unroll") for (int n = 0; n < 2; ++n) _Pragma("unroll") for (int k = 0; k < 2; ++k) dst[n][k] = *(const PG8_LAS bf16x8*)(lds + PG8_SB(b, h) + boff + n * 2048 + k * boff1); } } while (0)
#define PG8_MMA(ai, bj, At, Bt) do { __builtin_amdgcn_s_setprio(1); if constexpr (FP8) { _Pragma("unroll") for (int m = 0; m < 4; ++m) _Pragma("unroll") for (int n = 0; n < 2; ++n) \
        acc[ai][bj][m][n] = __builtin_amdgcn_mfma_scale_f32_16x16x128_f8f6f4(Bt##8[n], At##8[m], acc[ai][bj][m][n], 0, 0, 0, 0, 0, 0); } \
        else { _Pragma("unroll") for (int m = 0; m < 4; ++m) _Pragma("unroll") for (int n = 0; n < 2; ++n) _Pragma("unroll") for (int k = 0; k < 2; ++k) \
        acc[ai][bj][m][n] = __builtin_amdgcn_mfma_f32_16x16x32_bf16(Bt[n][k], At[m][k], acc[ai][bj][m][n], 0, 0, 0); } __builtin_amdgcn_s_setprio(0); } while (0)
#define PG8_WAIT_V(n) asm volatile("s_waitcnt vmcnt(" #n ")" ::: "memory")
#define PG8_WAIT_L(n) asm volatile("s_waitcnt lgkmcnt(" #n ")" ::: "memory")
#define PG8_BAR __builtin_amdgcn_s_barrier()
#define PG8_SCHED __builtin_amdgcn_sched_barrier(0)
    Unit cur, nxt; int ui = 0;
    if (!S.next(0, cur)) return;
    f32x4 acc[2][2][4][2];
#pragma unroll
    for (int a = 0; a < 2; ++a)
#pragma unroll
        for (int b = 0; b < 2; ++b)
#pragma unroll
            for (int m = 0; m < 4; ++m)
#pragma unroll
                for (int n = 0; n < 2; ++n) acc[a][b][m][n] = (f32x4){0.f, 0.f, 0.f, 0.f};
    bf16x8 At[4][2], B0[2][2], B1[2][2]; v8i_t At8[4], B08[2], B18[2];
    unsigned cA = GATHER ? 0u : (unsigned)cur.pm * tstep, cB = (unsigned)cur.bt * tstep;
    if constexpr (GATHER) { PG8_GTOK(gA, 0); }
    if constexpr (SP2) {
        PG8_STAGE_B(PG8_SB(0, 0), cB); PG8_STAGE_B(PG8_SB(0, 1), cB + hstep); PG8_STAGE_A1(0, 0, cA); PG8_STAGE_A1(0, 1, cA);
        if (wr == 1) PG8_BAR;
        PG8_WAIT_V(2); PG8_BAR;
        PG8_STAGE_B(PG8_SB(1, 0), cB + kstep); PG8_STAGE_A1(1, 0, cA + kstep); PG8_STAGE_B(PG8_SB(1, 1), cB + hstep + kstep);
        PG8_WAIT_V(6); PG8_BAR;
    } else {
        static_assert(SP2 || !GATHER, "gathered A rows: SP2 loop only");
        PG8_STAGE_B(PG8_SB(0, 0), cB); PG8_STAGE_R(PG8_SA(0, 0), rsA, cA, voffA); PG8_STAGE_B(PG8_SB(0, 1), cB + hstep); PG8_STAGE_R(PG8_SA(0, 1), rsA, cA + hstep, voffA);
        if (wr == 1) PG8_BAR;
        PG8_WAIT_V(4); PG8_BAR;
        PG8_STAGE_B(PG8_SB(1, 0), cB + kstep); PG8_STAGE_R(PG8_SA(1, 0), rsA, cA + kstep, voffA); PG8_STAGE_B(PG8_SB(1, 1), cB + hstep + kstep);
        PG8_WAIT_V(6); PG8_BAR;
    }
    for (;;) {
        const bool has_next = S.next(ui + 1, nxt);
        const unsigned nA = GATHER ? cA : (has_next ? (unsigned)nxt.pm * tstep : cA), nB = has_next ? (unsigned)nxt.bt * tstep : cB;
#pragma unroll 1
        for (int t = 0; t < nt; t += 2) {
            const bool last = (t == nt - 2);
            if constexpr (GATHER) {
#pragma unroll
                for (int _h = 0; _h < 2; ++_h)
#pragma unroll
                    for (int _i = 0; _i < 2; ++_i) gU[_h][_i] = gA[_h][_i];
                if (last && has_next) { PG8_GTOK(gU, ui + 1); } }

            const unsigned a1 = cA + (unsigned)(t + 1) * kstep;
            const unsigned a2 = last ? nA : cA + (unsigned)(t + 2) * kstep, b2 = last ? nB : cB + (unsigned)(t + 2) * kstep;
            const unsigned a3 = a2 + kstep, b3 = b2 + kstep;
            if constexpr (SP2) {
            PG8_LDB(B0, 0, 0); PG8_LDB(B1, 0, 1); PG8_SCHED; PG8_LDA(At, 0, 0); PG8_STAGE_A1(1, 1, a1);
            PG8_WAIT_V(8); PG8_WAIT_L(0); PG8_BAR; PG8_MMA(0, 0, At, B0); PG8_MMA(0, 1, At, B1); PG8_BAR; PG8_SCHED;
            PG8_LDA(At, 0, 1); PG8_STAGE_B(PG8_SB(0, 0), b2); PG8_STAGE_B(PG8_SB(0, 1), b2 + hstep); PG8_STAGE_A2(0, 0, a2);
            PG8_WAIT_V(8); PG8_WAIT_L(0); PG8_BAR; PG8_MMA(1, 0, At, B0); PG8_MMA(1, 1, At, B1); PG8_BAR; PG8_SCHED;
            PG8_LDB(B0, 1, 0); PG8_LDB(B1, 1, 1); PG8_SCHED; PG8_LDA(At, 1, 0); PG8_STAGE_A2(0, 1, a2);
            PG8_WAIT_V(8); PG8_WAIT_L(0); PG8_BAR; PG8_MMA(0, 0, At, B0); PG8_MMA(0, 1, At, B1); PG8_BAR; PG8_SCHED;
            PG8_LDA(At, 1, 1); PG8_STAGE_B(PG8_SB(1, 0), b3); PG8_STAGE_B(PG8_SB(1, 1), b3 + hstep); PG8_STAGE_A2(1, 0, a3);
            PG8_WAIT_V(8); PG8_WAIT_L(0); PG8_BAR; PG8_MMA(1, 0, At, B0); PG8_MMA(1, 1, At, B1); PG8_BAR; PG8_SCHED;
            } else {
            PG8_LDB(B0, 0, 0); PG8_SCHED; PG8_LDA(At, 0, 0); PG8_STAGE_R(PG8_SA(1, 1), rsA, a1 + hstep, voffA);
            PG8_WAIT_L(8); PG8_BAR; PG8_WAIT_L(0); PG8_MMA(0, 0, At, B0); PG8_BAR; PG8_SCHED;
            PG8_LDB(B1, 0, 1); PG8_STAGE_B(PG8_SB(0, 0), b2);
            PG8_BAR; PG8_WAIT_L(0); PG8_MMA(0, 1, At, B1); PG8_BAR;
            PG8_LDA(At, 0, 1); PG8_STAGE_R(PG8_SA(0, 0), rsA, a2, voffA);
            PG8_BAR; PG8_WAIT_L(0); PG8_MMA(1, 0, At, B0); PG8_BAR; PG8_SCHED;
            PG8_STAGE_B(PG8_SB(0, 1), b2 + hstep);
            PG8_WAIT_V(6); PG8_BAR; PG8_MMA(1, 1, At, B1); PG8_BAR;
            PG8_LDB(B0, 1, 0); PG8_SCHED; PG8_LDA(At, 1, 0); PG8_STAGE_R(PG8_SA(0, 1), rsA, a2 + hstep, voffA);
            PG8_WAIT_L(8); PG8_BAR; PG8_WAIT_L(0); PG8_MMA(0, 0, At, B0); PG8_BAR; PG8_SCHED;
            PG8_LDB(B1, 1, 1); PG8_STAGE_B(PG8_SB(1, 0), b3);
            PG8_BAR; PG8_WAIT_L(0); PG8_MMA(0, 1, At, B1); PG8_BAR;
            PG8_LDA(At, 1, 1); PG8_STAGE_R(PG8_SA(1, 0), rsA, a3, voffA);
            PG8_BAR; PG8_WAIT_L(0); PG8_MMA(1, 0, At, B0); PG8_BAR; PG8_SCHED;
            PG8_STAGE_B(PG8_SB(1, 1), b3 + hstep);
            PG8_WAIT_V(6); PG8_BAR; PG8_MMA(1, 1, At, B1); PG8_BAR;
            }
        }
        if constexpr (ALIGN_EPI) { if (wr == 0) PG8_BAR; }
        E(acc, cur, wr, wc, fr, fq);
        if (!has_next) break;
#pragma unroll
        for (int a = 0; a < 2; ++a)
#pragma unroll
            for (int b = 0; b < 2; ++b)
#pragma unroll
                for (int m = 0; m < 4; ++m)
#pragma unroll
                    for (int n = 0; n < 2; ++n) { f32x2 z0, z1; asm volatile("v_mov_b64 %0, 0\n\tv_mov_b64 %1, 0" : "=v"(z0), "=v"(z1)); acc[a][b][m][n] = (f32x4){z0[0], z0[1], z1[0], z1[1]}; }
        cur = nxt; cA = nA; cB = nB; ++ui;
        if constexpr (GATHER) { PG8_GTOK(gA, ui); }
        if constexpr (ALIGN_EPI) { if (wr == 1) PG8_BAR; }
    }
    PG8_WAIT_V(0);
    if constexpr (!ALIGN_EPI) { if (wr == 0) PG8_BAR; }
    PG8_BAR;
#undef PG8_SA
#undef PG8_SB
#undef PG8_STAGE_R
#undef PG8_STAGE_B
#undef PG8_LDA
#undef PG8_STAGE_A1
#undef PG8_STAGE_A2
#undef PG8_GTOK
#undef PG8_LDB
#undef PG8_MMA
#undef PG8_WAIT_V
#undef PG8_WAIT_L
#undef PG8_BAR
#undef PG8_SCHED
}

struct EpiHgIn {
    static constexpr bool PERM = true;
    bf16_t* out0; size_t seg_stride; const float* omlF; const float* omlB;
    __device__ __forceinline__ void operator()(const f32x4 (&acc)[2][2][4][2], const Unit& u, int wr, int wc, int fr, int fq) const {
        const int seg = u.pn >> 2, colt = (u.pn & 3) * BM;
        bf16_t* base = out0 + (size_t)seg * seg_stride;
        const int row0 = u.pm * BM + wr * 64 + fr, col0 = colt + wc * 32 + 8 * fq;
        f32x4 ov[2][2];
        const float* oml = (seg == 2) ? omlF : omlB;
#pragma unroll
        for (int bj = 0; bj < 2; ++bj)
#pragma unroll
            for (int n = 0; n < 2; ++n) ov[bj][n] = (seg == 2 || seg == 3) ? *(const f32x4*)(oml + col0 + bj * HALF + 4 * n) : (f32x4){1.f, 1.f, 1.f, 1.f};
        auto body = [&](auto act) {
#pragma unroll
            for (int ai = 0; ai < 2; ++ai)
#pragma unroll
                for (int m = 0; m < 4; ++m) { bf16_t* rowp = base + (size_t)(row0 + ai * HALF + m * 16) * D + col0;
#pragma unroll
                    for (int bj = 0; bj < 2; ++bj) { f32x4 v[2] = {acc[ai][bj][m][0], acc[ai][bj][m][1]};
#pragma unroll
                        for (int n = 0; n < 2; ++n)
#pragma unroll
                            for (int j = 0; j < 4; ++j) v[n][j] = act(v[n][j], ov[bj][n][j]);
                        u32x4 w; w.x = cvt_pk_bf16(v[0][0], v[0][1]); w.y = cvt_pk_bf16(v[0][2], v[0][3]); w.z = cvt_pk_bf16(v[1][0], v[1][1]); w.w = cvt_pk_bf16(v[1][2], v[1][3]);
                        *(u32x4*)(rowp + bj * HALF) = w; } } };
        if (seg == 0 || seg == 4) body([](float x, float) { return siluf(x); });
        else if (seg == 1) body([](float x, float) { return x; });
        else body([](float x, float o) { return o * frcp(1.0f + fexp(x)); });
    }
};
struct EpiMlIn {
    static constexpr bool PERM = true;
    bf16_t* out0; size_t seg_stride; float* gt; const float* bgate;
    __device__ __forceinline__ void operator()(const f32x4 (&acc)[2][2][4][2], const Unit& u, int wr, int wc, int fr, int fq) const {
        const int seg = u.pn >> 2, colt = (u.pn & 3) * BM;
        const int row0 = u.pm * BM + wr * 64 + fr, col0 = colt + wc * 32 + 8 * fq;
        if (seg == 3) {
            if (wc == 0) {
                const f32x4 b0 = *(const f32x4*)(bgate + 8 * fq), b1 = *(const f32x4*)(bgate + 8 * fq + 4);
#pragma unroll
                for (int ai = 0; ai < 2; ++ai)
#pragma unroll
                    for (int m = 0; m < 4; ++m) { float* rowp = gt + (size_t)(row0 + ai * HALF + m * 16) * 32 + 8 * fq; f32x4 v[2] = {acc[ai][0][m][0] + b0, acc[ai][0][m][1] + b1};
#pragma unroll
                        for (int n = 0; n < 2; ++n)
#pragma unroll
                            for (int j = 0; j < 4; ++j) { const float y = v[n][j] * (1.0f / 15.0f); float t = 15.0f * (1.0f - 2.0f * frcp(1.0f + fexp(2.0f * y)));
                                if (fq >= 2) t = fminf(t, 0.f) - __logf(1.0f + fexp(-fabsf(t)));
                                v[n][j] = t; }
                        *(f32x4*)(rowp) = v[0]; *(f32x4*)(rowp + 4) = v[1]; }
            }
            return;
        }
        bf16_t* base = out0 + (size_t)seg * seg_stride;
#pragma unroll
        for (int ai = 0; ai < 2; ++ai)
#pragma unroll
            for (int m = 0; m < 4; ++m) { bf16_t* rowp = base + (size_t)(row0 + ai * HALF + m * 16) * D + col0;
#pragma unroll
                for (int bj = 0; bj < 2; ++bj) { f32x4 v[2] = {acc[ai][bj][m][0], acc[ai][bj][m][1]};
                    if (seg == 2) {
#pragma unroll
                        for (int n = 0; n < 2; ++n)
#pragma unroll
                            for (int j = 0; j < 4; ++j) v[n][j] = frcp(1.0f + fexp(-v[n][j])); }
                    u32x4 w; w.x = cvt_pk_bf16(v[0][0], v[0][1]); w.y = cvt_pk_bf16(v[0][2], v[0][3]); w.z = cvt_pk_bf16(v[1][0], v[1][1]); w.w = cvt_pk_bf16(v[1][2], v[1][3]);
                    *(u32x4*)(rowp + bj * HALF) = w; } }
    }
};
template <bool IN_BF16> struct EpiResid {
    static constexpr bool PERM = true;
    const void* in_ctx; const void* in_lat; bf16_t* out; const float* mod_ctx; const float* mod_lat; int row_off; float asc;
    __device__ __forceinline__ void operator()(const f32x4 (&acc)[2][2][4][2], const Unit& u, int wr, int wc, int, int) const {
        const int ln = lane_now(), fr = ln & 15, fq = ln >> 4;
        const int R0 = u.pm * BM + row_off;
        const bool isctx = R0 < NTC;
        const float* mod = isctx ? mod_ctx : mod_lat + (size_t)((R0 - NTC) / SEQ) * (6 * D);
        const size_t inrow0 = isctx ? (size_t)R0 : (size_t)(R0 - NTC);
        const int rl0 = wr * 64 + fr, col0 = u.pn * BM + wc * 32 + 8 * fq;
        const unsigned long long inb = (isctx ? (unsigned long long)in_ctx : (unsigned long long)in_lat) + (unsigned long long)(inrow0 * D) * (IN_BF16 ? 2u : 4u);
        f32x4 mv[2][2];
#pragma unroll
        for (int bj = 0; bj < 2; ++bj)
#pragma unroll
            for (int n = 0; n < 2; ++n) mv[bj][n] = *(const f32x4*)(mod + col0 + bj * HALF + 4 * n) * asc;
#pragma unroll
        for (int ai = 0; ai < 2; ++ai) {
            if constexpr (IN_BF16) {
                u32x4 rb[4][2];
#pragma unroll
                for (int m = 0; m < 4; ++m)
#pragma unroll
                    for (int bj = 0; bj < 2; ++bj) rb[m][bj] = *(const __attribute__((address_space(1))) u32x4*)(inb + ((unsigned long long)(rl0 + ai * HALF + m * 16) * D + col0 + bj * HALF) * 2u);
                __builtin_amdgcn_sched_barrier(0);
#pragma unroll
                for (int m = 0; m < 4; ++m)
#pragma unroll
                    for (int bj = 0; bj < 2; ++bj) { const u32x4 w = rb[m][bj];
                        const f32x4 x0 = (f32x4){__uint_as_float(w.x << 16), __uint_as_float(w.x & 0xffff0000u), __uint_as_float(w.y << 16), __uint_as_float(w.y & 0xffff0000u)};
                        const f32x4 x1 = (f32x4){__uint_as_float(w.z << 16), __uint_as_float(w.z & 0xffff0000u), __uint_as_float(w.w << 16), __uint_as_float(w.w & 0xffff0000u)};
                        const f32x4 v0 = x0 + mv[bj][0] * acc[ai][bj][m][0], v1 = x1 + mv[bj][1] * acc[ai][bj][m][1];
                        u32x4 o; o.x = cvt_pk_bf16(v0[0], v0[1]); o.y = cvt_pk_bf16(v0[2], v0[3]); o.z = cvt_pk_bf16(v1[0], v1[1]); o.w = cvt_pk_bf16(v1[2], v1[3]);
                        *(u32x4*)(out + (size_t)(R0 + rl0 + ai * HALF + m * 16) * D + col0 + bj * HALF) = o; }
            } else {
                f32x4 rf[4][2][2];
#pragma unroll
                for (int m = 0; m < 4; ++m)
#pragma unroll
                    for (int bj = 0; bj < 2; ++bj) { const __attribute__((address_space(1))) f32x4* ip = (const __attribute__((address_space(1))) f32x4*)(inb + ((unsigned long long)(rl0 + ai * HALF + m * 16) * D + col0 + bj * HALF) * 4u); rf[m][bj][0] = ip[0]; rf[m][bj][1] = ip[1]; }
                __builtin_amdgcn_sched_barrier(0);
#pragma unroll
                for (int m = 0; m < 4; ++m)
#pragma unroll
                    for (int bj = 0; bj < 2; ++bj) { const f32x4 v0 = rf[m][bj][0] + mv[bj][0] * acc[ai][bj][m][0], v1 = rf[m][bj][1] + mv[bj][1] * acc[ai][bj][m][1];
                        u32x4 o; o.x = cvt_pk_bf16(v0[0], v0[1]); o.y = cvt_pk_bf16(v0[2], v0[3]); o.z = cvt_pk_bf16(v1[0], v1[1]); o.w = cvt_pk_bf16(v1[2], v1[3]);
                        *(u32x4*)(out + (size_t)(R0 + rl0 + ai * HALF + m * 16) * D + col0 + bj * HALF) = o; }
            }
            __builtin_amdgcn_sched_barrier(0);
        }
    }
};
struct EpiSwiglu {
    static constexpr bool PERM = true;
    bf16_t* H; const float* b1;
    __device__ __forceinline__ void operator()(const f32x4 (&acc)[2][2][4][2], const Unit& u, int wr, int wc, int, int) const {
        const int e = u.bt >> 3; const int ln = lane_now(), fr = ln & 15, fq = ln >> 4;
        const int row0 = u.pm * BM + wr * 64 + fr, col0 = u.pn * HALF + wc * 32 + 8 * fq;
        const float* bb = b1 + (size_t)e * 2048 + col0;
        f32x4 bg[2], bl[2];
#pragma unroll
        for (int n = 0; n < 2; ++n) { bg[n] = *(const f32x4*)(bb + 4 * n); bl[n] = *(const f32x4*)(bb + 1024 + 4 * n) + 1.0f; }
#pragma unroll
        for (int ai = 0; ai < 2; ++ai)
#pragma unroll
            for (int m = 0; m < 4; ++m) { unsigned char* rowp = (unsigned char*)H + (size_t)(row0 + ai * HALF + m * 16) * D + col0;
                f32x2 v[2][2];
#pragma unroll
                for (int n = 0; n < 2; ++n)
#pragma unroll
                    for (int jp = 0; jp < 2; ++jp) {
                        const f32x2 ag = (f32x2){acc[ai][0][m][n][2 * jp], acc[ai][0][m][n][2 * jp + 1]}, al = (f32x2){acc[ai][1][m][n][2 * jp], acc[ai][1][m][n][2 * jp + 1]};
                        const f32x2 g2 = __builtin_elementwise_fma(ag, (f32x2){0.0625f, 0.0625f}, (f32x2){bg[n][2 * jp], bg[n][2 * jp + 1]});
                        const f32x2 l2 = __builtin_elementwise_fma(al, (f32x2){0.0625f, 0.0625f}, (f32x2){bl[n][2 * jp], bl[n][2 * jp + 1]});
                        const f32x2 gl = (f32x2){fminf(g2[0], 7.0f), fminf(g2[1], 7.0f)};
                        const f32x2 lc = (f32x2){__builtin_amdgcn_fmed3f(l2[0], -6.0f, 8.0f), __builtin_amdgcn_fmed3f(l2[1], -6.0f, 8.0f)};
                        const f32x2 t2 = gl * (f32x2){-1.702f * 1.44269504089f, -1.702f * 1.44269504089f};
                        const f32x2 d2 = (f32x2){__builtin_amdgcn_exp2f(t2[0]), __builtin_amdgcn_exp2f(t2[1])} + (f32x2){1.0f, 1.0f};
                        const f32x2 r2 = (f32x2){frcp(d2[0]), frcp(d2[1])};
                        v[n][jp] = (gl * lc) * r2; }
                v2u w; w.x = pk4_fp8(v[0][0][0], v[0][0][1], v[0][1][0], v[0][1][1]); w.y = pk4_fp8(v[1][0][0], v[1][0][1], v[1][1][0], v[1][1][1]);
                *(v2u*)(rowp) = w; }
    }
};
struct EpiW2 {
    static constexpr bool PERM = true;
    bf16_t* Y; const float* b2;
    __device__ __forceinline__ void operator()(const f32x4 (&acc)[2][2][4][2], const Unit& u, int wr, int wc, int fr, int fq) const {
        const int e = u.bt >> 2;
        const int row0 = u.pm * BM + wr * 64 + fr, col0 = u.pn * BM + wc * 32 + 8 * fq;
        const float* bb = b2 + (size_t)e * 1024 + col0;
        f32x4 bv[2][2];
#pragma unroll
        for (int bj = 0; bj < 2; ++bj)
#pragma unroll
            for (int n = 0; n < 2; ++n) bv[bj][n] = *(const f32x4*)(bb + bj * HALF + 4 * n) * 16.0f;
#pragma unroll
        for (int ai = 0; ai < 2; ++ai)
#pragma unroll
            for (int m = 0; m < 4; ++m) { unsigned char* rowp = (unsigned char*)Y + (size_t)(row0 + ai * HALF + m * 16) * D + col0;
#pragma unroll
                for (int bj = 0; bj < 2; ++bj) { f32x4 v0 = acc[ai][bj][m][0] + bv[bj][0], v1 = acc[ai][bj][m][1] + bv[bj][1];
#pragma unroll
                    for (int j = 0; j < 4; ++j) { v0[j] = __builtin_amdgcn_fmed3f(v0[j], -448.0f, 448.0f); v1[j] = __builtin_amdgcn_fmed3f(v1[j], -448.0f, 448.0f); }
                    v2u w; w.x = pk4_fp8(v0[0], v0[1], v0[2], v0[3]); w.y = pk4_fp8(v1[0], v1[1], v1[2], v1[3]);
                    *(v2u*)(rowp + bj * HALF) = w; } }
    }
};
}

#define XB_TMO      128
#define XB_XCNT(j)  (256  + 64 * (j))
#define XB_XSUB(j)  (1280 + 64 * (j))
#define XB_XGEN(j)  (2304 + 64 * (j))
#define XB_TOP      3328
#define XB_TOPGEN   3392
#define XCD_BAR_WORDS 3456
#define XB_SPIN_CAP (1u << 18)
__device__ __forceinline__ unsigned xb_ld(unsigned* p)              { return __hip_atomic_load(p, __ATOMIC_RELAXED, __HIP_MEMORY_SCOPE_AGENT); }
__device__ __forceinline__ unsigned xb_add(unsigned* p, unsigned v) { return __hip_atomic_fetch_add(p, v, __ATOMIC_RELAXED, __HIP_MEMORY_SCOPE_AGENT); }
__device__ __forceinline__ unsigned xb_xcc_id() { return (unsigned)__builtin_amdgcn_s_getreg((3 << 11) | 20) & 0xFu; }
#define XB_SPIN(cond, bar) do { unsigned _sp = 0; while (cond) { __builtin_amdgcn_s_sleep(1); \
    if ((++_sp & 255u) == 0u) { if (xb_ld(&(bar)[XB_TMO])) break; if (_sp > XB_SPIN_CAP) { atomicAdd(&(bar)[XB_TMO], 1u); break; } } } } while (0)
struct XcdBarrier { unsigned* bar; unsigned x; volatile LAS unsigned* st; };
__device__ __forceinline__ XcdBarrier xcd_barrier_post(unsigned* bar, volatile LAS unsigned* st) {
    XcdBarrier b; b.bar = bar; b.x = xb_xcc_id(); b.st = st;
    if (threadIdx.x == 0) (void)xb_add(&bar[XB_XCNT(b.x)], 1u);
    return b;
}
__device__ __forceinline__ void xcd_barrier_complete(unsigned* bar, unsigned x, unsigned& nloc, unsigned& nx) {
    const unsigned G = gridDim.x * gridDim.y * gridDim.z;
    unsigned sum, cnt, mine, sp = 0u;
    for (;;) {
        sum = 0u; cnt = 0u; mine = 0u;
#pragma unroll
        for (unsigned j = 0; j < 16; ++j) { const unsigned c = xb_ld(&bar[XB_XCNT(j)]); sum += c; cnt += (c > 0u) ? 1u : 0u; mine = (j == x) ? c : mine; }
        if (sum == G) break;
        __builtin_amdgcn_s_sleep(1);
        if ((++sp & 255u) == 0u) { if (xb_ld(&bar[XB_TMO])) break; if (sp > XB_SPIN_CAP) { atomicAdd(&bar[XB_TMO], 1u); break; } }
    }
    nloc = mine > 0u ? mine : 1u; nx = cnt > 0u ? cnt : 1u;
}
__device__ __forceinline__ void xcd_barrier(const XcdBarrier& b) {
    asm volatile("s_waitcnt vmcnt(0)" ::: "memory");
    __syncthreads();
    if (threadIdx.x == 0) {
        unsigned* bar = b.bar;
        __builtin_amdgcn_s_waitcnt(0);
        unsigned nloc = b.st[0], nx = b.st[1];
        if (nloc == 0u) { xcd_barrier_complete(bar, b.x, nloc, nx); b.st[0] = nloc; b.st[1] = nx; }
        const unsigned old = xb_add(&bar[XB_XSUB(b.x)], 1u);
        const unsigned gen = old / nloc;
        if (old + 1u == (gen + 1u) * nloc) {
            __builtin_amdgcn_fence(__ATOMIC_RELEASE, "agent");
            asm volatile("s_waitcnt vmcnt(0)" ::: "memory");
            const unsigned og = xb_add(&bar[XB_TOP], 1u);
            const unsigned tg = og / nx;
            if (og + 1u == (tg + 1u) * nx) xb_add(&bar[XB_TOPGEN], 1u);
            else XB_SPIN(xb_ld(&bar[XB_TOPGEN]) == tg, bar);
            __builtin_amdgcn_fence(__ATOMIC_ACQUIRE, "agent");
            xb_add(&bar[XB_XGEN(b.x)], 1u);
            asm volatile("s_waitcnt vmcnt(0)" ::: "memory");
        } else {
            XB_SPIN(xb_ld(&bar[XB_XGEN(b.x)]) == gen, bar);
            __builtin_amdgcn_fence(__ATOMIC_ACQUIRE, "agent");
            asm volatile("s_waitcnt vmcnt(0)" ::: "memory");
        }
    }
    __syncthreads();
}

struct Args { const float* in[25]; float* out; unsigned char* ws; int ph_lo, ph_hi; };
typedef const volatile __attribute__((address_space(4))) Args& ArgsRef;
enum { I_X = 0, I_C, I_CTX, I_CCTX, I_ADAW, I_ADAB, I_NMIXG, I_NFFNG, I_HGWIN, I_HGLB, I_HGNG, I_HGWOUT, I_MLWIN, I_MLBG, I_MLCW, I_MLCB, I_MLNG, I_MLWOUT, I_RW, I_RB, I_W1, I_B1, I_W2, I_B2, I_FNG };

__device__ __forceinline__ float wave_sum(float v) {
#pragma unroll
    for (int o = 1; o < 64; o <<= 1) v += __shfl_xor(v, o);
    return v;
}

struct TItem { const float* W; bf16* WT; int N, drow, k0, n0, f8; };
__device__ __forceinline__ void titem_load(const TItem& t, float (&tv)[32], int lane) {
#pragma unroll
    for (int i = 0; i < 32; ++i) tv[i] = t.W[(size_t)(t.k0 + 2 * i + (lane >> 5)) * t.N + t.n0 + (lane & 31)];
}

template <int LAYER> __device__ __forceinline__ void expert_tiles(ArgsRef a, LAS unsigned char* lds, int max_tiles) {
    const int tid = threadIdx.x, lane = tid & 63, wave = __builtin_amdgcn_readfirstlane(tid >> 6);
    constexpr int TP = 260;
    LAS float* T = (LAS float*)lds;
    const float* W1 = a.in[I_W1] + (size_t)LAYER * 32 * D * 2048; const float* W2 = a.in[I_W2] + (size_t)LAYER * 32 * D * D;
    unsigned char* W1T = a.ws + WS_W1 + (size_t)LAYER * 32 * 2048 * D; unsigned char* W2T = a.ws + WS_W2 + (size_t)LAYER * 32 * D * D;
    constexpr int NT1 = 32 * 64, NL = NT1 + 32 * 32;
    auto tsrc = [&](int t, int& N) -> const float* { if (t < NT1) { const int mat = t >> 6, r = t & 63; N = 2048; return W1 + ((size_t)mat * D + 128 * (r >> 3)) * 2048 + 256 * (r & 7); }
        const int t2 = t - NT1, mat = t2 >> 5, r = t2 & 31; N = D; return W2 + ((size_t)mat * D + 128 * (r >> 2)) * D + 256 * (r & 3); };
    unsigned* tcnt = (unsigned*)(a.ws + WS_CTL) + CW_TILE + LAYER; LAS int* tq = (LAS int*)(lds + LDS_MISC + 16);
    __syncthreads();
    if (tid == 0) { tq[1] = max_tiles >= 1 ? (int)__hip_atomic_fetch_add(tcnt, 1u, __ATOMIC_RELAXED, __HIP_MEMORY_SCOPE_AGENT) : NL;
                    tq[0] = max_tiles >= 2 ? (int)__hip_atomic_fetch_add(tcnt, 1u, __ATOMIC_RELAXED, __HIP_MEMORY_SCOPE_AGENT) : NL; }
    __syncthreads();
    int t = tq[1];
    if (t < NL) {
        f32x4 v[16]; { int N; const float* sp = tsrc(t, N) + (size_t)(16 * wave) * N + 4 * lane;
#pragma unroll
            for (int i = 0; i < 16; ++i) v[i] = *(const f32x4*)(sp + (size_t)i * N); }
        for (int k = 1; ; ++k) {
#pragma unroll
            for (int i = 0; i < 16; ++i) *(LAS f32x4*)(T + (16 * wave + i) * TP + ((4 * lane + 8 * wave) & 255)) = v[i];
            __syncthreads();
            const int tn = tq[(k + 1) & 1]; unsigned tnn = 0u; const bool want = (k + 2 <= max_tiles) && tn < NL;
            if (tid == 0 && want) tnn = __hip_atomic_fetch_add(tcnt, 1u, __ATOMIC_RELAXED, __HIP_MEMORY_SCOPE_AGENT);
            if (tn < NL) { int N2; const float* sp = tsrc(tn, N2) + (size_t)(16 * wave) * N2 + 4 * lane;
#pragma unroll
                for (int i = 0; i < 16; ++i) v[i] = *(const f32x4*)(sp + (size_t)i * N2); }
            __builtin_amdgcn_sched_barrier(0);
            const int ks = lane & 7, nl = lane >> 3;
#pragma unroll
            for (int q = 0; q < 4; ++q) { const int n = 32 * wave + 8 * q + nl; unsigned char* dp;
                if (t < NT1) { const int mat = t >> 6, r = t & 63, ng = 256 * (r & 7) + n, cc = ng & 1023, bj = ng >> 10; dp = W1T + ((size_t)mat * 2048 + 256 * (cc >> 7) + 128 * bj + (cc & 127)) * D + 128 * (r >> 3); }
                else { const int t2 = t - NT1, mat = t2 >> 5, r = t2 & 31; dp = W2T + ((size_t)mat * D + 256 * (r & 3) + n) * D + 128 * (r >> 2); }
                const LAS float* tp = T + (16 * ks) * TP + ((n + 8 * ks) & 255); float x[16];
#pragma unroll
                for (int i = 0; i < 16; ++i) x[i] = 16.f * tp[i * TP];
                v4u o; o.x = pk4_fp8(x[0], x[1], x[2], x[3]); o.y = pk4_fp8(x[4], x[5], x[6], x[7]); o.z = pk4_fp8(x[8], x[9], x[10], x[11]); o.w = pk4_fp8(x[12], x[13], x[14], x[15]);
                *(v4u*)(dp + 16 * ks) = o; }
            if (tid == 0) tq[k & 1] = want ? (int)tnn : NL;
            __syncthreads();
            if (tn >= NL) break;
            t = tn;
        }
    }
}
template <class Sched> __device__ __forceinline__ bool idle_last_round(const Sched& S) { pg8::Unit u; Sched S0 = S; S0.c = 0; int n = 0, n0 = 0; while (S.next(n, u)) ++n; while (S0.next(n0, u)) ++n0; return n < n0; }

__device__ __forceinline__ void ph_prologue(ArgsRef a, LAS unsigned char* lds) {
    const int tid = threadIdx.x, lane = tid & 63, wave = __builtin_amdgcn_readfirstlane(tid >> 6), G = gridDim.x;
    unsigned char* ws = a.ws;
    float* modl = (float*)(ws + WS_SM + SM_MODL); float* modc = (float*)(ws + WS_SM + SM_MODC); float* oml = (float*)(ws + WS_SM + SM_OML);
    {
        LAS float* actT = (LAS float*)lds;
        LAS float* red = (LAS float*)(lds + 81920);
        bool staged = false;
        for (int it = blockIdx.x; it < 192; it += G) {
            if (!staged) {
                { float cv[34];
#pragma unroll
                    for (int i = 0; i < 34; ++i) { const int r = i >> 1, k = tid + 512 * (i & 1); cv[i] = r < 16 ? a.in[I_C][r * 1024 + k] : a.in[I_CCTX][k]; }
#pragma unroll
                    for (int i = 0; i < 34; ++i) { const int r = i >> 1, k = tid + 512 * (i & 1); actT[k * 20 + r] = siluf(cv[i]); } }
                __syncthreads(); staged = true;
            }
            const int layer = it / 96, n0 = (it % 96) * 64;
            const float* W = a.in[I_ADAW] + (size_t)layer * D * 6 * D + n0 + lane;
            float acc[17];
#pragma unroll
            for (int r = 0; r < 17; ++r) acc[r] = 0.f;
#pragma unroll 1
            for (int kb = wave * 128; kb < wave * 128 + 128; kb += 32) {
              float wv[32];
#pragma unroll
              for (int i = 0; i < 32; ++i) wv[i] = W[(size_t)(kb + i) * (6 * D)];
              __builtin_amdgcn_sched_barrier(0);
#pragma unroll
              for (int i = 0; i < 32; ++i) { const int k = kb + i; const float w = wv[i];
                const LAS f32x4* ap = (const LAS f32x4*)(actT + k * 20);
                const f32x4 a0 = ap[0], a1 = ap[1], a2 = ap[2], a3 = ap[3]; const float a16 = actT[k * 20 + 16];
                acc[0] += a0[0] * w; acc[1] += a0[1] * w; acc[2] += a0[2] * w; acc[3] += a0[3] * w;
                acc[4] += a1[0] * w; acc[5] += a1[1] * w; acc[6] += a1[2] * w; acc[7] += a1[3] * w;
                acc[8] += a2[0] * w; acc[9] += a2[1] * w; acc[10] += a2[2] * w; acc[11] += a2[3] * w;
                acc[12] += a3[0] * w; acc[13] += a3[1] * w; acc[14] += a3[2] * w; acc[15] += a3[3] * w;
                acc[16] += a16 * w;
              }
            }
#pragma unroll
            for (int r = 0; r < 17; ++r) red[(wave * 17 + r) * 64 + lane] = acc[r];
            __syncthreads();
            for (int idx = tid; idx < 17 * 64; idx += NTHREADS) { const int r = idx >> 6, l = idx & 63; float s = a.in[I_ADAB][layer * 6 * D + n0 + l];
#pragma unroll
                for (int w = 0; w < 8; ++w) s += red[(w * 17 + r) * 64 + l];
                const int sl = (n0 + l) >> 10, dcol = (n0 + l) & 1023;
                if (sl == 1) s = a.in[I_NMIXG][layer * D + dcol] * (1.0f + s); else if (sl == 4) s = a.in[I_NFFNG][layer * D + dcol] * (1.0f + s);
                if (r < 16) modl[((size_t)layer * 16 + r) * (6 * D) + n0 + l] = s; else modc[(size_t)layer * (6 * D) + n0 + l] = s; }
            __syncthreads();
        }
        __syncthreads();
    }
    {
        const int gt = blockIdx.x * NTHREADS + tid;
        if (gt < 2 * D) { const int dir = gt >> 10, c = gt & 1023; const float* lg = a.in[I_HGLB] + (size_t)dir * 3 * D + c;
            const float l0 = lg[0], l1 = lg[D], l2 = lg[2 * D]; const float mx = fmaxf(l0, fmaxf(l1, l2));
            const float e0 = __expf(l0 - mx), e1 = __expf(l1 - mx), e2 = __expf(l2 - mx);
            oml[gt] = (e1 + e2) / (e0 + e1 + e2); }
    }
    {
        LAS float* scr = (LAS float*)(lds + wave * 16384);
        const int gw = blockIdx.x * NWAVES + wave, NGW = G * NWAVES;
        bf16* WHGIN = (bf16*)(ws + WS_WHGIN); bf16* WHGOUT = (bf16*)(ws + WS_WHGOUT); bf16* WMLIN = (bf16*)(ws + WS_WMLIN); bf16* WMLOUT = (bf16*)(ws + WS_WMLOUT);
        bf16* W1T = (bf16*)(ws + WS_W1); bf16* W2T = (bf16*)(ws + WS_W2);
        constexpr int S0 = 16 * 160, S1 = 16 * 32, S2 = 16 * 97, S3 = 16 * 32, S4 = 64 * 16 * 64, S5 = 64 * 16 * 32;
        constexpr int NITEMS = S0 + S1 + S2 + S3;
        auto decode = [&](int it) -> TItem { int r = it; TItem t;
            if (r < S0) { t.f8 = 0; t.W = a.in[I_HGWIN]; t.N = HG_N; t.WT = WHGIN; t.drow = (r % 160) * 32; t.k0 = (r / 160) * 64; t.n0 = (r % 160) * 32; return t; } r -= S0;
            if (r < S1) { t.f8 = OUTPROJ_FP8; t.W = a.in[I_HGWOUT]; t.N = D; t.WT = WHGOUT; t.drow = (r % 32) * 32; t.k0 = (r / 32) * 64; t.n0 = (r % 32) * 32; return t; } r -= S1;
            if (r < S2) { t.f8 = 0; t.W = a.in[I_MLWIN]; t.N = ML_N; t.WT = WMLIN; t.drow = (r % 97) * 32; t.k0 = (r / 97) * 64; t.n0 = (r % 97) * 32; return t; } r -= S2;
            if (r < S3) { t.f8 = OUTPROJ_FP8; t.W = a.in[I_MLWOUT]; t.N = D; t.WT = WMLOUT; t.drow = (r % 32) * 32; t.k0 = (r / 32) * 64; t.n0 = (r % 32) * 32; return t; } r -= S3;
            if (r < S4) { const int mat = r >> 10, q = r & 1023, nb = q & 63, kb = q >> 6; const int n0 = nb * 32, cc = n0 & 1023, bj = n0 >> 10;
                t.f8 = 1; t.W = a.in[I_W1] + (size_t)mat * D * 2048; t.N = 2048; t.WT = (bf16*)((unsigned char*)W1T + (size_t)mat * 2048 * D); t.drow = 256 * (cc >> 7) + 128 * bj + (cc & 127); t.k0 = kb * 64; t.n0 = n0; return t; } r -= S4;
            { const int mat = r >> 9, q = r & 511, nb = q & 31, kb = q >> 5;
                t.f8 = 1; t.W = a.in[I_W2] + (size_t)mat * D * D; t.N = D; t.WT = (bf16*)((unsigned char*)W2T + (size_t)mat * D * D); t.drow = nb * 32; t.k0 = kb * 64; t.n0 = nb * 32; return t; } };
        float tv[32]; TItem cur = decode(gw < NITEMS ? gw : 0);
        titem_load(cur, tv, lane);
        for (int it = gw; it < NITEMS; it += NGW) {
#pragma unroll
            for (int i = 0; i < 32; ++i) scr[(2 * i + (lane >> 5)) * 33 + (lane & 31)] = tv[i];
            LDS_WAIT(); asm volatile("" ::: "memory");
            const TItem nxt = decode(it + NGW < NITEMS ? it + NGW : it);
            if (it + NGW < NITEMS) titem_load(nxt, tv, lane);
            const int c = lane & 7;
#pragma unroll
            for (int j = 0; j < 4; ++j) { const int n = (lane >> 3) + 8 * j; const LAS float* sp = scr + (8 * c) * 33 + n;
                if (cur.f8) { v2u o8; o8.x = pk4_fp8(16.f * sp[0 * 33], 16.f * sp[1 * 33], 16.f * sp[2 * 33], 16.f * sp[3 * 33]); o8.y = pk4_fp8(16.f * sp[4 * 33], 16.f * sp[5 * 33], 16.f * sp[6 * 33], 16.f * sp[7 * 33]);
                    *(v2u*)((unsigned char*)cur.WT + (size_t)(cur.drow + n) * D + cur.k0 + 8 * c) = o8; }
                else { v4u o; o.x = pk2(sp[0 * 33], sp[1 * 33]); o.y = pk2(sp[2 * 33], sp[3 * 33]); o.z = pk2(sp[4 * 33], sp[5 * 33]); o.w = pk2(sp[6 * 33], sp[7 * 33]);
                    *(v4u*)(cur.WT + (size_t)(cur.drow + n) * D + cur.k0 + 8 * c) = o; } }
            LDS_WAIT(); asm volatile("" ::: "memory");
            cur = nxt;
        }
        for (size_t i = (size_t)blockIdx.x * NTHREADS + tid; i < (size_t)(ML_NP - ML_N) * D / 8; i += (size_t)G * NTHREADS) ((v4u*)(WMLIN + (size_t)ML_N * D))[i] = (v4u){0u, 0u, 0u, 0u};
    }
    expert_tiles<0>(a, lds, 1 << 30);
}

__device__ __forceinline__ void ph_modulate(ArgsRef a, const float* src_ctx, const float* src_lat, const float* g, int layer, int shift_idx, int R0, int R1, bf16* out) {
    const int tid = threadIdx.x, lane = tid & 63, wave = __builtin_amdgcn_readfirstlane(tid >> 6);
    const float* modl = (const float*)(a.ws + WS_SM + SM_MODL) + (size_t)layer * 16 * 6 * D; const float* modc = (const float*)(a.ws + WS_SM + SM_MODC) + (size_t)layer * 6 * D;
    const int gw = blockIdx.x * NWAVES + wave, NGW = gridDim.x * NWAVES;
    for (int Rq = R0 + gw; Rq < R1; Rq += 2 * NGW) {
        f32x4 v[2][4], sh[2][4], sc[2][4];
#pragma unroll
        for (int u = 0; u < 2; ++u) { const int R = (Rq + u * NGW < R1) ? Rq + u * NGW : Rq;
            const bool isctx = R < NTC;
            const float* xr = isctx ? src_ctx + (size_t)R * D : src_lat + (size_t)(R - NTC) * D;
            const float* mod = isctx ? modc : modl + (size_t)((R - NTC) / SEQ) * 6 * D;
#pragma unroll
            for (int j = 0; j < 4; ++j) { v[u][j] = ((const f32x4*)xr)[64 * j + lane]; sh[u][j] = ((const f32x4*)(mod + shift_idx * D))[64 * j + lane]; sc[u][j] = ((const f32x4*)(mod + (shift_idx + 1) * D))[64 * j + lane]; } }
        __builtin_amdgcn_sched_barrier(0);
#pragma unroll
        for (int u = 0; u < 2; ++u) { const int R = Rq + u * NGW;
            float ss = 0.f;
#pragma unroll
            for (int j = 0; j < 4; ++j) ss += (v[u][j][0] * v[u][j][0] + v[u][j][1] * v[u][j][1]) + (v[u][j][2] * v[u][j][2] + v[u][j][3] * v[u][j][3]);
            const float rs = 1.0f / sqrtf(wave_sum(ss) * (1.0f / D) + EPS);
            if (R < R1) { v2u* o8 = (v2u*)(out + (size_t)R * D);
#pragma unroll
                for (int j = 0; j < 4; ++j) { const f32x4 y = v[u][j] * rs * sc[u][j] + sh[u][j];
                    v2u w; w.x = pk2(y[0], y[1]); w.y = pk2(y[2], y[3]); o8[64 * j + lane] = w; } } }
    }
}

__device__ __forceinline__ int seq_row(int b, int dir, int p) {
    if (p < CTX) { const int t = dir ? CTX - 1 - p : p; return b * CTX + t; }
    const int pl = p - CTX; const int t = dir ? SEQ - 1 - pl : pl; return NTC + b * SEQ + t;
}


typedef short s16x4 __attribute__((ext_vector_type(4)));
typedef float f32x16 __attribute__((ext_vector_type(16)));
__device__ __forceinline__ unsigned offb(unsigned row, unsigned ch) { return 256u * row + 16u * (ch ^ (((row & 3u) << 2) | ((row >> 2) & 3u))); }
__device__ __forceinline__ s16x4 tr16(const LAS unsigned char* p) { return __builtin_amdgcn_ds_read_tr16_b64_v4i16((LAS s16x4*)p); }
__device__ __forceinline__ bf16x8 rd_row_b(const LAS unsigned char* tile, int lane, int rb, int kk) { return *(const LAS bf16x8*)(tile + offb(32 * rb + (lane & 31), 2 * kk + (lane >> 5))); }
__device__ __forceinline__ bf16x8 rd_tr_b(const LAS unsigned char* tile, int lane, int c, int ks) {
    const unsigned h = lane >> 5, blk = (lane >> 4) & 1, q = (lane & 15) >> 2, p = lane & 3;
    const s16x4 x = tr16(tile + offb(16 * ks + 8 * h + q, 4 * c + 2 * blk + (p >> 1)) + 8 * (p & 1));
    const s16x4 y = tr16(tile + offb(16 * ks + 8 * h + 4 + q, 4 * c + 2 * blk + (p >> 1)) + 8 * (p & 1));
    return (bf16x8){x[0], x[1], x[2], x[3], y[0], y[1], y[2], y[3]};
}
__device__ __forceinline__ bf16x8 rd_row_p(const LAS unsigned char* tile, int st, int lane, int rb, int kk) { return *(const LAS bf16x8*)(tile + (32 * rb + (lane & 31)) * st + (16 * kk + 8 * (lane >> 5)) * 2); }
__device__ __forceinline__ bf16x8 rd_tr_p(const LAS unsigned char* tile, int st, int lane, int c, int ks) {
    const unsigned h = lane >> 5, blk = (lane >> 4) & 1, q = (lane & 15) >> 2, p = lane & 3;
    const LAS unsigned char* b = tile + (16 * ks + 8 * h + q) * st + (32 * c + 16 * blk + 4 * p) * 2;
    const s16x4 x = tr16(b), y = tr16(b + 4 * st);
    return (bf16x8){x[0], x[1], x[2], x[3], y[0], y[1], y[2], y[3]};
}
__device__ __forceinline__ void tri_tile(int idx, int& ti4, int& si4) {
    ti4 = idx < 1 ? 0 : idx < 3 ? 1 : idx < 6 ? 2 : 3; si4 = idx - (ti4 * (ti4 + 1)) / 2;
}

__device__ __forceinline__ void ph_hg_scan(ArgsRef a, LAS unsigned char* lds) {
    const int tid = threadIdx.x, lane = tid & 63, w = __builtin_amdgcn_readfirstlane(tid >> 6), hh = lane >> 5, r32 = lane & 31;
    const bf16* QS = (const bf16*)(a.ws + WS_BIG); const bf16* VI = QS + (size_t)NT * D; const bf16* KF = VI + (size_t)NT * D; const bf16* KB = KF + (size_t)NT * D;
    bf16* OF = (bf16*)(a.ws + WS_BIG + 5 * T72); bf16* OB = OF + (size_t)NT * D;
    constexpr int SQ = 272, SV = 320, SA = 144;
    constexpr int O_QA = 0, O_KA = 17408, O_V = 34816, O_ST = 55296, O_ATT = 90112, O_OST = 99328, O_TOT = 116736, O_FIRST = 120832, O_EB = 124928, O_EG = 125440;
    LAS unsigned char* QA = lds + O_QA; LAS unsigned char* KA = lds + O_KA; LAS unsigned char* VT = lds + O_V; LAS unsigned char* ST = lds + O_ST;
    LAS unsigned char* ATT = lds + O_ATT; LAS unsigned char* OST = lds + O_OST;
    LAS float* TOT = (LAS float*)(lds + O_TOT); LAS float* FIRST = (LAS float*)(lds + O_FIRST); LAS float* EB = (LAS float*)(lds + O_EB); LAS float* EG = (LAS float*)(lds + O_EG);
    for (int i = tid; i < 64 * SA / 4; i += NTHREADS) ((LAS unsigned*)ATT)[i] = 0u;
    const int ls = tid >> 4, lc = tid & 15;
    const int tq = (lane & 15) >> 2, tp = lane & 3, tblk = (lane >> 4) & 1;
    const LAS unsigned char* rQA = QA + r32 * SQ + hh * 16;
    const LAS unsigned char* rST = ST + r32 * SQ + hh * 16;
    const LAS unsigned char* rATT = ATT + r32 * SA + hh * 16;
    const LAS unsigned char* tV = VT + (8 * hh + tq) * SV + (16 * tblk + 4 * tp) * 2;
    const LAS unsigned char* tK = KA + (8 * hh + tq) * SQ + (16 * tblk + 4 * tp) * 2;
    const int fr = lane & 15, fq = lane >> 4;
    const int ti = w >> 2, ej = w & 3, di = w >> 1, e2 = 2 * (w & 1);
    for (int item = blockIdx.x; item < 256; item += gridDim.x) {
        const int dir = item & 1, h = (item >> 1) & 7, b = item >> 4;
        const bf16* Kd = dir ? KB : KF; bf16* Od = dir ? OB : OF;
        f32x16 S0, S1;
#pragma unroll
        for (int i = 0; i < 16; ++i) { S0[i] = 0.f; S1[i] = 0.f; }
        v4u pq[2], pk[2], pv[2];
#pragma unroll
        for (int x = 0; x < 2; ++x) { const size_t off = (size_t)seq_row(b, dir, ls + 32 * x) * D + h * 128 + lc * 8; pq[x] = *(const v4u*)(QS + off); pk[x] = *(const v4u*)(Kd + off); pv[x] = *(const v4u*)(VI + off); }
#pragma unroll
        for (int x = 0; x < 2; ++x) { *(LAS v4u*)(QA + (ls + 32 * x) * SQ + lc * 16) = pq[x]; *(LAS v4u*)(KA + (ls + 32 * x) * SQ + lc * 16) = pk[x]; *(LAS v4u*)(VT + (ls + 32 * x) * SV + lc * 16) = pv[x]; }
        for (int ch = 0; ch < (CTX + SEQ) / 64; ++ch) {
            __syncthreads();
            if (ch + 1 < (CTX + SEQ) / 64) {
#pragma unroll
                for (int x = 0; x < 2; ++x) { const size_t off = (size_t)seq_row(b, dir, (ch + 1) * 64 + ls + 32 * x) * D + h * 128 + lc * 8; pq[x] = *(const v4u*)(QS + off); pk[x] = *(const v4u*)(Kd + off); pv[x] = *(const v4u*)(VI + off); }
            }
            unsigned kwv[8], qwv[8]; float l0[8], l1[8];
#pragma unroll
            for (int i = 0; i < 8; ++i) { kwv[i] = *(const LAS unsigned*)(KA + (8 * w + i) * SQ + lane * 4); qwv[i] = *(const LAS unsigned*)(QA + (8 * w + i) * SQ + lane * 4); }
            { float r0 = 0.f, r1 = 0.f;
#pragma unroll
                for (int i = 0; i < 8; ++i) { l0[i] = __builtin_amdgcn_logf(fmaxf(1.0f - bf2f(kwv[i] & 0xffffu), 1e-30f)); l1[i] = __builtin_amdgcn_logf(fmaxf(1.0f - bf2f(kwv[i] >> 16), 1e-30f)); r0 += l0[i]; r1 += l1[i]; }
                *(LAS f32x2*)(TOT + w * 128 + 2 * lane) = (f32x2){r0, r1}; *(LAS f32x2*)(FIRST + w * 128 + 2 * lane) = (f32x2){l0[0], l1[0]}; }
            __syncthreads();
            { float p0 = 0.f, p1 = 0.f, br0 = 0.f, br1 = 0.f, be0 = 0.f, be1 = 0.f; f32x2 tt[8];
#pragma unroll
                for (int o = 0; o < 8; ++o) tt[o] = *(const LAS f32x2*)(TOT + o * 128 + 2 * lane);
                const f32x2 ff = *(const LAS f32x2*)(FIRST + 4 * 128 + 2 * lane);
#pragma unroll
                for (int o = 0; o < 8; ++o) { if (o < w) { p0 += tt[o][0]; p1 += tt[o][1]; } if (o < 4) { br0 += tt[o][0]; br1 += tt[o][1]; } be0 += tt[o][0]; be1 += tt[o][1]; }
                br0 += ff[0]; br1 += ff[1];
#pragma unroll
                for (int i = 0; i < 8; ++i) { p0 += l0[i]; p1 += l1[i];
                    const float ea0 = __builtin_amdgcn_exp2f(p0 - br0), ea1 = __builtin_amdgcn_exp2f(p1 - br1), ek0 = __builtin_amdgcn_exp2f(br0 - p0), ek1 = __builtin_amdgcn_exp2f(br1 - p1);
                    *(LAS unsigned*)(QA + (8 * w + i) * SQ + lane * 4) = pk2(bf2f(qwv[i] & 0xffffu) * ea0, bf2f(qwv[i] >> 16) * ea1);
                    *(LAS unsigned*)(KA + (8 * w + i) * SQ + lane * 4) = pk2(bf2f(kwv[i] & 0xffffu) * ek0, bf2f(kwv[i] >> 16) * ek1); }
                if (w == 0) { *(LAS f32x2*)(EB + 2 * lane) = (f32x2){__builtin_amdgcn_exp2f(br0), __builtin_amdgcn_exp2f(br1)}; *(LAS f32x2*)(EG + 2 * lane) = (f32x2){__builtin_amdgcn_exp2f(be0 - br0), __builtin_amdgcn_exp2f(be1 - br1)}; } }
            __syncthreads();
            {
                f32x4 eb[4], eg[4];
#pragma unroll
                for (int g = 0; g < 4; ++g) { eb[g] = *(const LAS f32x4*)(EB + 32 * di + 8 * g + 4 * hh); eg[g] = *(const LAS f32x4*)(EG + 32 * di + 8 * g + 4 * hh); }
                bf16x8 kA[4], vB0[4], vB1[4];
#pragma unroll
                for (int kk = 0; kk < 4; ++kk) { const LAS unsigned char* pa = tK + kk * 16 * SQ + di * 64; const s16x4 x = tr16(pa), y = tr16(pa + 4 * SQ); kA[kk] = (bf16x8){x[0], x[1], x[2], x[3], y[0], y[1], y[2], y[3]}; }
#pragma unroll
                for (int kk = 0; kk < 4; ++kk) { const LAS unsigned char* pb = tV + kk * 16 * SV + e2 * 64; const s16x4 x = tr16(pb), y = tr16(pb + 4 * SV), x2 = tr16(pb + 64), y2 = tr16(pb + 64 + 4 * SV);
                    vB0[kk] = (bf16x8){x[0], x[1], x[2], x[3], y[0], y[1], y[2], y[3]}; vB1[kk] = (bf16x8){x2[0], x2[1], x2[2], x2[3], y2[0], y2[1], y2[2], y2[3]}; }
#pragma unroll
                for (int rep = 0; rep < 2; ++rep) { const int idx = w + 8 * rep; if (idx < 10) { int ti4, si4; tri_tile(idx, ti4, si4);
                    bf16x8 A[4], Bm[4];
#pragma unroll
                    for (int kk = 0; kk < 4; ++kk) { A[kk] = *(const LAS bf16x8*)(QA + (16 * ti4 + fr) * SQ + fq * 16 + kk * 64); Bm[kk] = *(const LAS bf16x8*)(KA + (16 * si4 + fr) * SQ + fq * 16 + kk * 64); }
                    f32x4 acc = (f32x4){0.f, 0.f, 0.f, 0.f};
#pragma unroll
                    for (int kk = 0; kk < 4; ++kk) acc = __builtin_amdgcn_mfma_f32_16x16x32_bf16(A[kk], Bm[kk], acc, 0, 0, 0);
                    const int scol = 16 * si4 + fr;
#pragma unroll
                    for (int r = 0; r < 4; ++r) { const int trow = 16 * ti4 + 4 * fq + r; *(LAS unsigned short*)(ATT + trow * SA + scol * 2) = (unsigned short)f2bf(scol <= trow ? acc[r] : 0.f); } } }
#pragma unroll
                for (int g = 0; g < 4; ++g) {
#pragma unroll
                    for (int j = 0; j < 4; ++j) { S0[4 * g + j] *= eb[g][j]; S1[4 * g + j] *= eb[g][j]; }
                    v2u w0, w1; w0.x = pk2(S0[4 * g], S0[4 * g + 1]); w0.y = pk2(S0[4 * g + 2], S0[4 * g + 3]); w1.x = pk2(S1[4 * g], S1[4 * g + 1]); w1.y = pk2(S1[4 * g + 2], S1[4 * g + 3]);
                    *(LAS v2u*)(ST + (32 * e2 + r32) * SQ + (32 * di + 8 * g + 4 * hh) * 2) = w0; *(LAS v2u*)(ST + (32 * e2 + 32 + r32) * SQ + (32 * di + 8 * g + 4 * hh) * 2) = w1; }
#pragma unroll
                for (int kk = 0; kk < 4; ++kk) { S0 = __builtin_amdgcn_mfma_f32_32x32x16_bf16(kA[kk], vB0[kk], S0, 0, 0, 0); S1 = __builtin_amdgcn_mfma_f32_32x32x16_bf16(kA[kk], vB1[kk], S1, 0, 0, 0); }
#pragma unroll
                for (int g = 0; g < 4; ++g)
#pragma unroll
                    for (int j = 0; j < 4; ++j) { S0[4 * g + j] *= eg[g][j]; S1[4 * g + j] *= eg[g][j]; }
            }
            __syncthreads();
            { f32x16 o;
#pragma unroll
                for (int i = 0; i < 16; ++i) o[i] = 0.f;
                bf16x8 A[4], Bm[4];
#pragma unroll
                for (int kk = 0; kk < 4; ++kk) { A[kk] = *(const LAS bf16x8*)(rATT + ti * 32 * SA + kk * 32); const LAS unsigned char* pb = tV + kk * 16 * SV + ej * 64; const s16x4 x = tr16(pb), y = tr16(pb + 4 * SV); Bm[kk] = (bf16x8){x[0], x[1], x[2], x[3], y[0], y[1], y[2], y[3]}; }
                bf16x8 A2[4], B2[4];
#pragma unroll
                for (int kk = 0; kk < 4; ++kk) { A2[kk] = *(const LAS bf16x8*)(rQA + ti * 32 * SQ + kk * 32); B2[kk] = *(const LAS bf16x8*)(rST + ej * 32 * SQ + kk * 32); }
#pragma unroll
                for (int kk = 0; kk < 4; ++kk) o = __builtin_amdgcn_mfma_f32_32x32x16_bf16(A[kk], Bm[kk], o, 0, 0, 0);
#pragma unroll
                for (int kk = 0; kk < 4; ++kk) { A[kk] = *(const LAS bf16x8*)(rQA + ti * 32 * SQ + (kk + 4) * 32); Bm[kk] = *(const LAS bf16x8*)(rST + ej * 32 * SQ + (kk + 4) * 32); }
#pragma unroll
                for (int kk = 0; kk < 4; ++kk) o = __builtin_amdgcn_mfma_f32_32x32x16_bf16(A2[kk], B2[kk], o, 0, 0, 0);
#pragma unroll
                for (int kk = 0; kk < 4; ++kk) o = __builtin_amdgcn_mfma_f32_32x32x16_bf16(A[kk], Bm[kk], o, 0, 0, 0);
                const int ecol = 32 * ej + r32;
#pragma unroll
                for (int r = 0; r < 16; ++r) { const int trow = 32 * ti + (r & 3) + 8 * (r >> 2) + 4 * hh; *(LAS unsigned short*)(OST + trow * SQ + ecol * 2) = (unsigned short)f2bf(o[r]); } }
            __syncthreads();
            if (ch + 1 < (CTX + SEQ) / 64) {
#pragma unroll
                for (int x = 0; x < 2; ++x) { *(LAS v4u*)(QA + (ls + 32 * x) * SQ + lc * 16) = pq[x]; *(LAS v4u*)(KA + (ls + 32 * x) * SQ + lc * 16) = pk[x]; *(LAS v4u*)(VT + (ls + 32 * x) * SV + lc * 16) = pv[x]; } }
#pragma unroll
            for (int x = 0; x < 2; ++x) { const int row = ls + 32 * x; const v4u val = *(const LAS v4u*)(OST + row * SQ + lc * 16);
                *(v4u*)(Od + (size_t)seq_row(b, dir, ch * 64 + row) * D + h * 128 + lc * 8) = val; }
        }
        __syncthreads();
    }
}


__device__ __forceinline__ float wave_incl_sum(float v) {
    v += dppf<0x111, 0xf>(0.f, v); v += dppf<0x112, 0xf>(0.f, v); v += dppf<0x114, 0xf>(0.f, v); v += dppf<0x118, 0xf>(0.f, v);
    v += dppf<0x142, 0xa>(0.f, v); v += dppf<0x143, 0xc>(0.f, v); return v;
}
__device__ __forceinline__ float wave_incl_max(float v) {
    const float ninf = -3.0e38f;
    v = fmaxf(v, dppf<0x111, 0xf>(ninf, v)); v = fmaxf(v, dppf<0x112, 0xf>(ninf, v)); v = fmaxf(v, dppf<0x114, 0xf>(ninf, v)); v = fmaxf(v, dppf<0x118, 0xf>(ninf, v));
    v = fmaxf(v, dppf<0x142, 0xa>(ninf, v)); v = fmaxf(v, dppf<0x143, 0xc>(ninf, v)); return v;
}
__device__ __forceinline__ void ph_ml_scan(ArgsRef a, LAS unsigned char* lds) {
    const int tid = threadIdx.x, lane = tid & 63, w = __builtin_amdgcn_readfirstlane(tid >> 6), hh = lane >> 5, r32 = lane & 31;
    const bf16* QK = (const bf16*)(a.ws + WS_BIG + 3 * T72); const bf16* VV = (const bf16*)(a.ws + WS_BIG + 1 * T72);
    bf16* HF = (bf16*)(a.ws + WS_BIG + 4 * T72); bf16* HB = (bf16*)(a.ws + WS_BIG + 5 * T72);
    const float* Gt = (const float*)(a.ws + WS_GT);
    constexpr int SA = 144, SO = 272, SV = 320;
    constexpr int O_Q = 0, O_K = 9216, O_KW = 18432, O_SC = 27648, O_V = 36864, O_CT = 57344, O_OST = 75776, O_VEC = 93184, O_NP = 95488;
    LAS unsigned char* Qt = lds + O_Q; LAS unsigned char* Kt = lds + O_K; LAS unsigned char* KW = lds + O_KW; LAS unsigned char* SC = lds + O_SC;
    LAS unsigned char* VT = lds + O_V; LAS unsigned char* CT = lds + O_CT; LAS unsigned char* OST = lds + O_OST;
    LAS float* vA = (LAS float*)(lds + O_VEC); LAS float* vM = vA + 64; LAS float* vWI = vM + 64; LAS float* vEMM = vWI + 64; LAS float* vWK = vEMM + 64;
    LAS float* vRI = vWK + 64; LAS float* vWIRI = vRI + 64; LAS float* vN = vWIRI + 64; LAS float* vSC = vN + 64;
    LAS float* NP = (LAS float*)(lds + O_NP);
    for (int i = tid; i < 64 * SA / 4; i += NTHREADS) ((LAS unsigned*)SC)[i] = 0u;
    const int ls = tid >> 4, lc = tid & 15;
    const int qs = tid >> 3, qc = tid & 7;
    const int tq = (lane & 15) >> 2, tp = lane & 3, tblk = (lane >> 4) & 1;
    const LAS unsigned char* tV = VT + (8 * hh + tq) * SV + (16 * tblk + 4 * tp) * 2;
    const LAS unsigned char* tKW = KW + (8 * hh + tq) * SA + (16 * tblk + 4 * tp) * 2;
    const int fr = lane & 15, fq = lane >> 4;
    const int ti = w >> 2, ej = w & 3, di = w >> 2;
    for (int item = blockIdx.x; item < 256; item += gridDim.x) {
        const int dir = item & 1, h = (item >> 1) & 7, b = item >> 4;
        bf16* Hd = dir ? HB : HF;
        const int ci = dir * 8 + h, cf = 16 + dir * 8 + h;
        f32x16 Cs;
#pragma unroll
        for (int i = 0; i < 16; ++i) Cs[i] = 0.f;
        for (int i = tid; i < 128 * SA / 4; i += NTHREADS) ((LAS unsigned*)CT)[i] = 0u;
        if (tid < 64) vN[tid] = 0.f;
        NP[tid] = 0.f;
        float m0 = 0.f, m0n = 0.f, dec_prev = 0.f;
        v4u pq, pk, pv[2]; float pgi = 0.f, pgf = 0.f;
        { const size_t ro = (size_t)seq_row(b, dir, qs) * D; pq = *(const v4u*)(QK + ro + h * 64 + qc * 8); pk = *(const v4u*)(QK + ro + 512 + h * 64 + qc * 8);
#pragma unroll
            for (int x = 0; x < 2; ++x) pv[x] = *(const v4u*)(VV + (size_t)seq_row(b, dir, ls + 32 * x) * D + h * 128 + lc * 8);
            if (tid < 64) { const float* gr = Gt + (size_t)seq_row(b, dir, tid) * 32; pgi = gr[ci]; pgf = gr[cf]; } }
        __syncthreads();
#define ML_S0() do { \
            *(LAS v4u*)(Qt + qs * SA + qc * 16) = pq; *(LAS v4u*)(Kt + qs * SA + qc * 16) = pk; \
            _Pragma("unroll") for (int x = 0; x < 2; ++x) *(LAS v4u*)(VT + (ls + 32 * x) * SV + lc * 16) = pv[x]; \
            if (w == 0) { \
                float np[8]; \
                _Pragma("unroll") for (int o = 0; o < 8; ++o) np[o] = NP[o * 64 + lane]; \
                const float nold = vN[lane]; \
                const float bb = wave_incl_sum(pgf); \
                const float aa = pgi - bb; const float cm = wave_incl_max(aa); \
                const float M = fmaxf(m0, cm), M63 = __shfl(M, 63), bend = __shfl(bb, 63); \
                vA[lane] = aa; vM[lane] = M; vWI[lane] = __expf(m0 - M); vEMM[lane] = __expf(-(bb + M)); vWK[lane] = __expf(aa - M63); \
                const float dec = __expf(m0 - M63); \
                if (lane == 0) vSC[0] = dec; \
                vN[lane] = dec_prev * nold + (((np[0] + np[1]) + (np[2] + np[3])) + ((np[4] + np[5]) + (np[6] + np[7]))); \
                dec_prev = dec; m0n = bend + M63; \
            } } while (0)
        ML_S0();
        for (int ch = 0; ch < (CTX + SEQ) / 64; ++ch) {
            __syncthreads();
            if (ch + 1 < (CTX + SEQ) / 64) { const size_t ro = (size_t)seq_row(b, dir, (ch + 1) * 64 + qs) * D; pq = *(const v4u*)(QK + ro + h * 64 + qc * 8); pk = *(const v4u*)(QK + ro + 512 + h * 64 + qc * 8);
#pragma unroll
                for (int x = 0; x < 2; ++x) pv[x] = *(const v4u*)(VV + (size_t)seq_row(b, dir, (ch + 1) * 64 + ls + 32 * x) * D + h * 128 + lc * 8);
                if (tid < 64) { const float* gr = Gt + (size_t)seq_row(b, dir, (ch + 1) * 64 + tid) * 32; pgi = gr[ci]; pgf = gr[cf]; } }
            {
                const v4u kv = *(const LAS v4u*)(Kt + qs * SA + qc * 16); const float wk = vWK[qs];
#pragma unroll
                for (int rep = 0; rep < 2; ++rep) { const int idx = w + 8 * rep; if (idx < 10) { int ti4, si4; tri_tile(idx, ti4, si4);
                    const bf16x8 A0 = *(const LAS bf16x8*)(Qt + (16 * ti4 + fr) * SA + fq * 16), A1 = *(const LAS bf16x8*)(Qt + (16 * ti4 + fr) * SA + fq * 16 + 64);
                    const bf16x8 B0 = *(const LAS bf16x8*)(Kt + (16 * si4 + fr) * SA + fq * 16), B1 = *(const LAS bf16x8*)(Kt + (16 * si4 + fr) * SA + fq * 16 + 64);
                    const int scol = 16 * si4 + fr; const float as = vA[scol]; const f32x4 M4 = *(const LAS f32x4*)(vM + 16 * ti4 + 4 * fq);
                    f32x4 acc = (f32x4){0.f, 0.f, 0.f, 0.f};
                    acc = __builtin_amdgcn_mfma_f32_16x16x32_bf16(A0, B0, acc, 0, 0, 0); acc = __builtin_amdgcn_mfma_f32_16x16x32_bf16(A1, B1, acc, 0, 0, 0);
#pragma unroll
                    for (int r = 0; r < 4; ++r) { const int trow = 16 * ti4 + 4 * fq + r; *(LAS unsigned short*)(SC + trow * SA + scol * 2) = (unsigned short)f2bf(scol <= trow ? acc[r] * __expf(as - M4[r]) : 0.f); } } }
                const unsigned kx[4] = {kv.x, kv.y, kv.z, kv.w}; v4u o; float kf[8];
#pragma unroll
                for (int j = 0; j < 4; ++j) { kf[2 * j] = bf2f(kx[j] & 0xffffu) * wk; kf[2 * j + 1] = bf2f(kx[j] >> 16) * wk; }
                o.x = pk2(kf[0], kf[1]); o.y = pk2(kf[2], kf[3]); o.z = pk2(kf[4], kf[5]); o.w = pk2(kf[6], kf[7]);
                *(LAS v4u*)(KW + qs * SA + qc * 16) = o; }
            __syncthreads();
            f32x16 accA, accB;
            { const v4u sv = *(const LAS v4u*)(SC + qs * SA + qc * 16), qv = *(const LAS v4u*)(Qt + qs * SA + qc * 16); const f32x4 n0 = *(const LAS f32x4*)(vN + 8 * qc), n1 = *(const LAS f32x4*)(vN + 8 * qc + 4);
                const float wi = vWI[qs], emm = vEMM[qs], dec = vSC[0];
                unsigned short kwc[8];
#pragma unroll
                for (int i = 0; i < 8; ++i) kwc[i] = *(const LAS unsigned short*)(KW + (8 * w + i) * SA + lane * 2);
                bf16x8 A[4], Bm[4], A2[4], B2[4];
#pragma unroll
                for (int kk = 0; kk < 4; ++kk) { A[kk] = *(const LAS bf16x8*)(SC + (32 * ti + r32) * SA + hh * 16 + kk * 32); const LAS unsigned char* pb = tV + kk * 16 * SV + ej * 64; const s16x4 x = tr16(pb), y = tr16(pb + 4 * SV); Bm[kk] = (bf16x8){x[0], x[1], x[2], x[3], y[0], y[1], y[2], y[3]}; }
#pragma unroll
                for (int kk = 0; kk < 4; ++kk) { A2[kk] = *(const LAS bf16x8*)(Qt + (32 * ti + r32) * SA + hh * 16 + kk * 32); B2[kk] = *(const LAS bf16x8*)(CT + (32 * ej + r32) * SA + hh * 16 + kk * 32); }
                const unsigned sx[4] = {sv.x, sv.y, sv.z, sv.w}, qx[4] = {qv.x, qv.y, qv.z, qv.w};
                float ssum = 0.f;
#pragma unroll
                for (int j = 0; j < 4; ++j) { ssum += bf2f(sx[j] & 0xffffu) + bf2f(sx[j] >> 16); }
                const float dot = bf2f(qx[0] & 0xffffu) * n0[0] + bf2f(qx[0] >> 16) * n0[1] + bf2f(qx[1] & 0xffffu) * n0[2] + bf2f(qx[1] >> 16) * n0[3]
                    + bf2f(qx[2] & 0xffffu) * n1[0] + bf2f(qx[2] >> 16) * n1[1] + bf2f(qx[3] & 0xffffu) * n1[2] + bf2f(qx[3] >> 16) * n1[3];
                float part = ssum + wi * dot;
                part += __shfl_xor(part, 1); part += __shfl_xor(part, 2); part += __shfl_xor(part, 4);
                if (qc == 0) { const float rinv = 1.0f / fmaxf(fabsf(part), emm); vRI[qs] = rinv; vWIRI[qs] = wi * rinv; }
                { float cs = 0.f;
#pragma unroll
                    for (int i = 0; i < 8; ++i) cs += bf2f(kwc[i]);
                    NP[w * 64 + lane] = cs; }
#pragma unroll
                for (int i = 0; i < 16; ++i) { accA[i] = 0.f; accB[i] = 0.f; }
#pragma unroll
                for (int kk = 0; kk < 4; ++kk) accA = __builtin_amdgcn_mfma_f32_32x32x16_bf16(A[kk], Bm[kk], accA, 0, 0, 0);
#pragma unroll
                for (int kk = 0; kk < 4; ++kk) { const LAS unsigned char* pa = tKW + kk * 16 * SA + di * 64; const s16x4 x = tr16(pa), y = tr16(pa + 4 * SA); A[kk] = (bf16x8){x[0], x[1], x[2], x[3], y[0], y[1], y[2], y[3]}; }
#pragma unroll
                for (int kk = 0; kk < 4; ++kk) accB = __builtin_amdgcn_mfma_f32_32x32x16_bf16(A2[kk], B2[kk], accB, 0, 0, 0);
#pragma unroll
                for (int i = 0; i < 16; ++i) Cs[i] *= dec;
#pragma unroll
                for (int kk = 0; kk < 4; ++kk) Cs = __builtin_amdgcn_mfma_f32_32x32x16_bf16(A[kk], Bm[kk], Cs, 0, 0, 0); }
            __syncthreads();
            { const int ecol = 32 * ej + r32;
                f32x4 ri[4], wr[4];
#pragma unroll
                for (int g = 0; g < 4; ++g) { ri[g] = *(const LAS f32x4*)(vRI + 32 * ti + 8 * g + 4 * hh); wr[g] = *(const LAS f32x4*)(vWIRI + 32 * ti + 8 * g + 4 * hh); }
#pragma unroll
                for (int g = 0; g < 4; ++g) {
#pragma unroll
                    for (int j = 0; j < 4; ++j) { const int trow = 32 * ti + 8 * g + 4 * hh + j; *(LAS unsigned short*)(OST + trow * SO + ecol * 2) = (unsigned short)f2bf(accA[4 * g + j] * ri[g][j] + accB[4 * g + j] * wr[g][j]); }
                    v2u cw; cw.x = pk2(Cs[4 * g], Cs[4 * g + 1]); cw.y = pk2(Cs[4 * g + 2], Cs[4 * g + 3]);
                    *(LAS v2u*)(CT + ecol * SA + (32 * di + 8 * g + 4 * hh) * 2) = cw; }
                m0 = m0n; }
            __syncthreads();
            if (ch + 1 < (CTX + SEQ) / 64) ML_S0();
            if (ch >= CTX / 64) {
#pragma unroll
                for (int x = 0; x < 2; ++x) { const int row = ls + 32 * x; const v4u val = *(const LAS v4u*)(OST + row * SO + lc * 16);
                    *(v4u*)(Hd + (size_t)seq_row(b, dir, ch * 64 + row) * D + h * 128 + lc * 8) = val; } }
        }
#undef ML_S0
        __syncthreads();
    }
}

template <bool F8> __device__ __forceinline__ void ph_readout(const bf16* Oa, const bf16* Ob, const bf16* gate, const float* g, int R0, int R1, bf16* Y) {
    const int tid = threadIdx.x, lane = tid & 63, wave = __builtin_amdgcn_readfirstlane(tid >> 6);
    const int gw = blockIdx.x * NWAVES + wave, NGW = gridDim.x * NWAVES;
    f32x4 gg[4];
#pragma unroll
    for (int j4 = 0; j4 < 4; ++j4) gg[j4] = *(const f32x4*)(g + lane * 16 + j4 * 4);
    for (int Rq = R0 + gw; Rq < R1; Rq += 2 * NGW) {
        v4u x[2][2], y[2][2], z[2][2];
#pragma unroll
        for (int u = 0; u < 2; ++u) { const int R = (Rq + u * NGW < R1) ? Rq + u * NGW : Rq; const size_t off = (size_t)R * D + lane * 16;
#pragma unroll
            for (int hh = 0; hh < 2; ++hh) { x[u][hh] = *(const v4u*)(Oa + off + hh * 8); y[u][hh] = *(const v4u*)(Ob + off + hh * 8); z[u][hh] = *(const v4u*)(gate + off + hh * 8); } }
        __builtin_amdgcn_sched_barrier(0);
#pragma unroll
        for (int u = 0; u < 2; ++u) { const int R = Rq + u * NGW; const size_t off = (size_t)R * D + lane * 16;
            float o[16], gt[16]; float ss = 0.f;
#pragma unroll
            for (int hh = 0; hh < 2; ++hh) {
                const unsigned xx[4] = {x[u][hh].x, x[u][hh].y, x[u][hh].z, x[u][hh].w}, yy[4] = {y[u][hh].x, y[u][hh].y, y[u][hh].z, y[u][hh].w}, zz[4] = {z[u][hh].x, z[u][hh].y, z[u][hh].z, z[u][hh].w};
#pragma unroll
                for (int j = 0; j < 4; ++j) { o[hh * 8 + 2 * j] = bf2f(xx[j] & 0xffffu) + bf2f(yy[j] & 0xffffu); o[hh * 8 + 2 * j + 1] = bf2f(xx[j] >> 16) + bf2f(yy[j] >> 16);
                    gt[hh * 8 + 2 * j] = bf2f(zz[j] & 0xffffu); gt[hh * 8 + 2 * j + 1] = bf2f(zz[j] >> 16); } }
#pragma unroll
            for (int j = 0; j < 16; ++j) ss += o[j] * o[j];
            ss += __shfl_xor(ss, 1); ss += __shfl_xor(ss, 2); ss += __shfl_xor(ss, 4);
            const float rs = 1.0f / sqrtf(ss * (1.0f / 128.0f) + EPS);
            float yv[16];
#pragma unroll
            for (int j4 = 0; j4 < 4; ++j4)
#pragma unroll
                for (int j = 0; j < 4; ++j) yv[j4 * 4 + j] = o[j4 * 4 + j] * rs * gg[j4][j] * gt[j4 * 4 + j];
            if (F8) { if (R < R1) { v4u w; w.x = pk4_fp8(yv[0], yv[1], yv[2], yv[3]); w.y = pk4_fp8(yv[4], yv[5], yv[6], yv[7]); w.z = pk4_fp8(yv[8], yv[9], yv[10], yv[11]); w.w = pk4_fp8(yv[12], yv[13], yv[14], yv[15]);
                    *(v4u*)((unsigned char*)Y + (size_t)R * D + lane * 16) = w; } }
            else if (R < R1) { v4u w0, w1; w0.x = pk2(yv[0], yv[1]); w0.y = pk2(yv[2], yv[3]); w0.z = pk2(yv[4], yv[5]); w0.w = pk2(yv[6], yv[7]);
                w1.x = pk2(yv[8], yv[9]); w1.y = pk2(yv[10], yv[11]); w1.z = pk2(yv[12], yv[13]); w1.w = pk2(yv[14], yv[15]);
                *(v4u*)(Y + off) = w0; *(v4u*)(Y + off + 8) = w1; } }
    }
}

struct MoeTab { LAS int* pstart; LAS int* cnt; LAS int* nblk; LAS int* blkE; };
__device__ __forceinline__ MoeTab moe_tab(LAS unsigned char* lds) { MoeTab t; t.pstart = (LAS int*)(lds + LDS_TAB); t.cnt = t.pstart + 36; t.nblk = t.cnt + 32; t.blkE = t.nblk + 4; return t; }
__device__ __forceinline__ void moe_tables(ArgsRef a, int layer, LAS unsigned char* lds) {
    const MoeTab t = moe_tab(lds);
    const unsigned* cnt = (const unsigned*)(a.ws + WS_CTL) + CW_CNT + 64 * layer;
    __syncthreads();
    if (threadIdx.x < 32) t.cnt[threadIdx.x] = (int)__hip_atomic_load(cnt + threadIdx.x, __ATOMIC_RELAXED, __HIP_MEMORY_SCOPE_AGENT);
    __syncthreads();
    if (threadIdx.x < 64) { const int e = threadIdx.x & 31; const int nb = (t.cnt[e] + 255) >> 8; int incl = nb;
#pragma unroll
        for (int o = 1; o < 32; o <<= 1) { const int v = __shfl_up(incl, o, 32); if (e >= o) incl += v; }
        const int p0 = incl - nb;
        if (threadIdx.x < 32) { t.pstart[e] = p0 * 256; for (int j = 0; j < nb; ++j) t.blkE[p0 + j] = e; if (e == 31) { t.pstart[32] = incl * 256; t.nblk[0] = incl; } } }
    __syncthreads();
}

__device__ __forceinline__ void ph_router(ArgsRef a, const bf16* X, const float* g, int layer, int R0, int R1, bf16* Fout, LAS unsigned char* lds) {
    const int tid = threadIdx.x, lane = tid & 63, wave = __builtin_amdgcn_readfirstlane(tid >> 6), G = gridDim.x;
    const int fr = lane & 15, fq = lane >> 4;
    const float* modl = (const float*)(a.ws + WS_SM + SM_MODL) + (size_t)layer * 16 * 6 * D; const float* modc = (const float*)(a.ws + WS_SM + SM_MODC) + (size_t)layer * 6 * D;
    constexpr int APITCH = 2 * D + 16;
    constexpr int PPITCH = 36;
    LAS unsigned char* Ahi = lds; LAS unsigned char* Alo = lds + 16 * APITCH;
    LAS float* P = (LAS float*)(lds + 32 * APITCH);
    LAS int* cntL = (LAS int*)(lds + LDS_TAB);
    LAS int* baseL = cntL + 32;
    LAS int* infoL = baseL + 32;
    int* slot = (int*)(a.ws + WS_SLOT); float* gate = (float*)(a.ws + WS_GATE); int* rte = (int*)(a.ws + WS_RTE);
    unsigned* cntG = (unsigned*)(a.ws + WS_CTL) + CW_CNT + 64 * layer;
    const float* rw = a.in[I_RW] + (size_t)layer * D * NE; const float* rb = a.in[I_RB] + layer * NE;
    bf16x8 Bh[4][2], Bl[4][2];
#pragma unroll
    for (int kk = 0; kk < 4; ++kk)
#pragma unroll
        for (int nt = 0; nt < 2; ++nt) { v4u h, l;
#pragma unroll
            for (int j = 0; j < 4; ++j) { const float* wp = rw + (size_t)(32 * (4 * wave + kk) + 8 * fq + 2 * j) * NE + 16 * nt + fr; const float w0v = wp[0], w1v = wp[NE];
                const unsigned hh = pk2(w0v, w1v); h[j] = hh; l[j] = pk2(w0v - bf2f(hh & 0xffffu), w1v - bf2f(hh >> 16)); }
            Bh[kk][nt] = __builtin_bit_cast(bf16x8, h); Bl[kk][nt] = __builtin_bit_cast(bf16x8, l); }
    if (tid < 32) cntL[tid] = 0;
    const int nrows = R1 - R0, per = (nrows + G - 1) / G;
    const int w0 = R0 + blockIdx.x * per, w1 = (w0 + per < R1) ? w0 + per : R1;
    const int ntile = (w1 > w0) ? (w1 - w0 + 15) >> 4 : 0;
    __syncthreads();
    v2u xq[2][4]; f32x4 shq[2][4], scq[2][4];
    if (ntile > 0) {
#pragma unroll
        for (int rr = 0; rr < 2; ++rr) { const int R = (w0 + 2 * wave + rr < w1) ? w0 + 2 * wave + rr : w1 - 1;
            const float* mod = (R < NTC) ? modc : modl + (size_t)((R - NTC) / SEQ) * 6 * D;
#pragma unroll
            for (int j = 0; j < 4; ++j) { xq[rr][j] = ((const v2u*)(X + (size_t)R * D))[64 * j + lane]; shq[rr][j] = ((const f32x4*)(mod + 3 * D))[64 * j + lane]; scq[rr][j] = ((const f32x4*)(mod + 4 * D))[64 * j + lane]; } }
    }
    for (int ti = 0; ti < ntile; ++ti) {
        const int r = w0 + 16 * ti + 2 * wave;
#pragma unroll
        for (int rr = 0; rr < 2; ++rr) {
            const int R = (r + rr < w1) ? r + rr : w1 - 1;
            f32x4 v[4]; float ss = 0.f;
#pragma unroll
            for (int j = 0; j < 4; ++j) { const v2u xw = xq[rr][j]; v[j] = (f32x4){bf2f(xw.x & 0xffffu), bf2f(xw.x >> 16), bf2f(xw.y & 0xffffu), bf2f(xw.y >> 16)}; ss += (v[j][0] * v[j][0] + v[j][1] * v[j][1]) + (v[j][2] * v[j][2] + v[j][3] * v[j][3]); }
            const float rs = 1.0f / sqrtf(wave_sum(ss) * (1.0f / D) + EPS);
            unsigned* o8 = (unsigned*)((unsigned char*)Fout + (size_t)R * D);
            LAS unsigned char* ah = Ahi + (2 * wave + rr) * APITCH + 8 * lane; LAS unsigned char* al = Alo + (2 * wave + rr) * APITCH + 8 * lane;
#pragma unroll
            for (int j = 0; j < 4; ++j) { const f32x4 f = v[j] * rs * scq[rr][j] + shq[rr][j];
                if (r + rr < w1) o8[64 * j + lane] = pk4_fp8(f[0], f[1], f[2], f[3]);
                const unsigned h0 = pk2(f[0], f[1]), h1 = pk2(f[2], f[3]);
                *(LAS v2u*)(ah + 512 * j) = (v2u){h0, h1};
                *(LAS v2u*)(al + 512 * j) = (v2u){pk2(f[0] - bf2f(h0 & 0xffffu), f[1] - bf2f(h0 >> 16)), pk2(f[2] - bf2f(h1 & 0xffffu), f[3] - bf2f(h1 >> 16))}; }
            if (ti + 1 < ntile) { const int Rn = (r + 16 + rr < w1) ? r + 16 + rr : w1 - 1;
                const float* mod = (Rn < NTC) ? modc : modl + (size_t)((Rn - NTC) / SEQ) * 6 * D;
#pragma unroll
                for (int j = 0; j < 4; ++j) { xq[rr][j] = ((const v2u*)(X + (size_t)Rn * D))[64 * j + lane]; shq[rr][j] = ((const f32x4*)(mod + 3 * D))[64 * j + lane]; scq[rr][j] = ((const f32x4*)(mod + 4 * D))[64 * j + lane]; } }
        }
        __syncthreads();
        f32x4 acc[2] = {(f32x4){0.f, 0.f, 0.f, 0.f}, (f32x4){0.f, 0.f, 0.f, 0.f}};
#pragma unroll
        for (int kk = 0; kk < 4; ++kk) {
            const bf16x8 ahf = *(const LAS bf16x8*)(Ahi + fr * APITCH + 64 * (4 * wave + kk) + 16 * fq);
            const bf16x8 alf = *(const LAS bf16x8*)(Alo + fr * APITCH + 64 * (4 * wave + kk) + 16 * fq);
#pragma unroll
            for (int nt = 0; nt < 2; ++nt) {
                acc[nt] = __builtin_amdgcn_mfma_f32_16x16x32_bf16(alf, Bh[kk][nt], acc[nt], 0, 0, 0);
                acc[nt] = __builtin_amdgcn_mfma_f32_16x16x32_bf16(ahf, Bl[kk][nt], acc[nt], 0, 0, 0);
                acc[nt] = __builtin_amdgcn_mfma_f32_16x16x32_bf16(ahf, Bh[kk][nt], acc[nt], 0, 0, 0); }
        }
#pragma unroll
        for (int nt = 0; nt < 2; ++nt)
#pragma unroll
            for (int i = 0; i < 4; ++i) P[(wave * 16 + 4 * fq + i) * PPITCH + 16 * nt + fr] = acc[nt][i];
        __syncthreads();
        const int ex = lane & 31;
        float val = rb[ex];
#pragma unroll
        for (int w = 0; w < 8; ++w) val += P[(w * 16 + 2 * wave + (lane >> 5)) * PPITCH + ex];
        const unsigned bits = __float_as_uint(val);
        unsigned key = ((bits ^ ((unsigned)((int)bits >> 31) | 0x80000000u)) & ~31u) | (unsigned)(31 - ex);
        int te[4];
#pragma unroll
        for (int k = 0; k < 4; ++k) { unsigned m = key;
            m = max(m, (unsigned)__builtin_amdgcn_update_dpp((int)m, (int)m, 0x128, 0xf, 0xf, false));
            m = max(m, (unsigned)__builtin_amdgcn_update_dpp((int)m, (int)m, 0x124, 0xf, 0xf, false));
            m = max(m, (unsigned)__builtin_amdgcn_update_dpp((int)m, (int)m, 0x122, 0xf, 0xf, false));
            m = max(m, (unsigned)__builtin_amdgcn_update_dpp((int)m, (int)m, 0x121, 0xf, 0xf, false));
            const auto sw = __builtin_amdgcn_permlane16_swap(m, m, false, false); m = max((unsigned)sw[0], (unsigned)sw[1]);
            te[k] = 31 - (int)(m & 31u); if (ex == te[k]) key = 0u; }
        float tv[4];
#pragma unroll
        for (int k = 0; k < 4; ++k) tv[k] = __shfl(val, (lane & 32) | te[k]);
        const float e1 = __expf(tv[1] - tv[0]), e2 = __expf(tv[2] - tv[0]), e3 = __expf(tv[3] - tv[0]); const float inv = 1.0f / (1.0f + e1 + e2 + e3);
        const int R = r + (lane >> 5);
        if (ex < 4 && R < w1) {
            const int es = ex == 0 ? te[0] : ex == 1 ? te[1] : ex == 2 ? te[2] : te[3];
            const float gs = (ex == 0 ? 1.0f : ex == 1 ? e1 : ex == 2 ? e2 : e3) * inv;
            const int lr = __hip_atomic_fetch_add(cntL + es, 1, __ATOMIC_RELAXED, __HIP_MEMORY_SCOPE_WORKGROUP);
            infoL[(R - w0) * 4 + ex] = es | (lr << 8);
            gate[(size_t)R * 4 + ex] = gs;
        }
    }
    __syncthreads();
    if (tid < 32) baseL[tid] = (int)__hip_atomic_fetch_add(cntG + tid, (unsigned)cntL[tid], __ATOMIC_RELAXED, __HIP_MEMORY_SCOPE_AGENT);
    __syncthreads();
    for (int idx = tid; idx < (w1 - w0) * 4; idx += NTHREADS) { const int info = infoL[idx], e = info & 255, rk = baseL[e] + (info >> 8); const int R = w0 + (idx >> 2);
        slot[(size_t)R * 4 + (idx & 3)] = e | (rk << 8); rte[(size_t)e * NT + rk] = R; }
    __syncthreads();
}
constexpr int LDS_TOK = 131072;
__device__ __forceinline__ void moe_tok_table(ArgsRef a, const pg8::MoeOrder& S, LAS unsigned char* lds) {
    const MoeTab t = moe_tab(lds); LAS int* tokL = (LAS int*)(lds + LDS_TOK); const int* rte = (const int*)(a.ws + WS_RTE);
    const int tid = threadIdx.x;
    int val[14]; bool has[14];
#pragma unroll
    for (int q = 0; q < 14; ++q) { const int i = 2 * q + (tid >> 8); pg8::Unit u; has[q] = S.next(i, u); val[q] = 0;
        if (has[q]) { const int dest = u.pm * 256 + (tid & 255), e = t.blkE[u.pm], rk = dest - t.pstart[e];
            if (rk < t.cnt[e]) val[q] = rte[(size_t)e * NT + rk]; } }
#pragma unroll
    for (int q = 0; q < 14; ++q) { const int i = 2 * q + (tid >> 8); if (has[q]) tokL[i * 256 + (tid & 255)] = val[q]; }
    __syncthreads();
}

template <bool FINAL>
__device__ __forceinline__ void ph_combine(ArgsRef a, int layer, const bf16* Xin, const bf16* Ys, int R0, int R1, bf16* Xout, bf16* Hout, float* outF, LAS unsigned char* lds) {
    moe_tables(a, layer, lds); const MoeTab t = moe_tab(lds);
    const int tid = threadIdx.x, lane = tid & 63, wave = __builtin_amdgcn_readfirstlane(tid >> 6);
    const float* modl = (const float*)(a.ws + WS_SM + SM_MODL) + (size_t)layer * 16 * 6 * D; const float* modc = (const float*)(a.ws + WS_SM + SM_MODC) + (size_t)layer * 6 * D;
    const float* modl2 = (const float*)(a.ws + WS_SM + SM_MODL) + (size_t)1 * 16 * 6 * D; const float* modc2 = (const float*)(a.ws + WS_SM + SM_MODC) + (size_t)1 * 6 * D;
    const int* slot = (const int*)(a.ws + WS_SLOT); const float* gate = (const float*)(a.ws + WS_GATE);
    const int gw = blockIdx.x * NWAVES + wave, NGW = gridDim.x * NWAVES;
    for (int Rq = R0 + gw; Rq < R1; Rq += 2 * NGW) {
        unsigned yv[2][4][4]; v2u xv[2][4]; float gk[2][4];
#pragma unroll
        for (int u = 0; u < 2; ++u) { const int R = (Rq + u * NGW < R1) ? Rq + u * NGW : Rq;
#pragma unroll
            for (int k = 0; k < 4; ++k) { const int info = slot[(size_t)R * 4 + k]; gk[u][k] = gate[(size_t)R * 4 + k] * 0.0625f; const int dest = t.pstart[info & 255] + (info >> 8);
                const unsigned* yr = (const unsigned*)((const unsigned char*)Ys + (size_t)dest * D);
#pragma unroll
                for (int j = 0; j < 4; ++j) yv[u][k][j] = yr[64 * j + lane]; }
#pragma unroll
            for (int j = 0; j < 4; ++j) xv[u][j] = ((const v2u*)(Xin + (size_t)R * D))[64 * j + lane]; }
        __builtin_amdgcn_sched_barrier(0);
#pragma unroll
        for (int u = 0; u < 2; ++u) { const int R = Rq + u * NGW;
            const int Rc = (R < R1) ? R : Rq; const bool isctx = Rc < NTC; const int bidx = isctx ? 0 : (Rc - NTC) / SEQ;
            const float* mod = isctx ? modc : modl + (size_t)bidx * 6 * D;
            f32x4 v[4]; float ss = 0.f;
#pragma unroll
            for (int j = 0; j < 4; ++j) { f32x4 m = (f32x4){0.f, 0.f, 0.f, 0.f};
#pragma unroll
                for (int k = 0; k < 4; ++k) { const unsigned w = yv[u][k][j]; const float g = gk[u][k]; const auto lo = __builtin_amdgcn_cvt_pk_f32_fp8((int)w, false), hi = __builtin_amdgcn_cvt_pk_f32_fp8((int)w, true); m[0] += g * lo[0]; m[1] += g * lo[1]; m[2] += g * hi[0]; m[3] += g * hi[1]; }
                const v2u xw = xv[u][j]; const f32x4 xi = (f32x4){bf2f(xw.x & 0xffffu), bf2f(xw.x >> 16), bf2f(xw.y & 0xffffu), bf2f(xw.y >> 16)};
                v[j] = xi + ((const f32x4*)(mod + 5 * D))[64 * j + lane] * m; ss += (v[j][0] * v[j][0] + v[j][1] * v[j][1]) + (v[j][2] * v[j][2] + v[j][3] * v[j][3]); }
            const float rs = 1.0f / sqrtf(wave_sum(ss) * (1.0f / D) + EPS);
            if (R < R1) {
                if (FINAL) {
                    f32x4* o = (f32x4*)(outF + (size_t)(R - NTC) * D);
#pragma unroll
                    for (int j = 0; j < 4; ++j) o[64 * j + lane] = v[j] * rs * ((const f32x4*)a.in[I_FNG])[64 * j + lane];
                } else {
                    const float* mod2 = isctx ? modc2 : modl2 + (size_t)bidx * 6 * D;
                    v2u* xo = (v2u*)(Xout + (size_t)R * D); v2u* o8 = (v2u*)(Hout + (size_t)R * D);
#pragma unroll
                    for (int j = 0; j < 4; ++j) { { v2u xq; xq.x = pk2(v[j][0], v[j][1]); xq.y = pk2(v[j][2], v[j][3]); xo[64 * j + lane] = xq; }
                        const f32x4 sh = ((const f32x4*)(mod2))[64 * j + lane], sc = ((const f32x4*)(mod2 + D))[64 * j + lane];
                        const f32x4 y = v[j] * rs * sc + sh; v2u w; w.x = pk2(y[0], y[1]); w.y = pk2(y[2], y[3]); o8[64 * j + lane] = w; }
                }
            }
        }
    }
}

__device__ __forceinline__ void ph_conv(ArgsRef a, const bf16* QKR, bf16* QK) {
    const int tid = threadIdx.x;
    const float* cw = a.in[I_MLCW]; const float* cb = a.in[I_MLCB];
    const int c8 = (tid & 127) * 8;
    float w[9][8], bb[8];
#pragma unroll
    for (int t = 0; t < 9; ++t)
#pragma unroll
        for (int j = 0; j < 8; ++j) w[t][j] = cw[t * 1024 + c8 + j];
#pragma unroll
    for (int j = 0; j < 8; ++j) bb[j] = cb[c8 + j];
    const float osc = c8 < 512 ? 0.125f : 1.0f;
    constexpr int NLAT = 16 * 32 * 16, NITEM = NLAT + 16 * 64;
    for (int item = blockIdx.x * 4 + (tid >> 7); item < NITEM; item += gridDim.x * 4) {
        const bool isctx = item >= NLAT;
        int y, x0, rowbase, W;
        if (!isctx) { const int b = item >> 9; y = (item >> 4) & 31; x0 = (item & 15) * 4; rowbase = NTC + b * SEQ + y * 64; W = 64; }
        else { const int it2 = item - NLAT; y = 0; x0 = (it2 & 63) * 4; rowbase = (it2 >> 6) * CTX; W = CTX; }
        if (isctx && c8 < 512) {
#pragma unroll
            for (int pp = 0; pp < 4; ++pp) *(v4u*)(QK + (size_t)(rowbase + x0 + pp) * D + c8) = (v4u){0u, 0u, 0u, 0u};
            continue; }
        v4u win[3][6];
#pragma unroll
        for (int ky = 0; ky < 3; ++ky) { const int yy = y + ky - 1; const bool rv = isctx ? (ky == 1) : (yy >= 0 && yy < 32);
            const int yc = isctx ? 0 : (yy < 0 ? 0 : yy > 31 ? 31 : yy); const int rb = rowbase + (isctx ? 0 : (yc - y) * 64);
#pragma unroll
            for (int c = 0; c < 6; ++c) { const int xx = x0 - 1 + c; const int xc = xx < 0 ? 0 : xx >= W ? W - 1 : xx;
                const v4u x = *(const v4u*)(QKR + (size_t)(rb + xc) * D + c8);
                win[ky][c] = (rv && xx >= 0 && xx < W) ? x : (v4u){0u, 0u, 0u, 0u}; } }
        __builtin_amdgcn_sched_barrier(0);
#pragma unroll
        for (int pp = 0; pp < 4; ++pp) {
            float acc[8];
#pragma unroll
            for (int j = 0; j < 8; ++j) acc[j] = bb[j];
#pragma unroll
            for (int ky = 0; ky < 3; ++ky)
#pragma unroll
                for (int kx = 0; kx < 3; ++kx) { const v4u x = win[ky][pp + kx]; const unsigned xs[4] = {x.x, x.y, x.z, x.w};
#pragma unroll
                    for (int j = 0; j < 4; ++j) { acc[2 * j] += w[ky * 3 + kx][2 * j] * bf2f(xs[j] & 0xffffu); acc[2 * j + 1] += w[ky * 3 + kx][2 * j + 1] * bf2f(xs[j] >> 16); } }
            float yv[8];
#pragma unroll
            for (int j = 0; j < 8; ++j) yv[j] = siluf(acc[j]) * osc;
            v4u o; o.x = pk2(yv[0], yv[1]); o.y = pk2(yv[2], yv[3]); o.z = pk2(yv[4], yv[5]); o.w = pk2(yv[6], yv[7]);
            *(v4u*)(QK + (size_t)(rowbase + x0 + pp) * D + c8) = o; }
    }
}


constexpr int N_PHASES = 21;
__global__ void __launch_bounds__(NTHREADS, 2) fwd(Args a_unused) {
    ArgsRef a = *(const volatile __attribute__((address_space(4))) Args*)__builtin_amdgcn_kernarg_segment_ptr();
    extern __shared__ __attribute__((aligned(16))) unsigned char lds_raw[];
    LAS unsigned char* lds = (LAS unsigned char*)lds_raw;
    const int tid = threadIdx.x, G = gridDim.x;
    unsigned char* ws = a.ws;
    if (tid < 16) ((LAS unsigned*)(lds + LDS_MISC))[tid] = 0u;
    __syncthreads();
    XcdBarrier bar; bar.bar = (unsigned*)(ws + WS_CTL) + CW_BAR; bar.x = 0; bar.st = nullptr;
    const int lo = a.ph_lo, hi = a.ph_hi;
    if (hi - lo > 1) bar = xcd_barrier_post((unsigned*)(ws + WS_CTL) + CW_BAR, (volatile LAS unsigned*)(lds + LDS_MISC));
#ifndef PH_MASK
#define PH_MASK 0xFFFFFFFFu
#endif
#define IN(k) (((PH_MASK >> (k)) & 1u) && lo <= (k) && (k) < hi)
#define SEAM(k) do { if (IN(k) && IN((k) + 1)) xcd_barrier(bar); } while (0)

    bf16* ACT = (bf16*)(ws + WS_ACT);
    bf16* X1 = (bf16*)(ws + WS_X1); bf16* X2 = (bf16*)(ws + WS_X2);
    bf16* BIG = (bf16*)(ws + WS_BIG);
    const float* modl = (const float*)(ws + WS_SM + SM_MODL); const float* modc = (const float*)(ws + WS_SM + SM_MODC); const float* oml = (const float*)(ws + WS_SM + SM_OML);
    bf16* XS = BIG; bf16* HM = (bf16*)(ws + WS_BIG + 304 * MiB);

    if (IN(0)) { {  ph_prologue(a, lds);  } } SEAM(0);
    if (IN(1)) { {  ph_modulate(a, a.in[I_CTX], a.in[I_X], a.in[I_NMIXG], 0, 0, 0, NT, ACT);  } } SEAM(1);
    if (IN(2)) { {  pg8::Gemm g{ACT, (const bf16*)(ws + WS_WHGIN), D}; pg8::StaticOrder S; S.init(NT, HG_N, G, (int)blockIdx.x);
        pg8::EpiHgIn E{BIG, (size_t)NT * D, oml, oml + D}; pg8::gemm_phase<pg8::EpiHgIn, pg8::StaticOrder>(lds, g, S, E);
        if (idle_last_round(S)) expert_tiles<1>(a, lds, 2);  } } SEAM(2);
    if (IN(3)) { {  ph_hg_scan(a, lds);
          } } SEAM(3);
    if (IN(4)) { {  ph_readout<OUTPROJ_FP8>(BIG + (size_t)5 * NT * D, BIG + (size_t)6 * NT * D, BIG + (size_t)4 * NT * D, a.in[I_HGNG], 0, NT, ACT);  } } SEAM(4);
    if (IN(5)) { {  pg8::Gemm g{ACT, (const bf16*)(ws + WS_WHGOUT), D}; pg8::StaticOrder S; S.init(NT, D, G, (int)blockIdx.x);
        pg8::EpiResid<false> E{a.in[I_CTX], a.in[I_X], X1, modc + 2 * D, modl + 2 * D, 0, OUTPROJ_FP8 ? 0.0625f : 1.0f}; pg8::gemm_phase<pg8::EpiResid<false>, pg8::StaticOrder, true, true, false, OUTPROJ_FP8 != 0>(lds, g, S, E);
        if (idle_last_round(S)) expert_tiles<1>(a, lds, 2);  } } SEAM(5);
    if (IN(6)) { {  ph_router(a, X1, a.in[I_NFFNG], 0, 0, NT, ACT, lds);  } } SEAM(6);
    if (IN(8)) { {  moe_tables(a, 0, lds); const MoeTab t = moe_tab(lds);
        pg8::Gemm g{ACT, (const bf16*)(ws + WS_W1), D}; pg8::MoeOrder S{t.nblk[0], 8, G, (int)blockIdx.x, t.blkE}; moe_tok_table(a, S, lds);
        pg8::EpiSwiglu E{HM, a.in[I_B1]}; pg8::gemm_phase<pg8::EpiSwiglu, pg8::MoeOrder, true, true, true, true>(lds, g, S, E, (const LAS int*)(lds + LDS_TOK));
        if (idle_last_round(S)) expert_tiles<1>(a, lds, 1);  } } SEAM(8);
    if (IN(9)) { {  moe_tables(a, 0, lds); const MoeTab t = moe_tab(lds);
        pg8::Gemm g{HM, (const bf16*)(ws + WS_W2), D}; pg8::MoeOrder S{t.nblk[0], 4, G, (int)blockIdx.x, t.blkE};
        pg8::EpiW2 E{XS, a.in[I_B2]}; pg8::gemm_phase<pg8::EpiW2, pg8::MoeOrder, true, true, false, true>(lds, g, S, E);
        if (idle_last_round(S)) expert_tiles<1>(a, lds, 1);  } } SEAM(9);
    if (IN(10)) { {  ph_combine<false>(a, 0, X1, XS, 0, NT, X2, ACT, nullptr, lds);  } } SEAM(10);
    if (IN(11)) { {  pg8::Gemm g{ACT, (const bf16*)(ws + WS_WMLIN), D}; pg8::MlInOrder S; S.init(G, (int)blockIdx.x);
        pg8::EpiMlIn E{BIG, (size_t)NT * D, (float*)(ws + WS_GT), a.in[I_MLBG]}; pg8::gemm_phase<pg8::EpiMlIn, pg8::MlInOrder>(lds, g, S, E);
        expert_tiles<1>(a, lds, 1 << 30);  } } SEAM(11);
    if (IN(12)) { {  ph_conv(a, BIG, BIG + (size_t)3 * NT * D);  } } SEAM(12);
    if (IN(13)) { {  ph_ml_scan(a, lds);  } } SEAM(13);
    if (IN(14)) { {  ph_readout<OUTPROJ_FP8>(BIG + (size_t)4 * NT * D, BIG + (size_t)5 * NT * D, BIG + (size_t)2 * NT * D, a.in[I_MLNG], NTC, NT, ACT);  } } SEAM(14);
    if (IN(15)) { {  pg8::Gemm g{OUTPROJ_FP8 ? (const bf16*)((const unsigned char*)ACT + (size_t)NTC * D) : ACT + (size_t)NTC * D, (const bf16*)(ws + WS_WMLOUT), D}; pg8::StaticOrder S; S.init(NTL, D, G, (int)blockIdx.x);
        pg8::EpiResid<true> E{X2, X2 + (size_t)NTC * D, X1, modc + 6 * D + 2 * D, modl + (size_t)16 * 6 * D + 2 * D, NTC, OUTPROJ_FP8 ? 0.0625f : 1.0f}; pg8::gemm_phase<pg8::EpiResid<true>, pg8::StaticOrder, true, true, false, OUTPROJ_FP8 != 0>(lds, g, S, E);  } } SEAM(15);
    if (IN(16)) { {  ph_router(a, X1, a.in[I_NFFNG] + D, 1, NTC, NT, ACT, lds);  } } SEAM(16);
    if (IN(18)) { {  moe_tables(a, 1, lds); const MoeTab t = moe_tab(lds);
        pg8::Gemm g{ACT, (const bf16*)(ws + WS_W1 + (size_t)32 * 2048 * D), D}; pg8::MoeOrder S{t.nblk[0], 8, G, (int)blockIdx.x, t.blkE}; moe_tok_table(a, S, lds);
        pg8::EpiSwiglu E{HM, a.in[I_B1] + 32 * 2048}; pg8::gemm_phase<pg8::EpiSwiglu, pg8::MoeOrder, true, true, true, true>(lds, g, S, E, (const LAS int*)(lds + LDS_TOK));  } } SEAM(18);
    if (IN(19)) { {  moe_tables(a, 1, lds); const MoeTab t = moe_tab(lds);
        pg8::Gemm g{HM, (const bf16*)(ws + WS_W2 + (size_t)32 * D * D), D}; pg8::MoeOrder S{t.nblk[0], 4, G, (int)blockIdx.x, t.blkE};
        pg8::EpiW2 E{XS, a.in[I_B2] + 32 * D}; pg8::gemm_phase<pg8::EpiW2, pg8::MoeOrder, true, true, false, true>(lds, g, S, E);  } } SEAM(19);
    if (IN(20)) { {  ph_combine<true>(a, 1, X1, XS, NTC, NT, nullptr, nullptr, a.out, lds);  } }
#undef IN
#undef SEAM
}

extern "C" void kernel_launch(void* const* d_in, const int* in_sizes, int n_in, void* d_out, int out_size, void* d_ws, size_t ws_size, hipStream_t stream) {
    static int grid = 0;
    if (grid == 0) {
        if (n_in != 25 || out_size != NTL * D || ws_size < WS_END) { fprintf(stderr, "kernel_launch: unexpected problem (n_in %d, out %d, ws %zu < %zu)\n", n_in, out_size, ws_size, (size_t)WS_END); grid = -1; return; }
        int dev = 0, cus = 0, per_cu = 0;
        if (hipGetDevice(&dev) != hipSuccess || hipDeviceGetAttribute(&cus, hipDeviceAttributeMultiprocessorCount, dev) != hipSuccess) { grid = -1; return; }
        if (hipFuncSetAttribute((const void*)fwd, hipFuncAttributeMaxDynamicSharedMemorySize, LDS_BYTES) != hipSuccess) { fprintf(stderr, "kernel_launch: hipFuncSetAttribute failed\n"); grid = -1; return; }
        if (hipOccupancyMaxActiveBlocksPerMultiprocessor(&per_cu, (const void*)fwd, NTHREADS, LDS_BYTES) != hipSuccess || per_cu < 1) { fprintf(stderr, "kernel_launch: occupancy query says %d blocks per CU\n", per_cu); }
        (void)hipGetLastError();
        grid = cus < 256 ? cus : 256;
    }
    if (grid < 0) return;
    if (hipMemsetAsync((char*)d_ws + WS_CTL, 0, CTL_ZERO_BYTES, stream) != hipSuccess) return;
    Args a{};
    for (int i = 0; i < 25; ++i) a.in[i] = (const float*)d_in[i];
    a.out = (float*)d_out; a.ws = (unsigned char*)d_ws;
#if MK_ONE_LAUNCH
    a.ph_lo = 0; a.ph_hi = N_PHASES;
    hipLaunchKernelGGL(fwd, dim3(grid), dim3(NTHREADS), LDS_BYTES, stream, a);
#else
    for (int p = 0; p < N_PHASES; ++p) { a.ph_lo = p; a.ph_hi = p + 1; hipLaunchKernelGGL(fwd, dim3(grid), dim3(NTHREADS), LDS_BYTES, stream, a); }
#endif
}
```

```cpp
#include <hip/hip_runtime.h>
#include <cstdio>
#include <cstdint>

#ifndef OUTPROJ_FP8
#define OUTPROJ_FP8 1
#endif
#ifndef MK_ONE_LAUNCH
#define MK_ONE_LAUNCH 1
#endif

#define LAS __attribute__((address_space(3)))
#define GAS __attribute__((address_space(1)))
typedef unsigned short bf16;
typedef unsigned v4u __attribute__((ext_vector_type(4)));
typedef unsigned v2u __attribute__((ext_vector_type(2)));
typedef float f32x4 __attribute__((ext_vector_type(4)));
typedef float f32x2 __attribute__((ext_vector_type(2)));
typedef short bf16x8 __attribute__((ext_vector_type(8)));

constexpr int NB = 16, SEQ = 2048, D = 1024, CTX = 256;
constexpr int NTC = NB * CTX, NTL = NB * SEQ, NT = NTC + NTL;
constexpr int NE = 32, TOPK = 4;
constexpr int HG_N = 5 * D;
constexpr int ML_N = 3104, ML_NP = 3328;
constexpr int NPADMAX = 155648;
constexpr float EPS = 1e-6f;
constexpr int NWAVES = 8, NTHREADS = 512;

constexpr size_t MiB = 1u << 20;
constexpr size_t WS_CTL = 0, CTL_ZERO_BYTES = 1 * MiB;
constexpr size_t WS_SM = 1 * MiB;
constexpr size_t SM_MODL = 0, SM_MODC = 786432, SM_OML = 835584;
constexpr size_t WS_SLOT = 2 * MiB;
constexpr size_t WS_GATE = 3 * MiB;
constexpr size_t WS_RTE = 4 * MiB;
constexpr size_t WS_GT = 10 * MiB;
constexpr size_t WS_WHGIN = 16 * MiB, WS_WHGOUT = 26 * MiB, WS_WMLIN = 28 * MiB, WS_WMLOUT = 35 * MiB;
constexpr size_t WS_W1 = 40 * MiB, WS_W2 = 296 * MiB;
constexpr size_t WS_X1 = 424 * MiB, WS_X2 = 568 * MiB, WS_ACT = 712 * MiB, WS_BIG = 784 * MiB;
constexpr size_t T72 = 72 * MiB;
constexpr size_t WS_END = WS_BIG + 608 * MiB;
constexpr int CW_CNT = 1024;
constexpr int CW_TILE = 2048, CW_BAR = 4096;

constexpr int LDS_BYTES = 160 * 1024;
constexpr int LDS_MISC = LDS_BYTES - 4096;
constexpr int LDS_TAB = LDS_MISC + 64;

__device__ __forceinline__ float bf2f(unsigned v) { return __uint_as_float(v << 16); }
typedef __bf16 bf2_t __attribute__((ext_vector_type(2)));
__device__ __forceinline__ unsigned pk2(float lo, float hi) { bf2_t v; v[0] = (__bf16)lo; v[1] = (__bf16)hi; return __builtin_bit_cast(unsigned, v); }
__device__ __forceinline__ unsigned f2bf(float f) { return pk2(f, f) & 0xffffu; }
__device__ __forceinline__ float fexp(float x) { return __builtin_amdgcn_exp2f(x * 1.44269504089f); }
__device__ __forceinline__ float frcp(float x) { return __builtin_amdgcn_rcpf(x); }
__device__ __forceinline__ float siluf(float v) { return v * frcp(1.0f + fexp(-v)); }
#define LDS_WAIT() asm volatile("s_waitcnt lgkmcnt(0)" ::: "memory")
__device__ __forceinline__ unsigned pk4_fp8(float a, float b, float c, float d) { int w = 0; w = __builtin_amdgcn_cvt_pk_fp8_f32(a, b, w, false); w = __builtin_amdgcn_cvt_pk_fp8_f32(c, d, w, true); return (unsigned)w; }
template <int CTRL, int RMASK> __device__ __forceinline__ float dppf(float old, float src) { return __int_as_float(__builtin_amdgcn_update_dpp(__float_as_int(old), __float_as_int(src), CTRL, RMASK, 0xf, false)); }

namespace pg8 {
#define PG8_LAS __attribute__((address_space(3)))
typedef unsigned short bf16_t;
typedef unsigned u32x4 __attribute__((ext_vector_type(4)));
constexpr int BM = 256, BK = 64, HALF = 128, HTB = HALF * BK * 2, STAGE_BYTES = 8 * HTB, NXCD = 8, WGM = 8;
__host__ __device__ __forceinline__ int lds_byte(int r, int c) { const int st = (r >> 4) * 2 + (c >> 5), rr = r & 15, cc = c & 31, ob = rr * 64 + cc * 2; return st * 1024 + (ob ^ (((ob >> 9) & 1) << 5)); }
__host__ __device__ __forceinline__ void stage_rc(int b, int& R, int& C) { const int st = b / 1024, sb = b % 1024, swz = sb ^ (((sb >> 9) & 1) << 5); R = (st >> 1) * 16 + swz / 64; C = (st & 1) * 32 + (swz % 64) / 2; }
__host__ __device__ __forceinline__ int perm32(int rho) { const int n = rho >> 4, i = rho & 15; return 8 * (i >> 2) + 4 * n + (i & 3); }

__device__ __forceinline__ int lane_now() { int l; asm volatile("v_mbcnt_lo_u32_b32 %0, -1, 0\n\tv_mbcnt_hi_u32_b32 %0, -1, %0" : "=v"(l)); return l; }
struct Unit { int pm, pn, bt; };
struct Gemm { const bf16_t* A; const bf16_t* Bt; int K; };

struct StaticOrder {
    int nM, nN, nwg, G, c;
    __device__ void init(int M, int N, int G_, int c_) { nM = M / BM; nN = N / BM; nwg = nM * nN; G = G_; c = c_; }
    __device__ bool next(int i, Unit& u) const {
        const long L = (long)i * G + c; if (L >= nwg) return false;
        int wgid = (int)L; { const int q = nwg / NXCD, r = nwg % NXCD, xcd = wgid % NXCD, off = wgid / NXCD; wgid = (xcd < r ? xcd * (q + 1) : r * (q + 1) + (xcd - r) * q) + off; }
        const int nig = WGM * nN, gid = wgid / nig, fm = gid * WGM, gsz = (nM - fm) < WGM ? (nM - fm) : WGM;
        u.pm = fm + ((wgid % nig) % gsz); u.pn = (wgid % nig) / gsz; u.bt = u.pn; return true;
    }
};
struct MlInOrder {
    StaticOrder lat; int G, c;
    __device__ void init(int G_, int c_) { lat.init(NTL, ML_NP, G_, 0); G = G_; c = c_; }
    __device__ bool next(int i, Unit& u) const {
        const long L = (long)i * G + c;
        if (L < lat.nwg) { StaticOrder t = lat; t.G = 1; t.c = 0; t.next((int)L, u); u.pm += NTC / BM; return true; }
        const int r = (int)(L - lat.nwg); if (r >= 16 * 7) return false;
        const int j = r % 7; u.pm = r / 7; u.pn = j < 2 ? 2 + j : j < 6 ? 2 + j : 12; u.bt = u.pn; return true;
    }
};
struct MoeOrder {
    int nblk, tilesN, G, c; const LAS int* blkE;
    __device__ bool next(int i, Unit& u) const {
        int pm, pn;
        const int J = G / 8;
        if ((G % 8) == 0 && (J % tilesN) == 0) { const int x = c % 8, j = c / 8, RB = J / tilesN; pm = (i * 8 + x) * RB + j / tilesN; pn = j % tilesN; }
        else { const long L = (long)i * G + c; pm = (int)(L / tilesN); pn = (int)(L % tilesN); }
        if (pm >= nblk) return false;
        u.pm = pm; u.pn = pn; u.bt = blkE[pm] * tilesN + pn; return true;
    }
};

__device__ __forceinline__ unsigned cvt_pk_bf16(float lo, float hi) { return pk2(lo, hi); }

__device__ __forceinline__ __attribute__((ext_vector_type(8))) int pk8(bf16x8 lo, bf16x8 hi) { typedef int v4i __attribute__((ext_vector_type(4))); const v4i a = __builtin_bit_cast(v4i, lo), b = __builtin_bit_cast(v4i, hi);
    return (__attribute__((ext_vector_type(8))) int){a[0], a[1], a[2], a[3], b[0], b[1], b[2], b[3]}; }
typedef int v8i_t __attribute__((ext_vector_type(8)));
typedef int v4i_q __attribute__((ext_vector_type(4)));
__device__ __forceinline__ int pg8_x16(int v) { int r; asm volatile("v_xor_b32 %0, 16, %1" : "=v"(r) : "v"(v)); return r; }
__device__ __forceinline__ v8i_t pk8q(v4i_q a, v4i_q b) { return __builtin_shufflevector(a, b, 0, 1, 2, 3, 4, 5, 6, 7); }
template <class Epi, class Sched, bool ALIGN_EPI = true, bool SP2 = true, bool GATHER = false, bool FP8 = false>
__device__ __forceinline__ void gemm_phase(PG8_LAS unsigned char* lds, const Gemm g, const Sched& S, const Epi& E, const PG8_LAS int* tokL = nullptr) {
    const int tid = threadIdx.x, wid = __builtin_amdgcn_readfirstlane(tid >> 6), lane = tid & 63, wr = wid >> 2, wc = wid & 3, fr = lane & 15, fq = lane >> 4;
    const int K = FP8 ? g.K / 2 : g.K, nt = K / BK;
    unsigned voffA[2], voffB[2];
#pragma unroll
    for (int i = 0; i < 2; ++i) { int R, C; stage_rc(tid * 16 + i * 8192, R, C); const int Rb = Epi::PERM ? ((R & ~31) + perm32(R & 31)) : R;
        voffA[i] = (unsigned)(R * K + C) * 2u; voffB[i] = (unsigned)(Rb * K + C) * 2u; }
    unsigned gA[2][2], gU[2][2];
#define PG8_GTOK(dst, uidx) do { const int _t = wid * 64 + lane_now(); _Pragma("unroll") for (int _i = 0; _i < 2; ++_i) { int _R, _C; stage_rc(_t * 16 + _i * 8192, _R, _C); _Pragma("unroll") for (int _h = 0; _h < 2; ++_h) dst[_h][_i] = (unsigned)tokL[(uidx) * 256 + _h * HALF + _R] * (unsigned)(K * 2) + (unsigned)(_C * 2); } } while (0)
    const unsigned kstep = (unsigned)(BK * 2);
    const unsigned hstep = (unsigned)HALF * K * 2;
    const unsigned tstep = 2 * hstep;
    const __amdgpu_buffer_rsrc_t rsA = __builtin_amdgcn_make_buffer_rsrc((void*)g.A, 0, -1, 0x00020000), rsB = __builtin_amdgcn_make_buffer_rsrc((void*)g.Bt, 0, -1, 0x00020000);
    const unsigned ldsw = (unsigned)wid * 1024u;
    const int aoff = FP8 ? (lds_byte(wr * 64 + fr, fq * 16) | ((fq & 1) << 4)) : lds_byte(wr * 64 + fr, fq * 8), boff = FP8 ? (lds_byte(wc * 32 + fr, fq * 16) | ((fq & 1) << 4)) : lds_byte(wc * 32 + fr, fq * 8);
#define aoffH pg8_x16(aoff)
#define boffH pg8_x16(boff)
    constexpr int aoff1 = FP8 ? 16 : 1024, boff1 = FP8 ? 16 : 1024;
#define PG8_SA(b, h) (((b) * 2 + (h)) * HTB)
#define PG8_SB(b, h) ((4 + (b) * 2 + (h)) * HTB)
#define PG8_STAGE_R(bufoff, rs, soff, voff) do { _Pragma("unroll") for (int _i = 0; _i < 2; ++_i) \
        __builtin_amdgcn_raw_ptr_buffer_load_lds(rs, (PG8_LAS void*)(lds + (bufoff) + ldsw + _i * 8192), 16, (int)(voff)[_i], (int)(soff), 0, 0); } while (0)
#define PG8_STAGE_B(bufoff, soff) PG8_STAGE_R(bufoff, rsB, soff, voffB)
#define PG8_STAGE_A1(b, h, ptr) do { if constexpr (GATHER) { PG8_STAGE_R(PG8_SA(b, h), rsA, ptr, gA[h]); } else { PG8_STAGE_R(PG8_SA(b, h), rsA, (ptr) + (h) * hstep, voffA); } } while (0)
#define PG8_STAGE_A2(b, h, ptr) do { if constexpr (GATHER) { PG8_STAGE_R(PG8_SA(b, h), rsA, ptr, gU[h]); } else { PG8_STAGE_R(PG8_SA(b, h), rsA, (ptr) + (h) * hstep, voffA); } } while (0)
#define PG8_LDA(dst, b, h) do { if constexpr (FP8) { _Pragma("unroll") for (int m = 0; m < 4; ++m) dst##8[m] = pk8q(*(const PG8_LAS v4i_q*)(lds + PG8_SA(b, h) + aoff + m * 2048), *(const PG8_LAS v4i_q*)(lds + PG8_SA(b, h) + aoffH + m * 2048)); } else { _Pragma("unroll") for (int m = 0; m < 4; ++m) _Pragma("unroll") for (int k = 0; k < 2; ++k) dst[m][k] = *(const PG8_LAS bf16x8*)(lds + PG8_SA(b, h) + aoff + m * 2048 + k * aoff1); } } while (0)
#define PG8_LDB(dst, b, h) do { if constexpr (FP8) { _Pragma("unroll") for (int n = 0; n < 2; ++n) dst##8[n] = pk8q(*(const PG8_LAS v4i_q*)(lds + PG8_SB(b, h) + boff + n * 2048), *(const PG8_LAS v4i_q*)(lds + PG8_SB(b, h) + boffH + n * 2048)); } else { _Pragma("unroll") for (int n = 0; n < 2; ++n) _Pragma("unroll") for (int k = 0; k < 2; ++k) dst[n][k] = *(const PG8_LAS bf16x8*)(lds + PG8_SB(b, h) + boff + n * 2048 + k * boff1); } } while (0)
#define PG8_MMA(ai, bj, At, Bt) do { __builtin_amdgcn_s_setprio(1); if constexpr (FP8) { _Pragma("unroll") for (int m = 0; m < 4; ++m) _Pragma("unroll") for (int n = 0; n < 2; ++n) \
        acc[ai][bj][m][n] = __builtin_amdgcn_mfma_scale_f32_16x16x128_f8f6f4(Bt##8[n], At##8[m], acc[ai][bj][m][n], 0, 0, 0, 0, 0, 0); } \
        else { _Pragma("unroll") for (int m = 0; m < 4; ++m) _Pragma("unroll") for (int n = 0; n < 2; ++n) _Pragma("unroll") for (int k = 0; k < 2; ++k) \
        acc[ai][bj][m][n] = __builtin_amdgcn_mfma_f32_16x16x32_bf16(Bt[n][k], At[m][k], acc[ai][bj][m][n], 0, 0, 0); } __builtin_amdgcn_s_setprio(0); } while (0)
#define PG8_WAIT_V(n) asm volatile("s_waitcnt vmcnt(" #n ")" ::: "memory")
#define PG8_WAIT_L(n) asm volatile("s_waitcnt lgkmcnt(" #n ")" ::: "memory")
#define PG8_BAR __builtin_amdgcn_s_barrier()
#define PG8_SCHED __builtin_amdgcn_sched_barrier(0)
    Unit cur, nxt; int ui = 0;
    if (!S.next(0, cur)) return;
    f32x4 acc[2][2][4][2];
#pragma unroll
    for (int a = 0; a < 2; ++a)
#pragma unroll
        for (int b = 0; b < 2; ++b)
#pragma unroll
            for (int m = 0; m < 4; ++m)
#pragma unroll
                for (int n = 0; n < 2; ++n) acc[a][b][m][n] = (f32x4){0.f, 0.f, 0.f, 0.f};
    bf16x8 At[4][2], B0[2][2], B1[2][2]; v8i_t At8[4], B08[2], B18[2];
    unsigned cA = GATHER ? 0u : (unsigned)cur.pm * tstep, cB = (unsigned)cur.bt * tstep;
    if constexpr (GATHER) { PG8_GTOK(gA, 0); }
    if constexpr (SP2) {
        PG8_STAGE_B(PG8_SB(0, 0), cB); PG8_STAGE_B(PG8_SB(0, 1), cB + hstep); PG8_STAGE_A1(0, 0, cA); PG8_STAGE_A1(0, 1, cA);
        if (wr == 1) PG8_BAR;
        PG8_WAIT_V(2); PG8_BAR;
        PG8_STAGE_B(PG8_SB(1, 0), cB + kstep); PG8_STAGE_A1(1, 0, cA + kstep); PG8_STAGE_B(PG8_SB(1, 1), cB + hstep + kstep);
        PG8_WAIT_V(6); PG8_BAR;
    } else {
        static_assert(SP2 || !GATHER, "gathered A rows: SP2 loop only");
        PG8_STAGE_B(PG8_SB(0, 0), cB); PG8_STAGE_R(PG8_SA(0, 0), rsA, cA, voffA); PG8_STAGE_B(PG8_SB(0, 1), cB + hstep); PG8_STAGE_R(PG8_SA(0, 1), rsA, cA + hstep, voffA);
        if (wr == 1) PG8_BAR;
        PG8_WAIT_V(4); PG8_BAR;
        PG8_STAGE_B(PG8_SB(1, 0), cB + kstep); PG8_STAGE_R(PG8_SA(1, 0), rsA, cA + kstep, voffA); PG8_STAGE_B(PG8_SB(1, 1), cB + hstep + kstep);
        PG8_WAIT_V(6); PG8_BAR;
    }
    for (;;) {
        const bool has_next = S.next(ui + 1, nxt);
        const unsigned nA = GATHER ? cA : (has_next ? (unsigned)nxt.pm * tstep : cA), nB = has_next ? (unsigned)nxt.bt * tstep : cB;
#pragma unroll 1
        for (int t = 0; t < nt; t += 2) {
            const bool last = (t == nt - 2);
            if constexpr (GATHER) {
#pragma unroll
                for (int _h = 0; _h < 2; ++_h)
#pragma unroll
                    for (int _i = 0; _i < 2; ++_i) gU[_h][_i] = gA[_h][_i];
                if (last && has_next) { PG8_GTOK(gU, ui + 1); } }

            const unsigned a1 = cA + (unsigned)(t + 1) * kstep;
            const unsigned a2 = last ? nA : cA + (unsigned)(t + 2) * kstep, b2 = last ? nB : cB + (unsigned)(t + 2) * kstep;
            const unsigned a3 = a2 + kstep, b3 = b2 + kstep;
            if constexpr (SP2) {
            PG8_LDB(B0, 0, 0); PG8_LDB(B1, 0, 1); PG8_SCHED; PG8_LDA(At, 0, 0); PG8_STAGE_A1(1, 1, a1);
            PG8_WAIT_V(8); PG8_WAIT_L(0); PG8_BAR; PG8_MMA(0, 0, At, B0); PG8_MMA(0, 1, At, B1); PG8_BAR; PG8_SCHED;
            PG8_LDA(At, 0, 1); PG8_STAGE_B(PG8_SB(0, 0), b2); PG8_STAGE_B(PG8_SB(0, 1), b2 + hstep); PG8_STAGE_A2(0, 0, a2);
            PG8_WAIT_V(8); PG8_WAIT_L(0); PG8_BAR; PG8_MMA(1, 0, At, B0); PG8_MMA(1, 1, At, B1); PG8_BAR; PG8_SCHED;
            PG8_LDB(B0, 1, 0); PG8_LDB(B1, 1, 1); PG8_SCHED; PG8_LDA(At, 1, 0); PG8_STAGE_A2(0, 1, a2);
            PG8_WAIT_V(8); PG8_WAIT_L(0); PG8_BAR; PG8_MMA(0, 0, At, B0); PG8_MMA(0, 1, At, B1); PG8_BAR; PG8_SCHED;
            PG8_LDA(At, 1, 1); PG8_STAGE_B(PG8_SB(1, 0), b3); PG8_STAGE_B(PG8_SB(1, 1), b3 + hstep); PG8_STAGE_A2(1, 0, a3);
            PG8_WAIT_V(8); PG8_WAIT_L(0); PG8_BAR; PG8_MMA(1, 0, At, B0); PG8_MMA(1, 1, At, B1); PG8_BAR; PG8_SCHED;
            } else {
            PG8_LDB(B0, 0, 0); PG8_SCHED; PG8_LDA(At, 0, 0); PG8_STAGE_R(PG8_SA(1, 1), rsA, a1 + hstep, voffA);
            PG8_WAIT_L(8); PG8_BAR; PG8_WAIT_L(0); PG8_MMA(0, 0, At, B0); PG8_BAR; PG8_SCHED;
            PG8_LDB(B1, 0, 1); PG8_STAGE_B(PG8_SB(0, 0), b2);
            PG8_BAR; PG8_WAIT_L(0); PG8_MMA(0, 1, At, B1); PG8_BAR;
            PG8_LDA(At, 0, 1); PG8_STAGE_R(PG8_SA(0, 0), rsA, a2, voffA);
            PG8_BAR; PG8_WAIT_L(0); PG8_MMA(1, 0, At, B0); PG8_BAR; PG8_SCHED;
            PG8_STAGE_B(PG8_SB(0, 1), b2 + hstep);
            PG8_WAIT_V(6); PG8_BAR; PG8_MMA(1, 1, At, B1); PG8_BAR;
            PG8_LDB(B0, 1, 0); PG8_SCHED; PG8_LDA(At, 1, 0); PG8_STAGE_R(PG8_SA(0, 1), rsA, a2 + hstep, voffA);
            PG8_WAIT_L(8); PG8_BAR; PG8_WAIT_L(0); PG8_MMA(0, 0, At, B0); PG8_BAR; PG8_SCHED;
            PG8_LDB(B1, 1, 1); PG8_STAGE_B(PG8_SB(1, 0), b3);
            PG8_BAR; PG8_WAIT_L(0); PG8_MMA(0, 1, At, B1); PG8_BAR;
            PG8_LDA(At, 1, 1); PG8_STAGE_R(PG8_SA(1, 0), rsA, a3, voffA);
            PG8_BAR; PG8_WAIT_L(0); PG8_MMA(1, 0, At, B0); PG8_BAR; PG8_SCHED;
            PG8_STAGE_B(PG8_SB(1, 1), b3 + hstep);
            PG8_WAIT_V(6); PG8_BAR; PG8_MMA(1, 1, At, B1); PG8_BAR;
            }
        }
        if constexpr (ALIGN_EPI) { if (wr == 0) PG8_BAR; }
        E(acc, cur, wr, wc, fr, fq);
        if (!has_next) break;
#pragma unroll
        for (int a = 0; a < 2; ++a)
#pragma unroll
            for (int b = 0; b < 2; ++b)
#pragma unroll
                for (int m = 0; m < 4; ++m)
#pragma unroll
                    for (int n = 0; n < 2; ++n) { f32x2 z0, z1; asm volatile("v_mov_b64 %0, 0\n\tv_mov_b64 %1, 0" : "=v"(z0), "=v"(z1)); acc[a][b][m][n] = (f32x4){z0[0], z0[1], z1[0], z1[1]}; }
        cur = nxt; cA = nA; cB = nB; ++ui;
        if constexpr (GATHER) { PG8_GTOK(gA, ui); }
        if constexpr (ALIGN_EPI) { if (wr == 1) PG8_BAR; }
    }
    PG8_WAIT_V(0);
    if constexpr (!ALIGN_EPI) { if (wr == 0) PG8_BAR; }
    PG8_BAR;
#undef PG8_SA
#undef PG8_SB
#undef PG8_STAGE_R
#undef PG8_STAGE_B
#undef PG8_LDA
#undef PG8_STAGE_A1
#undef PG8_STAGE_A2
#undef PG8_GTOK
#undef PG8_LDB
#undef PG8_MMA
#undef PG8_WAIT_V
#undef PG8_WAIT_L
#undef PG8_BAR
#undef PG8_SCHED
}

struct EpiHgIn {
    static constexpr bool PERM = true;
    bf16_t* out0; size_t seg_stride; const float* omlF; const float* omlB;
    __device__ __forceinline__ void operator()(const f32x4 (&acc)[2][2][4][2], const Unit& u, int wr, int wc, int fr, int fq) const {
        const int seg = u.pn >> 2, colt = (u.pn & 3) * BM;
        bf16_t* base = out0 + (size_t)seg * seg_stride;
        const int row0 = u.pm * BM + wr * 64 + fr, col0 = colt + wc * 32 + 8 * fq;
        f32x4 ov[2][2];
        const float* oml = (seg == 2) ? omlF : omlB;
#pragma unroll
        for (int bj = 0; bj < 2; ++bj)
#pragma unroll
            for (int n = 0; n < 2; ++n) ov[bj][n] = (seg == 2 || seg == 3) ? *(const f32x4*)(oml + col0 + bj * HALF + 4 * n) : (f32x4){1.f, 1.f, 1.f, 1.f};
        auto body = [&](auto act) {
#pragma unroll
            for (int ai = 0; ai < 2; ++ai)
#pragma unroll
                for (int m = 0; m < 4; ++m) { bf16_t* rowp = base + (size_t)(row0 + ai * HALF + m * 16) * D + col0;
#pragma unroll
                    for (int bj = 0; bj < 2; ++bj) { f32x4 v[2] = {acc[ai][bj][m][0], acc[ai][bj][m][1]};
#pragma unroll
                        for (int n = 0; n < 2; ++n)
#pragma unroll
                            for (int j = 0; j < 4; ++j) v[n][j] = act(v[n][j], ov[bj][n][j]);
                        u32x4 w; w.x = cvt_pk_bf16(v[0][0], v[0][1]); w.y = cvt_pk_bf16(v[0][2], v[0][3]); w.z = cvt_pk_bf16(v[1][0], v[1][1]); w.w = cvt_pk_bf16(v[1][2], v[1][3]);
                        *(u32x4*)(rowp + bj * HALF) = w; } } };
        if (seg == 0 || seg == 4) body([](float x, float) { return siluf(x); });
        else if (seg == 1) body([](float x, float) { return x; });
        else body([](float x, float o) { return o * frcp(1.0f + fexp(x)); });
    }
};
struct EpiMlIn {
    static constexpr bool PERM = true;
    bf16_t* out0; size_t seg_stride; float* gt; const float* bgate;
    __device__ __forceinline__ void operator()(const f32x4 (&acc)[2][2][4][2], const Unit& u, int wr, int wc, int fr, int fq) const {
        const int seg = u.pn >> 2, colt = (u.pn & 3) * BM;
        const int row0 = u.pm * BM + wr * 64 + fr, col0 = colt + wc * 32 + 8 * fq;
        if (seg == 3) {
            if (wc == 0) {
                const f32x4 b0 = *(const f32x4*)(bgate + 8 * fq), b1 = *(const f32x4*)(bgate + 8 * fq + 4);
#pragma unroll
                for (int ai = 0; ai < 2; ++ai)
#pragma unroll
                    for (int m = 0; m < 4; ++m) { float* rowp = gt + (size_t)(row0 + ai * HALF + m * 16) * 32 + 8 * fq; f32x4 v[2] = {acc[ai][0][m][0] + b0, acc[ai][0][m][1] + b1};
#pragma unroll
                        for (int n = 0; n < 2; ++n)
#pragma unroll
                            for (int j = 0; j < 4; ++j) { const float y = v[n][j] * (1.0f / 15.0f); float t = 15.0f * (1.0f - 2.0f * frcp(1.0f + fexp(2.0f * y)));
                                if (fq >= 2) t = fminf(t, 0.f) - __logf(1.0f + fexp(-fabsf(t)));
                                v[n][j] = t; }
                        *(f32x4*)(rowp) = v[0]; *(f32x4*)(rowp + 4) = v[1]; }
            }
            return;
        }
        bf16_t* base = out0 + (size_t)seg * seg_stride;
#pragma unroll
        for (int ai = 0; ai < 2; ++ai)
#pragma unroll
            for (int m = 0; m < 4; ++m) { bf16_t* rowp = base + (size_t)(row0 + ai * HALF + m * 16) * D + col0;
#pragma unroll
                for (int bj = 0; bj < 2; ++bj) { f32x4 v[2] = {acc[ai][bj][m][0], acc[ai][bj][m][1]};
                    if (seg == 2) {
#pragma unroll
                        for (int n = 0; n < 2; ++n)
#pragma unroll
                            for (int j = 0; j < 4; ++j) v[n][j] = frcp(1.0f + fexp(-v[n][j])); }
                    u32x4 w; w.x = cvt_pk_bf16(v[0][0], v[0][1]); w.y = cvt_pk_bf16(v[0][2], v[0][3]); w.z = cvt_pk_bf16(v[1][0], v[1][1]); w.w = cvt_pk_bf16(v[1][2], v[1][3]);
                    *(u32x4*)(rowp + bj * HALF) = w; } }
    }
};
template <bool IN_BF16> struct EpiResid {
    static constexpr bool PERM = true;
    const void* in_ctx; const void* in_lat; bf16_t* out; const float* mod_ctx; const float* mod_lat; int row_off; float asc;
    __device__ __forceinline__ void operator()(const f32x4 (&acc)[2][2][4][2], const Unit& u, int wr, int wc, int, int) const {
        const int ln = lane_now(), fr = ln & 15, fq = ln >> 4;
        const int R0 = u.pm * BM + row_off;
        const bool isctx = R0 < NTC;
        const float* mod = isctx ? mod_ctx : mod_lat + (size_t)((R0 - NTC) / SEQ) * (6 * D);
        const size_t inrow0 = isctx ? (size_t)R0 : (size_t)(R0 - NTC);
        const int rl0 = wr * 64 + fr, col0 = u.pn * BM + wc * 32 + 8 * fq;
        const unsigned long long inb = (isctx ? (unsigned long long)in_ctx : (unsigned long long)in_lat) + (unsigned long long)(inrow0 * D) * (IN_BF16 ? 2u : 4u);
        f32x4 mv[2][2];
#pragma unroll
        for (int bj = 0; bj < 2; ++bj)
#pragma unroll
            for (int n = 0; n < 2; ++n) mv[bj][n] = *(const f32x4*)(mod + col0 + bj * HALF + 4 * n) * asc;
#pragma unroll
        for (int ai = 0; ai < 2; ++ai) {
            if constexpr (IN_BF16) {
                u32x4 rb[4][2];
#pragma unroll
                for (int m = 0; m < 4; ++m)
#pragma unroll
                    for (int bj = 0; bj < 2; ++bj) rb[m][bj] = *(const __attribute__((address_space(1))) u32x4*)(inb + ((unsigned long long)(rl0 + ai * HALF + m * 16) * D + col0 + bj * HALF) * 2u);
                __builtin_amdgcn_sched_barrier(0);
#pragma unroll
                for (int m = 0; m < 4; ++m)
#pragma unroll
                    for (int bj = 0; bj < 2; ++bj) { const u32x4 w = rb[m][bj];
                        const f32x4 x0 = (f32x4){__uint_as_float(w.x << 16), __uint_as_float(w.x & 0xffff0000u), __uint_as_float(w.y << 16), __uint_as_float(w.y & 0xffff0000u)};
                        const f32x4 x1 = (f32x4){__uint_as_float(w.z << 16), __uint_as_float(w.z & 0xffff0000u), __uint_as_float(w.w << 16), __uint_as_float(w.w & 0xffff0000u)};
                        const f32x4 v0 = x0 + mv[bj][0] * acc[ai][bj][m][0], v1 = x1 + mv[bj][1] * acc[ai][bj][m][1];
                        u32x4 o; o.x = cvt_pk_bf16(v0[0], v0[1]); o.y = cvt_pk_bf16(v0[2], v0[3]); o.z = cvt_pk_bf16(v1[0], v1[1]); o.w = cvt_pk_bf16(v1[2], v1[3]);
                        *(u32x4*)(out + (size_t)(R0 + rl0 + ai * HALF + m * 16) * D + col0 + bj * HALF) = o; }
            } else {
                f32x4 rf[4][2][2];
#pragma unroll
                for (int m = 0; m < 4; ++m)
#pragma unroll
                    for (int bj = 0; bj < 2; ++bj) { const __attribute__((address_space(1))) f32x4* ip = (const __attribute__((address_space(1))) f32x4*)(inb + ((unsigned long long)(rl0 + ai * HALF + m * 16) * D + col0 + bj * HALF) * 4u); rf[m][bj][0] = ip[0]; rf[m][bj][1] = ip[1]; }
                __builtin_amdgcn_sched_barrier(0);
#pragma unroll
                for (int m = 0; m < 4; ++m)
#pragma unroll
                    for (int bj = 0; bj < 2; ++bj) { const f32x4 v0 = rf[m][bj][0] + mv[bj][0] * acc[ai][bj][m][0], v1 = rf[m][bj][1] + mv[bj][1] * acc[ai][bj][m][1];
                        u32x4 o; o.x = cvt_pk_bf16(v0[0], v0[1]); o.y = cvt_pk_bf16(v0[2], v0[3]); o.z = cvt_pk_bf16(v1[0], v1[1]); o.w = cvt_pk_bf16(v1[2], v1[3]);
                        *(u32x4*)(out + (size_t)(R0 + rl0 + ai * HALF + m * 16) * D + col0 + bj * HALF) = o; }
            }
            __builtin_amdgcn_sched_barrier(0);
        }
    }
};
struct EpiSwiglu {
    static constexpr bool PERM = true;
    bf16_t* H; const float* b1;
    __device__ __forceinline__ void operator()(const f32x4 (&acc)[2][2][4][2], const Unit& u, int wr, int wc, int, int) const {
        const int e = u.bt >> 3; const int ln = lane_now(), fr = ln & 15, fq = ln >> 4;
        const int row0 = u.pm * BM + wr * 64 + fr, col0 = u.pn * HALF + wc * 32 + 8 * fq;
        const float* bb = b1 + (size_t)e * 2048 + col0;
        f32x4 bg[2], bl[2];
#pragma unroll
        for (int n = 0; n < 2; ++n) { bg[n] = *(const f32x4*)(bb + 4 * n); bl[n] = *(const f32x4*)(bb + 1024 + 4 * n) + 1.0f; }
#pragma unroll
        for (int ai = 0; ai < 2; ++ai)
#pragma unroll
            for (int m = 0; m < 4; ++m) { unsigned char* rowp = (unsigned char*)H + (size_t)(row0 + ai * HALF + m * 16) * D + col0;
                f32x2 v[2][2];
#pragma unroll
                for (int n = 0; n < 2; ++n)
#pragma unroll
                    for (int jp = 0; jp < 2; ++jp) {
                        const f32x2 ag = (f32x2){acc[ai][0][m][n][2 * jp], acc[ai][0][m][n][2 * jp + 1]}, al = (f32x2){acc[ai][1][m][n][2 * jp], acc[ai][1][m][n][2 * jp + 1]};
                        const f32x2 g2 = __builtin_elementwise_fma(ag, (f32x2){0.0625f, 0.0625f}, (f32x2){bg[n][2 * jp], bg[n][2 * jp + 1]});
                        const f32x2 l2 = __builtin_elementwise_fma(al, (f32x2){0.0625f, 0.0625f}, (f32x2){bl[n][2 * jp], bl[n][2 * jp + 1]});
                        const f32x2 gl = (f32x2){fminf(g2[0], 7.0f), fminf(g2[1], 7.0f)};
                        const f32x2 lc = (f32x2){__builtin_amdgcn_fmed3f(l2[0], -6.0f, 8.0f), __builtin_amdgcn_fmed3f(l2[1], -6.0f, 8.0f)};
                        const f32x2 t2 = gl * (f32x2){-1.702f * 1.44269504089f, -1.702f * 1.44269504089f};
                        const f32x2 d2 = (f32x2){__builtin_amdgcn_exp2f(t2[0]), __builtin_amdgcn_exp2f(t2[1])} + (f32x2){1.0f, 1.0f};
                        const f32x2 r2 = (f32x2){frcp(d2[0]), frcp(d2[1])};
                        v[n][jp] = (gl * lc) * r2; }
                v2u w; w.x = pk4_fp8(v[0][0][0], v[0][0][1], v[0][1][0], v[0][1][1]); w.y = pk4_fp8(v[1][0][0], v[1][0][1], v[1][1][0], v[1][1][1]);
                *(v2u*)(rowp) = w; }
    }
};
struct EpiW2 {
    static constexpr bool PERM = true;
    bf16_t* Y; const float* b2;
    __device__ __forceinline__ void operator()(const f32x4 (&acc)[2][2][4][2], const Unit& u, int wr, int wc, int fr, int fq) const {
        const int e = u.bt >> 2;
        const int row0 = u.pm * BM + wr * 64 + fr, col0 = u.pn * BM + wc * 32 + 8 * fq;
        const float* bb = b2 + (size_t)e * 1024 + col0;
        f32x4 bv[2][2];
#pragma unroll
        for (int bj = 0; bj < 2; ++bj)
#pragma unroll
            for (int n = 0; n < 2; ++n) bv[bj][n] = *(const f32x4*)(bb + bj * HALF + 4 * n) * 16.0f;
#pragma unroll
        for (int ai = 0; ai < 2; ++ai)
#pragma unroll
            for (int m = 0; m < 4; ++m) { unsigned char* rowp = (unsigned char*)Y + (size_t)(row0 + ai * HALF + m * 16) * D + col0;
#pragma unroll
                for (int bj = 0; bj < 2; ++bj) { f32x4 v0 = acc[ai][bj][m][0] + bv[bj][0], v1 = acc[ai][bj][m][1] + bv[bj][1];
#pragma unroll
                    for (int j = 0; j < 4; ++j) { v0[j] = __builtin_amdgcn_fmed3f(v0[j], -448.0f, 448.0f); v1[j] = __builtin_amdgcn_fmed3f(v1[j], -448.0f, 448.0f); }
                    v2u w; w.x = pk4_fp8(v0[0], v0[1], v0[2], v0[3]); w.y = pk4_fp8(v1[0], v1[1], v1[2], v1[3]);
                    *(v2u*)(rowp + bj * HALF) = w; } }
    }
};
}

#define XB_TMO      128
#define XB_XCNT(j)  (256  + 64 * (j))
#define XB_XSUB(j)  (1280 + 64 * (j))
#define XB_XGEN(j)  (2304 + 64 * (j))
#define XB_TOP      3328
#define XB_TOPGEN   3392
#define XCD_BAR_WORDS 3456
#define XB_SPIN_CAP (1u << 18)
__device__ __forceinline__ unsigned xb_ld(unsigned* p)              { return __hip_atomic_load(p, __ATOMIC_RELAXED, __HIP_MEMORY_SCOPE_AGENT); }
__device__ __forceinline__ unsigned xb_add(unsigned* p, unsigned v) { return __hip_atomic_fetch_add(p, v, __ATOMIC_RELAXED, __HIP_MEMORY_SCOPE_AGENT); }
__device__ __forceinline__ unsigned xb_xcc_id() { return (unsigned)__builtin_amdgcn_s_getreg((3 << 11) | 20) & 0xFu; }
#define XB_SPIN(cond, bar) do { unsigned _sp = 0; while (cond) { __builtin_amdgcn_s_sleep(1); \
    if ((++_sp & 255u) == 0u) { if (xb_ld(&(bar)[XB_TMO])) break; if (_sp > XB_SPIN_CAP) { atomicAdd(&(bar)[XB_TMO], 1u); break; } } } } while (0)
struct XcdBarrier { unsigned* bar; unsigned x; volatile LAS unsigned* st; };
__device__ __forceinline__ XcdBarrier xcd_barrier_post(unsigned* bar, volatile LAS unsigned* st) {
    XcdBarrier b; b.bar = bar; b.x = xb_xcc_id(); b.st = st;
    if (threadIdx.x == 0) (void)xb_add(&bar[XB_XCNT(b.x)], 1u);
    return b;
}
__device__ __forceinline__ void xcd_barrier_complete(unsigned* bar, unsigned x, unsigned& nloc, unsigned& nx) {
    const unsigned G = gridDim.x * gridDim.y * gridDim.z;
    unsigned sum, cnt, mine, sp = 0u;
    for (;;) {
        sum = 0u; cnt = 0u; mine = 0u;
#pragma unroll
        for (unsigned j = 0; j < 16; ++j) { const unsigned c = xb_ld(&bar[XB_XCNT(j)]); sum += c; cnt += (c > 0u) ? 1u : 0u; mine = (j == x) ? c : mine; }
        if (sum == G) break;
        __builtin_amdgcn_s_sleep(1);
        if ((++sp & 255u) == 0u) { if (xb_ld(&bar[XB_TMO])) break; if (sp > XB_SPIN_CAP) { atomicAdd(&bar[XB_TMO], 1u); break; } }
    }
    nloc = mine > 0u ? mine : 1u; nx = cnt > 0u ? cnt : 1u;
}
__device__ __forceinline__ void xcd_barrier(const XcdBarrier& b) {
    asm volatile("s_waitcnt vmcnt(0)" ::: "memory");
    __syncthreads();
    if (threadIdx.x == 0) {
        unsigned* bar = b.bar;
        __builtin_amdgcn_s_waitcnt(0);
        unsigned nloc = b.st[0], nx = b.st[1];
        if (nloc == 0u) { xcd_barrier_complete(bar, b.x, nloc, nx); b.st[0] = nloc; b.st[1] = nx; }
        const unsigned old = xb_add(&bar[XB_XSUB(b.x)], 1u);
        const unsigned gen = old / nloc;
        if (old + 1u == (gen + 1u) * nloc) {
            __builtin_amdgcn_fence(__ATOMIC_RELEASE, "agent");
            asm volatile("s_waitcnt vmcnt(0)" ::: "memory");
            const unsigned og = xb_add(&bar[XB_TOP], 1u);
            const unsigned tg = og / nx;
            if (og + 1u == (tg + 1u) * nx) xb_add(&bar[XB_TOPGEN], 1u);
            else XB_SPIN(xb_ld(&bar[XB_TOPGEN]) == tg, bar);
            __builtin_amdgcn_fence(__ATOMIC_ACQUIRE, "agent");
            xb_add(&bar[XB_XGEN(b.x)], 1u);
            asm volatile("s_waitcnt vmcnt(0)" ::: "memory");
        } else {
            XB_SPIN(xb_ld(&bar[XB_XGEN(b.x)]) == gen, bar);
            __builtin_amdgcn_fence(__ATOMIC_ACQUIRE, "agent");
            asm volatile("s_waitcnt vmcnt(0)" ::: "memory");
        }
    }
    __syncthreads();
}

struct Args { const float* in[25]; float* out; unsigned char* ws; int ph_lo, ph_hi; };
typedef const volatile __attribute__((address_space(4))) Args& ArgsRef;
enum { I_X = 0, I_C, I_CTX, I_CCTX, I_ADAW, I_ADAB, I_NMIXG, I_NFFNG, I_HGWIN, I_HGLB, I_HGNG, I_HGWOUT, I_MLWIN, I_MLBG, I_MLCW, I_MLCB, I_MLNG, I_MLWOUT, I_RW, I_RB, I_W1, I_B1, I_W2, I_B2, I_FNG };

__device__ __forceinline__ float wave_sum(float v) {
#pragma unroll
    for (int o = 1; o < 64; o <<= 1) v += __shfl_xor(v, o);
    return v;
}

struct TItem { const float* W; bf16* WT; int N, drow, k0, n0, f8; };
__device__ __forceinline__ void titem_load(const TItem& t, float (&tv)[32], int lane) {
#pragma unroll
    for (int i = 0; i < 32; ++i) tv[i] = t.W[(size_t)(t.k0 + 2 * i + (lane >> 5)) * t.N + t.n0 + (lane & 31)];
}

template <int LAYER> __device__ __forceinline__ void expert_tiles(ArgsRef a, LAS unsigned char* lds, int max_tiles) {
    const int tid = threadIdx.x, lane = tid & 63, wave = __builtin_amdgcn_readfirstlane(tid >> 6);
    constexpr int TP = 260;
    LAS float* T = (LAS float*)lds;
    const float* W1 = a.in[I_W1] + (size_t)LAYER * 32 * D * 2048; const float* W2 = a.in[I_W2] + (size_t)LAYER * 32 * D * D;
    unsigned char* W1T = a.ws + WS_W1 + (size_t)LAYER * 32 * 2048 * D; unsigned char* W2T = a.ws + WS_W2 + (size_t)LAYER * 32 * D * D;
    constexpr int NT1 = 32 * 64, NL = NT1 + 32 * 32;
    auto tsrc = [&](int t, int& N) -> const float* { if (t < NT1) { const int mat = t >> 6, r = t & 63; N = 2048; return W1 + ((size_t)mat * D + 128 * (r >> 3)) * 2048 + 256 * (r & 7); }
        const int t2 = t - NT1, mat = t2 >> 5, r = t2 & 31; N = D; return W2 + ((size_t)mat * D + 128 * (r >> 2)) * D + 256 * (r & 3); };
    unsigned* tcnt = (unsigned*)(a.ws + WS_CTL) + CW_TILE + LAYER; LAS int* tq = (LAS int*)(lds + LDS_MISC + 16);
    __syncthreads();
    if (tid == 0) { tq[1] = max_tiles >= 1 ? (int)__hip_atomic_fetch_add(tcnt, 1u, __ATOMIC_RELAXED, __HIP_MEMORY_SCOPE_AGENT) : NL;
                    tq[0] = max_tiles >= 2 ? (int)__hip_atomic_fetch_add(tcnt, 1u, __ATOMIC_RELAXED, __HIP_MEMORY_SCOPE_AGENT) : NL; }
    __syncthreads();
    int t = tq[1];
    if (t < NL) {
        f32x4 v[16]; { int N; const float* sp = tsrc(t, N) + (size_t)(16 * wave) * N + 4 * lane;
#pragma unroll
            for (int i = 0; i < 16; ++i) v[i] = *(const f32x4*)(sp + (size_t)i * N); }
        for (int k = 1; ; ++k) {
#pragma unroll
            for (int i = 0; i < 16; ++i) *(LAS f32x4*)(T + (16 * wave + i) * TP + ((4 * lane + 8 * wave) & 255)) = v[i];
            __syncthreads();
            const int tn = tq[(k + 1) & 1]; unsigned tnn = 0u; const bool want = (k + 2 <= max_tiles) && tn < NL;
            if (tid == 0 && want) tnn = __hip_atomic_fetch_add(tcnt, 1u, __ATOMIC_RELAXED, __HIP_MEMORY_SCOPE_AGENT);
            if (tn < NL) { int N2; const float* sp = tsrc(tn, N2) + (size_t)(16 * wave) * N2 + 4 * lane;
#pragma unroll
                for (int i = 0; i < 16; ++i) v[i] = *(const f32x4*)(sp + (size_t)i * N2); }
            __builtin_amdgcn_sched_barrier(0);
            const int ks = lane & 7, nl = lane >> 3;
#pragma unroll
            for (int q = 0; q < 4; ++q) { const int n = 32 * wave + 8 * q + nl; unsigned char* dp;
                if (t < NT1) { const int mat = t >> 6, r = t & 63, ng = 256 * (r & 7) + n, cc = ng & 1023, bj = ng >> 10; dp = W1T + ((size_t)mat * 2048 + 256 * (cc >> 7) + 128 * bj + (cc & 127)) * D + 128 * (r >> 3); }
                else { const int t2 = t - NT1, mat = t2 >> 5, r = t2 & 31; dp = W2T + ((size_t)mat * D + 256 * (r & 3) + n) * D + 128 * (r >> 2); }
                const LAS float* tp = T + (16 * ks) * TP + ((n + 8 * ks) & 255); float x[16];
#pragma unroll
                for (int i = 0; i < 16; ++i) x[i] = 16.f * tp[i * TP];
                v4u o; o.x = pk4_fp8(x[0], x[1], x[2], x[3]); o.y = pk4_fp8(x[4], x[5], x[6], x[7]); o.z = pk4_fp8(x[8], x[9], x[10], x[11]); o.w = pk4_fp8(x[12], x[13], x[14], x[15]);
                *(v4u*)(dp + 16 * ks) = o; }
            if (tid == 0) tq[k & 1] = want ? (int)tnn : NL;
            __syncthreads();
            if (tn >= NL) break;
            t = tn;
        }
    }
}
template <class Sched> __device__ __forceinline__ bool idle_last_round(const Sched& S) { pg8::Unit u; Sched S0 = S; S0.c = 0; int n = 0, n0 = 0; while (S.next(n, u)) ++n; while (S0.next(n0, u)) ++n0; return n < n0; }

__device__ __forceinline__ void ph_prologue(ArgsRef a, LAS unsigned char* lds) {
    const int tid = threadIdx.x, lane = tid & 63, wave = __builtin_amdgcn_readfirstlane(tid >> 6), G = gridDim.x;
    unsigned char* ws = a.ws;
    float* modl = (float*)(ws + WS_SM + SM_MODL); float* modc = (float*)(ws + WS_SM + SM_MODC); float* oml = (float*)(ws + WS_SM + SM_OML);
    {
        LAS float* actT = (LAS float*)lds;
        LAS float* red = (LAS float*)(lds + 81920);
        bool staged = false;
        for (int it = blockIdx.x; it < 192; it += G) {
            if (!staged) {
                { float cv[34];
#pragma unroll
                    for (int i = 0; i < 34; ++i) { const int r = i >> 1, k = tid + 512 * (i & 1); cv[i] = r < 16 ? a.in[I_C][r * 1024 + k] : a.in[I_CCTX][k]; }
#pragma unroll
                    for (int i = 0; i < 34; ++i) { const int r = i >> 1, k = tid + 512 * (i & 1); actT[k * 20 + r] = siluf(cv[i]); } }
                __syncthreads(); staged = true;
            }
            const int layer = it / 96, n0 = (it % 96) * 64;
            const float* W = a.in[I_ADAW] + (size_t)layer * D * 6 * D + n0 + lane;
            float acc[17];
#pragma unroll
            for (int r = 0; r < 17; ++r) acc[r] = 0.f;
#pragma unroll 1
            for (int kb = wave * 128; kb < wave * 128 + 128; kb += 32) {
              float wv[32];
#pragma unroll
              for (int i = 0; i < 32; ++i) wv[i] = W[(size_t)(kb + i) * (6 * D)];
              __builtin_amdgcn_sched_barrier(0);
#pragma unroll
              for (int i = 0; i < 32; ++i) { const int k = kb + i; const float w = wv[i];
                const LAS f32x4* ap = (const LAS f32x4*)(actT + k * 20);
                const f32x4 a0 = ap[0], a1 = ap[1], a2 = ap[2], a3 = ap[3]; const float a16 = actT[k * 20 + 16];
                acc[0] += a0[0] * w; acc[1] += a0[1] * w; acc[2] += a0[2] * w; acc[3] += a0[3] * w;
                acc[4] += a1[0] * w; acc[5] += a1[1] * w; acc[6] += a1[2] * w; acc[7] += a1[3] * w;
                acc[8] += a2[0] * w; acc[9] += a2[1] * w; acc[10] += a2[2] * w; acc[11] += a2[3] * w;
                acc[12] += a3[0] * w; acc[13] += a3[1] * w; acc[14] += a3[2] * w; acc[15] += a3[3] * w;
                acc[16] += a16 * w;
              }
            }
#pragma unroll
            for (int r = 0; r < 17; ++r) red[(wave * 17 + r) * 64 + lane] = acc[r];
            __syncthreads();
            for (int idx = tid; idx < 17 * 64; idx += NTHREADS) { const int r = idx >> 6, l = idx & 63; float s = a.in[I_ADAB][layer * 6 * D + n0 + l];
#pragma unroll
                for (int w = 0; w < 8; ++w) s += red[(w * 17 + r) * 64 + l];
                const int sl = (n0 + l) >> 10, dcol = (n0 + l) & 1023;
                if (sl == 1) s = a.in[I_NMIXG][layer * D + dcol] * (1.0f + s); else if (sl == 4) s = a.in[I_NFFNG][layer * D + dcol] * (1.0f + s);
                if (r < 16) modl[((size_t)layer * 16 + r) * (6 * D) + n0 + l] = s; else modc[(size_t)layer * (6 * D) + n0 + l] = s; }
            __syncthreads();
        }
        __syncthreads();
    }
    {
        const int gt = blockIdx.x * NTHREADS + tid;
        if (gt < 2 * D) { const int dir = gt >> 10, c = gt & 1023; const float* lg = a.in[I_HGLB] + (size_t)dir * 3 * D + c;
            const float l0 = lg[0], l1 = lg[D], l2 = lg[2 * D]; const float mx = fmaxf(l0, fmaxf(l1, l2));
            const float e0 = __expf(l0 - mx), e1 = __expf(l1 - mx), e2 = __expf(l2 - mx);
            oml[gt] = (e1 + e2) / (e0 + e1 + e2); }
    }
    {
        LAS float* scr = (LAS float*)(lds + wave * 16384);
        const int gw = blockIdx.x * NWAVES + wave, NGW = G * NWAVES;
        bf16* WHGIN = (bf16*)(ws + WS_WHGIN); bf16* WHGOUT = (bf16*)(ws + WS_WHGOUT); bf16* WMLIN = (bf16*)(ws + WS_WMLIN); bf16* WMLOUT = (bf16*)(ws + WS_WMLOUT);
        bf16* W1T = (bf16*)(ws + WS_W1); bf16* W2T = (bf16*)(ws + WS_W2);
        constexpr int S0 = 16 * 160, S1 = 16 * 32, S2 = 16 * 97, S3 = 16 * 32, S4 = 64 * 16 * 64, S5 = 64 * 16 * 32;
        constexpr int NITEMS = S0 + S1 + S2 + S3;
        auto decode = [&](int it) -> TItem { int r = it; TItem t;
            if (r < S0) { t.f8 = 0; t.W = a.in[I_HGWIN]; t.N = HG_N; t.WT = WHGIN; t.drow = (r % 160) * 32; t.k0 = (r / 160) * 64; t.n0 = (r % 160) * 32; return t; } r -= S0;
            if (r < S1) { t.f8 = OUTPROJ_FP8; t.W = a.in[I_HGWOUT]; t.N = D; t.WT = WHGOUT; t.drow = (r % 32) * 32; t.k0 = (r / 32) * 64; t.n0 = (r % 32) * 32; return t; } r -= S1;
            if (r < S2) { t.f8 = 0; t.W = a.in[I_MLWIN]; t.N = ML_N; t.WT = WMLIN; t.drow = (r % 97) * 32; t.k0 = (r / 97) * 64; t.n0 = (r % 97) * 32; return t; } r -= S2;
            if (r < S3) { t.f8 = OUTPROJ_FP8; t.W = a.in[I_MLWOUT]; t.N = D; t.WT = WMLOUT; t.drow = (r % 32) * 32; t.k0 = (r / 32) * 64; t.n0 = (r % 32) * 32; return t; } r -= S3;
            if (r < S4) { const int mat = r >> 10, q = r & 1023, nb = q & 63, kb = q >> 6; const int n0 = nb * 32, cc = n0 & 1023, bj = n0 >> 10;
                t.f8 = 1; t.W = a.in[I_W1] + (size_t)mat * D * 2048; t.N = 2048; t.WT = (bf16*)((unsigned char*)W1T + (size_t)mat * 2048 * D); t.drow = 256 * (cc >> 7) + 128 * bj + (cc & 127); t.k0 = kb * 64; t.n0 = n0; return t; } r -= S4;
            { const int mat = r >> 9, q = r & 511, nb = q & 31, kb = q >> 5;
                t.f8 = 1; t.W = a.in[I_W2] + (size_t)mat * D * D; t.N = D; t.WT = (bf16*)((unsigned char*)W2T + (size_t)mat * D * D); t.drow = nb * 32; t.k0 = kb * 64; t.n0 = nb * 32; return t; } };
        float tv[32]; TItem cur = decode(gw < NITEMS ? gw : 0);
        titem_load(cur, tv, lane);
        for (int it = gw; it < NITEMS; it += NGW) {
#pragma unroll
            for (int i = 0; i < 32; ++i) scr[(2 * i + (lane >> 5)) * 33 + (lane & 31)] = tv[i];
            LDS_WAIT(); asm volatile("" ::: "memory");
            const TItem nxt = decode(it + NGW < NITEMS ? it + NGW : it);
            if (it + NGW < NITEMS) titem_load(nxt, tv, lane);
            const int c = lane & 7;
#pragma unroll
            for (int j = 0; j < 4; ++j) { const int n = (lane >> 3) + 8 * j; const LAS float* sp = scr + (8 * c) * 33 + n;
                if (cur.f8) { v2u o8; o8.x = pk4_fp8(16.f * sp[0 * 33], 16.f * sp[1 * 33], 16.f * sp[2 * 33], 16.f * sp[3 * 33]); o8.y = pk4_fp8(16.f * sp[4 * 33], 16.f * sp[5 * 33], 16.f * sp[6 * 33], 16.f * sp[7 * 33]);
                    *(v2u*)((unsigned char*)cur.WT + (size_t)(cur.drow + n) * D + cur.k0 + 8 * c) = o8; }
                else { v4u o; o.x = pk2(sp[0 * 33], sp[1 * 33]); o.y = pk2(sp[2 * 33], sp[3 * 33]); o.z = pk2(sp[4 * 33], sp[5 * 33]); o.w = pk2(sp[6 * 33], sp[7 * 33]);
                    *(v4u*)(cur.WT + (size_t)(cur.drow + n) * D + cur.k0 + 8 * c) = o; } }
            LDS_WAIT(); asm volatile("" ::: "memory");
            cur = nxt;
        }
        for (size_t i = (size_t)blockIdx.x * NTHREADS + tid; i < (size_t)(ML_NP - ML_N) * D / 8; i += (size_t)G * NTHREADS) ((v4u*)(WMLIN + (size_t)ML_N * D))[i] = (v4u){0u, 0u, 0u, 0u};
    }
    expert_tiles<0>(a, lds, 1 << 30);
}

__device__ __forceinline__ void ph_modulate(ArgsRef a, const float* src_ctx, const float* src_lat, const float* g, int layer, int shift_idx, int R0, int R1, bf16* out) {
    const int tid = threadIdx.x, lane = tid & 63, wave = __builtin_amdgcn_readfirstlane(tid >> 6);
    const float* modl = (const float*)(a.ws + WS_SM + SM_MODL) + (size_t)layer * 16 * 6 * D; const float* modc = (const float*)(a.ws + WS_SM + SM_MODC) + (size_t)layer * 6 * D;
    const int gw = blockIdx.x * NWAVES + wave, NGW = gridDim.x * NWAVES;
    for (int Rq = R0 + gw; Rq < R1; Rq += 2 * NGW) {
        f32x4 v[2][4], sh[2][4], sc[2][4];
#pragma unroll
        for (int u = 0; u < 2; ++u) { const int R = (Rq + u * NGW < R1) ? Rq + u * NGW : Rq;
            const bool isctx = R < NTC;
            const float* xr = isctx ? src_ctx + (size_t)R * D : src_lat + (size_t)(R - NTC) * D;
            const float* mod = isctx ? modc : modl + (size_t)((R - NTC) / SEQ) * 6 * D;
#pragma unroll
            for (int j = 0; j < 4; ++j) { v[u][j] = ((const f32x4*)xr)[64 * j + lane]; sh[u][j] = ((const f32x4*)(mod + shift_idx * D))[64 * j + lane]; sc[u][j] = ((const f32x4*)(mod + (shift_idx + 1) * D))[64 * j + lane]; } }
        __builtin_amdgcn_sched_barrier(0);
#pragma unroll
        for (int u = 0; u < 2; ++u) { const int R = Rq + u * NGW;
            float ss = 0.f;
#pragma unroll
            for (int j = 0; j < 4; ++j) ss += (v[u][j][0] * v[u][j][0] + v[u][j][1] * v[u][j][1]) + (v[u][j][2] * v[u][j][2] + v[u][j][3] * v[u][j][3]);
            const float rs = 1.0f / sqrtf(wave_sum(ss) * (1.0f / D) + EPS);
            if (R < R1) { v2u* o8 = (v2u*)(out + (size_t)R * D);
#pragma unroll
                for (int j = 0; j < 4; ++j) { const f32x4 y = v[u][j] * rs * sc[u][j] + sh[u][j];
                    v2u w; w.x = pk2(y[0], y[1]); w.y = pk2(y[2], y[3]); o8[64 * j + lane] = w; } } }
    }
}

__device__ __forceinline__ int seq_row(int b, int dir, int p) {
    if (p < CTX) { const int t = dir ? CTX - 1 - p : p; return b * CTX + t; }
    const int pl = p - CTX; const int t = dir ? SEQ - 1 - pl : pl; return NTC + b * SEQ + t;
}


typedef short s16x4 __attribute__((ext_vector_type(4)));
typedef float f32x16 __attribute__((ext_vector_type(16)));
__device__ __forceinline__ unsigned offb(unsigned row, unsigned ch) { return 256u * row + 16u * (ch ^ (((row & 3u) << 2) | ((row >> 2) & 3u))); }
__device__ __forceinline__ s16x4 tr16(const LAS unsigned char* p) { return __builtin_amdgcn_ds_read_tr16_b64_v4i16((LAS s16x4*)p); }
__device__ __forceinline__ bf16x8 rd_row_b(const LAS unsigned char* tile, int lane, int rb, int kk) { return *(const LAS bf16x8*)(tile + offb(32 * rb + (lane & 31), 2 * kk + (lane >> 5))); }
__device__ __forceinline__ bf16x8 rd_tr_b(const LAS unsigned char* tile, int lane, int c, int ks) {
    const unsigned h = lane >> 5, blk = (lane >> 4) & 1, q = (lane & 15) >> 2, p = lane & 3;
    const s16x4 x = tr16(tile + offb(16 * ks + 8 * h + q, 4 * c + 2 * blk + (p >> 1)) + 8 * (p & 1));
    const s16x4 y = tr16(tile + offb(16 * ks + 8 * h + 4 + q, 4 * c + 2 * blk + (p >> 1)) + 8 * (p & 1));
    return (bf16x8){x[0], x[1], x[2], x[3], y[0], y[1], y[2], y[3]};
}
__device__ __forceinline__ bf16x8 rd_row_p(const LAS unsigned char* tile, int st, int lane, int rb, int kk) { return *(const LAS bf16x8*)(tile + (32 * rb + (lane & 31)) * st + (16 * kk + 8 * (lane >> 5)) * 2); }
__device__ __forceinline__ bf16x8 rd_tr_p(const LAS unsigned char* tile, int st, int lane, int c, int ks) {
    const unsigned h = lane >> 5, blk = (lane >> 4) & 1, q = (lane & 15) >> 2, p = lane & 3;
    const LAS unsigned char* b = tile + (16 * ks + 8 * h + q) * st + (32 * c + 16 * blk + 4 * p) * 2;
    const s16x4 x = tr16(b), y = tr16(b + 4 * st);
    return (bf16x8){x[0], x[1], x[2], x[3], y[0], y[1], y[2], y[3]};
}
__device__ __forceinline__ void tri_tile(int idx, int& ti4, int& si4) {
    ti4 = idx < 1 ? 0 : idx < 3 ? 1 : idx < 6 ? 2 : 3; si4 = idx - (ti4 * (ti4 + 1)) / 2;
}

__device__ __forceinline__ void ph_hg_scan(ArgsRef a, LAS unsigned char* lds) {
    const int tid = threadIdx.x, lane = tid & 63, w = __builtin_amdgcn_readfirstlane(tid >> 6), hh = lane >> 5, r32 = lane & 31;
    const bf16* QS = (const bf16*)(a.ws + WS_BIG); const bf16* VI = QS + (size_t)NT * D; const bf16* KF = VI + (size_t)NT * D; const bf16* KB = KF + (size_t)NT * D;
    bf16* OF = (bf16*)(a.ws + WS_BIG + 5 * T72); bf16* OB = OF + (size_t)NT * D;
    constexpr int SQ = 272, SV = 320, SA = 144;
    constexpr int O_QA = 0, O_KA = 17408, O_V = 34816, O_ST = 55296, O_ATT = 90112, O_OST = 99328, O_TOT = 116736, O_FIRST = 120832, O_EB = 124928, O_EG = 125440;
    LAS unsigned char* QA = lds + O_QA; LAS unsigned char* KA = lds + O_KA; LAS unsigned char* VT = lds + O_V; LAS unsigned char* ST = lds + O_ST;
    LAS unsigned char* ATT = lds + O_ATT; LAS unsigned char* OST = lds + O_OST;
    LAS float* TOT = (LAS float*)(lds + O_TOT); LAS float* FIRST = (LAS float*)(lds + O_FIRST); LAS float* EB = (LAS float*)(lds + O_EB); LAS float* EG = (LAS float*)(lds + O_EG);
    for (int i = tid; i < 64 * SA / 4; i += NTHREADS) ((LAS unsigned*)ATT)[i] = 0u;
    const int ls = tid >> 4, lc = tid & 15;
    const int tq = (lane & 15) >> 2, tp = lane & 3, tblk = (lane >> 4) & 1;
    const LAS unsigned char* rQA = QA + r32 * SQ + hh * 16;
    const LAS unsigned char* rST = ST + r32 * SQ + hh * 16;
    const LAS unsigned char* rATT = ATT + r32 * SA + hh * 16;
    const LAS unsigned char* tV = VT + (8 * hh + tq) * SV + (16 * tblk + 4 * tp) * 2;
    const LAS unsigned char* tK = KA + (8 * hh + tq) * SQ + (16 * tblk + 4 * tp) * 2;
    const int fr = lane & 15, fq = lane >> 4;
    const int ti = w >> 2, ej = w & 3, di = w >> 1, e2 = 2 * (w & 1);
    for (int item = blockIdx.x; item < 256; item += gridDim.x) {
        const int dir = item & 1, h = (item >> 1) & 7, b = item >> 4;
        const bf16* Kd = dir ? KB : KF; bf16* Od = dir ? OB : OF;
        f32x16 S0, S1;
#pragma unroll
        for (int i = 0; i < 16; ++i) { S0[i] = 0.f; S1[i] = 0.f; }
        v4u pq[2], pk[2], pv[2];
#pragma unroll
        for (int x = 0; x < 2; ++x) { const size_t off = (size_t)seq_row(b, dir, ls + 32 * x) * D + h * 128 + lc * 8; pq[x] = *(const v4u*)(QS + off); pk[x] = *(const v4u*)(Kd + off); pv[x] = *(const v4u*)(VI + off); }
#pragma unroll
        for (int x = 0; x < 2; ++x) { *(LAS v4u*)(QA + (ls + 32 * x) * SQ + lc * 16) = pq[x]; *(LAS v4u*)(KA + (ls + 32 * x) * SQ + lc * 16) = pk[x]; *(LAS v4u*)(VT + (ls + 32 * x) * SV + lc * 16) = pv[x]; }
        for (int ch = 0; ch < (CTX + SEQ) / 64; ++ch) {
            __syncthreads();
            if (ch + 1 < (CTX + SEQ) / 64) {
#pragma unroll
                for (int x = 0; x < 2; ++x) { const size_t off = (size_t)seq_row(b, dir, (ch + 1) * 64 + ls + 32 * x) * D + h * 128 + lc * 8; pq[x] = *(const v4u*)(QS + off); pk[x] = *(const v4u*)(Kd + off); pv[x] = *(const v4u*)(VI + off); }
            }
            unsigned kwv[8], qwv[8]; float l0[8], l1[8];
#pragma unroll
            for (int i = 0; i < 8; ++i) { kwv[i] = *(const LAS unsigned*)(KA + (8 * w + i) * SQ + lane * 4); qwv[i] = *(const LAS unsigned*)(QA + (8 * w + i) * SQ + lane * 4); }
            { float r0 = 0.f, r1 = 0.f;
#pragma unroll
                for (int i = 0; i < 8; ++i) { l0[i] = __builtin_amdgcn_logf(fmaxf(1.0f - bf2f(kwv[i] & 0xffffu), 1e-30f)); l1[i] = __builtin_amdgcn_logf(fmaxf(1.0f - bf2f(kwv[i] >> 16), 1e-30f)); r0 += l0[i]; r1 += l1[i]; }
                *(LAS f32x2*)(TOT + w * 128 + 2 * lane) = (f32x2){r0, r1}; *(LAS f32x2*)(FIRST + w * 128 + 2 * lane) = (f32x2){l0[0], l1[0]}; }
            __syncthreads();
            { float p0 = 0.f, p1 = 0.f, br0 = 0.f, br1 = 0.f, be0 = 0.f, be1 = 0.f; f32x2 tt[8];
#pragma unroll
                for (int o = 0; o < 8; ++o) tt[o] = *(const LAS f32x2*)(TOT + o * 128 + 2 * lane);
                const f32x2 ff = *(const LAS f32x2*)(FIRST + 4 * 128 + 2 * lane);
#pragma unroll
                for (int o = 0; o < 8; ++o) { if (o < w) { p0 += tt[o][0]; p1 += tt[o][1]; } if (o < 4) { br0 += tt[o][0]; br1 += tt[o][1]; } be0 += tt[o][0]; be1 += tt[o][1]; }
                br0 += ff[0]; br1 += ff[1];
#pragma unroll
                for (int i = 0; i < 8; ++i) { p0 += l0[i]; p1 += l1[i];
                    const float ea0 = __builtin_amdgcn_exp2f(p0 - br0), ea1 = __builtin_amdgcn_exp2f(p1 - br1), ek0 = __builtin_amdgcn_exp2f(br0 - p0), ek1 = __builtin_amdgcn_exp2f(br1 - p1);
                    *(LAS unsigned*)(QA + (8 * w + i) * SQ + lane * 4) = pk2(bf2f(qwv[i] & 0xffffu) * ea0, bf2f(qwv[i] >> 16) * ea1);
                    *(LAS unsigned*)(KA + (8 * w + i) * SQ + lane * 4) = pk2(bf2f(kwv[i] & 0xffffu) * ek0, bf2f(kwv[i] >> 16) * ek1); }
                if (w == 0) { *(LAS f32x2*)(EB + 2 * lane) = (f32x2){__builtin_amdgcn_exp2f(br0), __builtin_amdgcn_exp2f(br1)}; *(LAS f32x2*)(EG + 2 * lane) = (f32x2){__builtin_amdgcn_exp2f(be0 - br0), __builtin_amdgcn_exp2f(be1 - br1)}; } }
            __syncthreads();
            {
                f32x4 eb[4], eg[4];
#pragma unroll
                for (int g = 0; g < 4; ++g) { eb[g] = *(const LAS f32x4*)(EB + 32 * di + 8 * g + 4 * hh); eg[g] = *(const LAS f32x4*)(EG + 32 * di + 8 * g + 4 * hh); }
                bf16x8 kA[4], vB0[4], vB1[4];
#pragma unroll
                for (int kk = 0; kk < 4; ++kk) { const LAS unsigned char* pa = tK + kk * 16 * SQ + di * 64; const s16x4 x = tr16(pa), y = tr16(pa + 4 * SQ); kA[kk] = (bf16x8){x[0], x[1], x[2], x[3], y[0], y[1], y[2], y[3]}; }
#pragma unroll
                for (int kk = 0; kk < 4; ++kk) { const LAS unsigned char* pb = tV + kk * 16 * SV + e2 * 64; const s16x4 x = tr16(pb), y = tr16(pb + 4 * SV), x2 = tr16(pb + 64), y2 = tr16(pb + 64 + 4 * SV);
                    vB0[kk] = (bf16x8){x[0], x[1], x[2], x[3], y[0], y[1], y[2], y[3]}; vB1[kk] = (bf16x8){x2[0], x2[1], x2[2], x2[3], y2[0], y2[1], y2[2], y2[3]}; }
#pragma unroll
                for (int rep = 0; rep < 2; ++rep) { const int idx = w + 8 * rep; if (idx < 10) { int ti4, si4; tri_tile(idx, ti4, si4);
                    bf16x8 A[4], Bm[4];
#pragma unroll
                    for (int kk = 0; kk < 4; ++kk) { A[kk] = *(const LAS bf16x8*)(QA + (16 * ti4 + fr) * SQ + fq * 16 + kk * 64); Bm[kk] = *(const LAS bf16x8*)(KA + (16 * si4 + fr) * SQ + fq * 16 + kk * 64); }
                    f32x4 acc = (f32x4){0.f, 0.f, 0.f, 0.f};
#pragma unroll
                    for (int kk = 0; kk < 4; ++kk) acc = __builtin_amdgcn_mfma_f32_16x16x32_bf16(A[kk], Bm[kk], acc, 0, 0, 0);
                    const int scol = 16 * si4 + fr;
#pragma unroll
                    for (int r = 0; r < 4; ++r) { const int trow = 16 * ti4 + 4 * fq + r; *(LAS unsigned short*)(ATT + trow * SA + scol * 2) = (unsigned short)f2bf(scol <= trow ? acc[r] : 0.f); } } }
#pragma unroll
                for (int g = 0; g < 4; ++g) {
#pragma unroll
                    for (int j = 0; j < 4; ++j) { S0[4 * g + j] *= eb[g][j]; S1[4 * g + j] *= eb[g][j]; }
                    v2u w0, w1; w0.x = pk2(S0[4 * g], S0[4 * g + 1]); w0.y = pk2(S0[4 * g + 2], S0[4 * g + 3]); w1.x = pk2(S1[4 * g], S1[4 * g + 1]); w1.y = pk2(S1[4 * g + 2], S1[4 * g + 3]);
                    *(LAS v2u*)(ST + (32 * e2 + r32) * SQ + (32 * di + 8 * g + 4 * hh) * 2) = w0; *(LAS v2u*)(ST + (32 * e2 + 32 + r32) * SQ + (32 * di + 8 * g + 4 * hh) * 2) = w1; }
#pragma unroll
                for (int kk = 0; kk < 4; ++kk) { S0 = __builtin_amdgcn_mfma_f32_32x32x16_bf16(kA[kk], vB0[kk], S0, 0, 0, 0); S1 = __builtin_amdgcn_mfma_f32_32x32x16_bf16(kA[kk], vB1[kk], S1, 0, 0, 0); }
#pragma unroll
                for (int g = 0; g < 4; ++g)
#pragma unroll
                    for (int j = 0; j < 4; ++j) { S0[4 * g + j] *= eg[g][j]; S1[4 * g + j] *= eg[g][j]; }
            }
            __syncthreads();
            { f32x16 o;
#pragma unroll
                for (int i = 0; i < 16; ++i) o[i] = 0.f;
                bf16x8 A[4], Bm[4];
#pragma unroll
                for (int kk = 0; kk < 4; ++kk) { A[kk] = *(const LAS bf16x8*)(rATT + ti * 32 * SA + kk * 32); const LAS unsigned char* pb = tV + kk * 16 * SV + ej * 64; const s16x4 x = tr16(pb), y = tr16(pb + 4 * SV); Bm[kk] = (bf16x8){x[0], x[1], x[2], x[3], y[0], y[1], y[2], y[3]}; }
                bf16x8 A2[4], B2[4];
#pragma unroll
                for (int kk = 0; kk < 4; ++kk) { A2[kk] = *(const LAS bf16x8*)(rQA + ti * 32 * SQ + kk * 32); B2[kk] = *(const LAS bf16x8*)(rST + ej * 32 * SQ + kk * 32); }
#pragma unroll
                for (int kk = 0; kk < 4; ++kk) o = __builtin_amdgcn_mfma_f32_32x32x16_bf16(A[kk], Bm[kk], o, 0, 0, 0);
#pragma unroll
                for (int kk = 0; kk < 4; ++kk) { A[kk] = *(const LAS bf16x8*)(rQA + ti * 32 * SQ + (kk + 4) * 32); Bm[kk] = *(const LAS bf16x8*)(rST + ej * 32 * SQ + (kk + 4) * 32); }
#pragma unroll
                for (int kk = 0; kk < 4; ++kk) o = __builtin_amdgcn_mfma_f32_32x32x16_bf16(A2[kk], B2[kk], o, 0, 0, 0);
#pragma unroll
                for (int kk = 0; kk < 4; ++kk) o = __builtin_amdgcn_mfma_f32_32x32x16_bf16(A[kk], Bm[kk], o, 0, 0, 0);
                const int ecol = 32 * ej + r32;
#pragma unroll
                for (int r = 0; r < 16; ++r) { const int trow = 32 * ti + (r & 3) + 8 * (r >> 2) + 4 * hh; *(LAS unsigned short*)(OST + trow * SQ + ecol * 2) = (unsigned short)f2bf(o[r]); } }
            __syncthreads();
            if (ch + 1 < (CTX + SEQ) / 64) {
#pragma unroll
                for (int x = 0; x < 2; ++x) { *(LAS v4u*)(QA + (ls + 32 * x) * SQ + lc * 16) = pq[x]; *(LAS v4u*)(KA + (ls + 32 * x) * SQ + lc * 16) = pk[x]; *(LAS v4u*)(VT + (ls + 32 * x) * SV + lc * 16) = pv[x]; } }
#pragma unroll
            for (int x = 0; x < 2; ++x) { const int row = ls + 32 * x; const v4u val = *(const LAS v4u*)(OST + row * SQ + lc * 16);
                *(v4u*)(Od + (size_t)seq_row(b, dir, ch * 64 + row) * D + h * 128 + lc * 8) = val; }
        }
        __syncthreads();
    }
}


__device__ __forceinline__ float wave_incl_sum(float v) {
    v += dppf<0x111, 0xf>(0.f, v); v += dppf<0x112, 0xf>(0.f, v); v += dppf<0x114, 0xf>(0.f, v); v += dppf<0x118, 0xf>(0.f, v);
    v += dppf<0x142, 0xa>(0.f, v); v += dppf<0x143, 0xc>(0.f, v); return v;
}
__device__ __forceinline__ float wave_incl_max(float v) {
    const float ninf = -3.0e38f;
    v = fmaxf(v, dppf<0x111, 0xf>(ninf, v)); v = fmaxf(v, dppf<0x112, 0xf>(ninf, v)); v = fmaxf(v, dppf<0x114, 0xf>(ninf, v)); v = fmaxf(v, dppf<0x118, 0xf>(ninf, v));
    v = fmaxf(v, dppf<0x142, 0xa>(ninf, v)); v = fmaxf(v, dppf<0x143, 0xc>(ninf, v)); return v;
}
__device__ __forceinline__ void ph_ml_scan(ArgsRef a, LAS unsigned char* lds) {
    const int tid = threadIdx.x, lane = tid & 63, w = __builtin_amdgcn_readfirstlane(tid >> 6), hh = lane >> 5, r32 = lane & 31;
    const bf16* QK = (const bf16*)(a.ws + WS_BIG + 3 * T72); const bf16* VV = (const bf16*)(a.ws + WS_BIG + 1 * T72);
    bf16* HF = (bf16*)(a.ws + WS_BIG + 4 * T72); bf16* HB = (bf16*)(a.ws + WS_BIG + 5 * T72);
    const float* Gt = (const float*)(a.ws + WS_GT);
    constexpr int SA = 144, SO = 272, SV = 320;
    constexpr int O_Q = 0, O_K = 9216, O_KW = 18432, O_SC = 27648, O_V = 36864, O_CT = 57344, O_OST = 75776, O_VEC = 93184, O_NP = 95488;
    LAS unsigned char* Qt = lds + O_Q; LAS unsigned char* Kt = lds + O_K; LAS unsigned char* KW = lds + O_KW; LAS unsigned char* SC = lds + O_SC;
    LAS unsigned char* VT = lds + O_V; LAS unsigned char* CT = lds + O_CT; LAS unsigned char* OST = lds + O_OST;
    LAS float* vA = (LAS float*)(lds + O_VEC); LAS float* vM = vA + 64; LAS float* vWI = vM + 64; LAS float* vEMM = vWI + 64; LAS float* vWK = vEMM + 64;
    LAS float* vRI = vWK + 64; LAS float* vWIRI = vRI + 64; LAS float* vN = vWIRI + 64; LAS float* vSC = vN + 64;
    LAS float* NP = (LAS float*)(lds + O_NP);
    for (int i = tid; i < 64 * SA / 4; i += NTHREADS) ((LAS unsigned*)SC)[i] = 0u;
    const int ls = tid >> 4, lc = tid & 15;
    const int qs = tid >> 3, qc = tid & 7;
    const int tq = (lane & 15) >> 2, tp = lane & 3, tblk = (lane >> 4) & 1;
    const LAS unsigned char* tV = VT + (8 * hh + tq) * SV + (16 * tblk + 4 * tp) * 2;
    const LAS unsigned char* tKW = KW + (8 * hh + tq) * SA + (16 * tblk + 4 * tp) * 2;
    const int fr = lane & 15, fq = lane >> 4;
    const int ti = w >> 2, ej = w & 3, di = w >> 2;
    for (int item = blockIdx.x; item < 256; item += gridDim.x) {
        const int dir = item & 1, h = (item >> 1) & 7, b = item >> 4;
        bf16* Hd = dir ? HB : HF;
        const int ci = dir * 8 + h, cf = 16 + dir * 8 + h;
        f32x16 Cs;
#pragma unroll
        for (int i = 0; i < 16; ++i) Cs[i] = 0.f;
        for (int i = tid; i < 128 * SA / 4; i += NTHREADS) ((LAS unsigned*)CT)[i] = 0u;
        if (tid < 64) vN[tid] = 0.f;
        NP[tid] = 0.f;
        float m0 = 0.f, m0n = 0.f, dec_prev = 0.f;
        v4u pq, pk, pv[2]; float pgi = 0.f, pgf = 0.f;
        { const size_t ro = (size_t)seq_row(b, dir, qs) * D; pq = *(const v4u*)(QK + ro + h * 64 + qc * 8); pk = *(const v4u*)(QK + ro + 512 + h * 64 + qc * 8);
#pragma unroll
            for (int x = 0; x < 2; ++x) pv[x] = *(const v4u*)(VV + (size_t)seq_row(b, dir, ls + 32 * x) * D + h * 128 + lc * 8);
            if (tid < 64) { const float* gr = Gt + (size_t)seq_row(b, dir, tid) * 32; pgi = gr[ci]; pgf = gr[cf]; } }
        __syncthreads();
#define ML_S0() do { \
            *(LAS v4u*)(Qt + qs * SA + qc * 16) = pq; *(LAS v4u*)(Kt + qs * SA + qc * 16) = pk; \
            _Pragma("unroll") for (int x = 0; x < 2; ++x) *(LAS v4u*)(VT + (ls + 32 * x) * SV + lc * 16) = pv[x]; \
            if (w == 0) { \
                float np[8]; \
                _Pragma("unroll") for (int o = 0; o < 8; ++o) np[o] = NP[o * 64 + lane]; \
                const float nold = vN[lane]; \
                const float bb = wave_incl_sum(pgf); \
                const float aa = pgi - bb; const float cm = wave_incl_max(aa); \
                const float M = fmaxf(m0, cm), M63 = __shfl(M, 63), bend = __shfl(bb, 63); \
                vA[lane] = aa; vM[lane] = M; vWI[lane] = __expf(m0 - M); vEMM[lane] = __expf(-(bb + M)); vWK[lane] = __expf(aa - M63); \
                const float dec = __expf(m0 - M63); \
                if (lane == 0) vSC[0] = dec; \
                vN[lane] = dec_prev * nold + (((np[0] + np[1]) + (np[2] + np[3])) + ((np[4] + np[5]) + (np[6] + np[7]))); \
                dec_prev = dec; m0n = bend + M63; \
            } } while (0)
        ML_S0();
        for (int ch = 0; ch < (CTX + SEQ) / 64; ++ch) {
            __syncthreads();
            if (ch + 1 < (CTX + SEQ) / 64) { const size_t ro = (size_t)seq_row(b, dir, (ch + 1) * 64 + qs) * D; pq = *(const v4u*)(QK + ro + h * 64 + qc * 8); pk = *(const v4u*)(QK + ro + 512 + h * 64 + qc * 8);
#pragma unroll
                for (int x = 0; x < 2; ++x) pv[x] = *(const v4u*)(VV + (size_t)seq_row(b, dir, (ch + 1) * 64 + ls + 32 * x) * D + h * 128 + lc * 8);
                if (tid < 64) { const float* gr = Gt + (size_t)seq_row(b, dir, (ch + 1) * 64 + tid) * 32; pgi = gr[ci]; pgf = gr[cf]; } }
            {
                const v4u kv = *(const LAS v4u*)(Kt + qs * SA + qc * 16); const float wk = vWK[qs];
#pragma unroll
                for (int rep = 0; rep < 2; ++rep) { const int idx = w + 8 * rep; if (idx < 10) { int ti4, si4; tri_tile(idx, ti4, si4);
                    const bf16x8 A0 = *(const LAS bf16x8*)(Qt + (16 * ti4 + fr) * SA + fq * 16), A1 = *(const LAS bf16x8*)(Qt + (16 * ti4 + fr) * SA + fq * 16 + 64);
                    const bf16x8 B0 = *(const LAS bf16x8*)(Kt + (16 * si4 + fr) * SA + fq * 16), B1 = *(const LAS bf16x8*)(Kt + (16 * si4 + fr) * SA + fq * 16 + 64);
                    const int scol = 16 * si4 + fr; const float as = vA[scol]; const f32x4 M4 = *(const LAS f32x4*)(vM + 16 * ti4 + 4 * fq);
                    f32x4 acc = (f32x4){0.f, 0.f, 0.f, 0.f};
                    acc = __builtin_amdgcn_mfma_f32_16x16x32_bf16(A0, B0, acc, 0, 0, 0); acc = __builtin_amdgcn_mfma_f32_16x16x32_bf16(A1, B1, acc, 0, 0, 0);
#pragma unroll
                    for (int r = 0; r < 4; ++r) { const int trow = 16 * ti4 + 4 * fq + r; *(LAS unsigned short*)(SC + trow * SA + scol * 2) = (unsigned short)f2bf(scol <= trow ? acc[r] * __expf(as - M4[r]) : 0.f); } } }
                const unsigned kx[4] = {kv.x, kv.y, kv.z, kv.w}; v4u o; float kf[8];
#pragma unroll
                for (int j = 0; j < 4; ++j) { kf[2 * j] = bf2f(kx[j] & 0xffffu) * wk; kf[2 * j + 1] = bf2f(kx[j] >> 16) * wk; }
                o.x = pk2(kf[0], kf[1]); o.y = pk2(kf[2], kf[3]); o.z = pk2(kf[4], kf[5]); o.w = pk2(kf[6], kf[7]);
                *(LAS v4u*)(KW + qs * SA + qc * 16) = o; }
            __syncthreads();
            f32x16 accA, accB;
            { const v4u sv = *(const LAS v4u*)(SC + qs * SA + qc * 16), qv = *(const LAS v4u*)(Qt + qs * SA + qc * 16); const f32x4 n0 = *(const LAS f32x4*)(vN + 8 * qc), n1 = *(const LAS f32x4*)(vN + 8 * qc + 4);
                const float wi = vWI[qs], emm = vEMM[qs], dec = vSC[0];
                unsigned short kwc[8];
#pragma unroll
                for (int i = 0; i < 8; ++i) kwc[i] = *(const LAS unsigned short*)(KW + (8 * w + i) * SA + lane * 2);
                bf16x8 A[4], Bm[4], A2[4], B2[4];
#pragma unroll
                for (int kk = 0; kk < 4; ++kk) { A[kk] = *(const LAS bf16x8*)(SC + (32 * ti + r32) * SA + hh * 16 + kk * 32); const LAS unsigned char* pb = tV + kk * 16 * SV + ej * 64; const s16x4 x = tr16(pb), y = tr16(pb + 4 * SV); Bm[kk] = (bf16x8){x[0], x[1], x[2], x[3], y[0], y[1], y[2], y[3]}; }
#pragma unroll
                for (int kk = 0; kk < 4; ++kk) { A2[kk] = *(const LAS bf16x8*)(Qt + (32 * ti + r32) * SA + hh * 16 + kk * 32); B2[kk] = *(const LAS bf16x8*)(CT + (32 * ej + r32) * SA + hh * 16 + kk * 32); }
                const unsigned sx[4] = {sv.x, sv.y, sv.z, sv.w}, qx[4] = {qv.x, qv.y, qv.z, qv.w};
                float ssum = 0.f;
#pragma unroll
                for (int j = 0; j < 4; ++j) { ssum += bf2f(sx[j] & 0xffffu) + bf2f(sx[j] >> 16); }
                const float dot = bf2f(qx[0] & 0xffffu) * n0[0] + bf2f(qx[0] >> 16) * n0[1] + bf2f(qx[1] & 0xffffu) * n0[2] + bf2f(qx[1] >> 16) * n0[3]
                    + bf2f(qx[2] & 0xffffu) * n1[0] + bf2f(qx[2] >> 16) * n1[1] + bf2f(qx[3] & 0xffffu) * n1[2] + bf2f(qx[3] >> 16) * n1[3];
                float part = ssum + wi * dot;
                part += __shfl_xor(part, 1); part += __shfl_xor(part, 2); part += __shfl_xor(part, 4);
                if (qc == 0) { const float rinv = 1.0f / fmaxf(fabsf(part), emm); vRI[qs] = rinv; vWIRI[qs] = wi * rinv; }
                { float cs = 0.f;
#pragma unroll
                    for (int i = 0; i < 8; ++i) cs += bf2f(kwc[i]);
                    NP[w * 64 + lane] = cs; }
#pragma unroll
                for (int i = 0; i < 16; ++i) { accA[i] = 0.f; accB[i] = 0.f; }
#pragma unroll
                for (int kk = 0; kk < 4; ++kk) accA = __builtin_amdgcn_mfma_f32_32x32x16_bf16(A[kk], Bm[kk], accA, 0, 0, 0);
#pragma unroll
                for (int kk = 0; kk < 4; ++kk) { const LAS unsigned char* pa = tKW + kk * 16 * SA + di * 64; const s16x4 x = tr16(pa), y = tr16(pa + 4 * SA); A[kk] = (bf16x8){x[0], x[1], x[2], x[3], y[0], y[1], y[2], y[3]}; }
#pragma unroll
                for (int kk = 0; kk < 4; ++kk) accB = __builtin_amdgcn_mfma_f32_32x32x16_bf16(A2[kk], B2[kk], accB, 0, 0, 0);
#pragma unroll
                for (int i = 0; i < 16; ++i) Cs[i] *= dec;
#pragma unroll
                for (int kk = 0; kk < 4; ++kk) Cs = __builtin_amdgcn_mfma_f32_32x32x16_bf16(A[kk], Bm[kk], Cs, 0, 0, 0); }
            __syncthreads();
            { const int ecol = 32 * ej + r32;
                f32x4 ri[4], wr[4];
#pragma unroll
                for (int g = 0; g < 4; ++g) { ri[g] = *(const LAS f32x4*)(vRI + 32 * ti + 8 * g + 4 * hh); wr[g] = *(const LAS f32x4*)(vWIRI + 32 * ti + 8 * g + 4 * hh); }
#pragma unroll
                for (int g = 0; g < 4; ++g) {
#pragma unroll
                    for (int j = 0; j < 4; ++j) { const int trow = 32 * ti + 8 * g + 4 * hh + j; *(LAS unsigned short*)(OST + trow * SO + ecol * 2) = (unsigned short)f2bf(accA[4 * g + j] * ri[g][j] + accB[4 * g + j] * wr[g][j]); }
                    v2u cw; cw.x = pk2(Cs[4 * g], Cs[4 * g + 1]); cw.y = pk2(Cs[4 * g + 2], Cs[4 * g + 3]);
                    *(LAS v2u*)(CT + ecol * SA + (32 * di + 8 * g + 4 * hh) * 2) = cw; }
                m0 = m0n; }
            __syncthreads();
            if (ch + 1 < (CTX + SEQ) / 64) ML_S0();
            if (ch >= CTX / 64) {
#pragma unroll
                for (int x = 0; x < 2; ++x) { const int row = ls + 32 * x; const v4u val = *(const LAS v4u*)(OST + row * SO + lc * 16);
                    *(v4u*)(Hd + (size_t)seq_row(b, dir, ch * 64 + row) * D + h * 128 + lc * 8) = val; } }
        }
#undef ML_S0
        __syncthreads();
    }
}

template <bool F8> __device__ __forceinline__ void ph_readout(const bf16* Oa, const bf16* Ob, const bf16* gate, const float* g, int R0, int R1, bf16* Y) {
    const int tid = threadIdx.x, lane = tid & 63, wave = __builtin_amdgcn_readfirstlane(tid >> 6);
    const int gw = blockIdx.x * NWAVES + wave, NGW = gridDim.x * NWAVES;
    f32x4 gg[4];
#pragma unroll
    for (int j4 = 0; j4 < 4; ++j4) gg[j4] = *(const f32x4*)(g + lane * 16 + j4 * 4);
    for (int Rq = R0 + gw; Rq < R1; Rq += 2 * NGW) {
        v4u x[2][2], y[2][2], z[2][2];
#pragma unroll
        for (int u = 0; u < 2; ++u) { const int R = (Rq + u * NGW < R1) ? Rq + u * NGW : Rq; const size_t off = (size_t)R * D + lane * 16;
#pragma unroll
            for (int hh = 0; hh < 2; ++hh) { x[u][hh] = *(const v4u*)(Oa + off + hh * 8); y[u][hh] = *(const v4u*)(Ob + off + hh * 8); z[u][hh] = *(const v4u*)(gate + off + hh * 8); } }
        __builtin_amdgcn_sched_barrier(0);
#pragma unroll
        for (int u = 0; u < 2; ++u) { const int R = Rq + u * NGW; const size_t off = (size_t)R * D + lane * 16;
            float o[16], gt[16]; float ss = 0.f;
#pragma unroll
            for (int hh = 0; hh < 2; ++hh) {
                const unsigned xx[4] = {x[u][hh].x, x[u][hh].y, x[u][hh].z, x[u][hh].w}, yy[4] = {y[u][hh].x, y[u][hh].y, y[u][hh].z, y[u][hh].w}, zz[4] = {z[u][hh].x, z[u][hh].y, z[u][hh].z, z[u][hh].w};
#pragma unroll
                for (int j = 0; j < 4; ++j) { o[hh * 8 + 2 * j] = bf2f(xx[j] & 0xffffu) + bf2f(yy[j] & 0xffffu); o[hh * 8 + 2 * j + 1] = bf2f(xx[j] >> 16) + bf2f(yy[j] >> 16);
                    gt[hh * 8 + 2 * j] = bf2f(zz[j] & 0xffffu); gt[hh * 8 + 2 * j + 1] = bf2f(zz[j] >> 16); } }
#pragma unroll
            for (int j = 0; j < 16; ++j) ss += o[j] * o[j];
            ss += __shfl_xor(ss, 1); ss += __shfl_xor(ss, 2); ss += __shfl_xor(ss, 4);
            const float rs = 1.0f / sqrtf(ss * (1.0f / 128.0f) + EPS);
            float yv[16];
#pragma unroll
            for (int j4 = 0; j4 < 4; ++j4)
#pragma unroll
                for (int j = 0; j < 4; ++j) yv[j4 * 4 + j] = o[j4 * 4 + j] * rs * gg[j4][j] * gt[j4 * 4 + j];
            if (F8) { if (R < R1) { v4u w; w.x = pk4_fp8(yv[0], yv[1], yv[2], yv[3]); w.y = pk4_fp8(yv[4], yv[5], yv[6], yv[7]); w.z = pk4_fp8(yv[8], yv[9], yv[10], yv[11]); w.w = pk4_fp8(yv[12], yv[13], yv[14], yv[15]);
                    *(v4u*)((unsigned char*)Y + (size_t)R * D + lane * 16) = w; } }
            else if (R < R1) { v4u w0, w1; w0.x = pk2(yv[0], yv[1]); w0.y = pk2(yv[2], yv[3]); w0.z = pk2(yv[4], yv[5]); w0.w = pk2(yv[6], yv[7]);
                w1.x = pk2(yv[8], yv[9]); w1.y = pk2(yv[10], yv[11]); w1.z = pk2(yv[12], yv[13]); w1.w = pk2(yv[14], yv[15]);
                *(v4u*)(Y + off) = w0; *(v4u*)(Y + off + 8) = w1; } }
    }
}

struct MoeTab { LAS int* pstart; LAS int* cnt; LAS int* nblk; LAS int* blkE; };
__device__ __forceinline__ MoeTab moe_tab(LAS unsigned char* lds) { MoeTab t; t.pstart = (LAS int*)(lds + LDS_TAB); t.cnt = t.pstart + 36; t.nblk = t.cnt + 32; t.blkE = t.nblk + 4; return t; }
__device__ __forceinline__ void moe_tables(ArgsRef a, int layer, LAS unsigned char* lds) {
    const MoeTab t = moe_tab(lds);
    const unsigned* cnt = (const unsigned*)(a.ws + WS_CTL) + CW_CNT + 64 * layer;
    __syncthreads();
    if (threadIdx.x < 32) t.cnt[threadIdx.x] = (int)__hip_atomic_load(cnt + threadIdx.x, __ATOMIC_RELAXED, __HIP_MEMORY_SCOPE_AGENT);
    __syncthreads();
    if (threadIdx.x < 64) { const int e = threadIdx.x & 31; const int nb = (t.cnt[e] + 255) >> 8; int incl = nb;
#pragma unroll
        for (int o = 1; o < 32; o <<= 1) { const int v = __shfl_up(incl, o, 32); if (e >= o) incl += v; }
        const int p0 = incl - nb;
        if (threadIdx.x < 32) { t.pstart[e] = p0 * 256; for (int j = 0; j < nb; ++j) t.blkE[p0 + j] = e; if (e == 31) { t.pstart[32] = incl * 256; t.nblk[0] = incl; } } }
    __syncthreads();
}

__device__ __forceinline__ void ph_router(ArgsRef a, const bf16* X, const float* g, int layer, int R0, int R1, bf16* Fout, LAS unsigned char* lds) {
    const int tid = threadIdx.x, lane = tid & 63, wave = __builtin_amdgcn_readfirstlane(tid >> 6), G = gridDim.x;
    const int fr = lane & 15, fq = lane >> 4;
    const float* modl = (const float*)(a.ws + WS_SM + SM_MODL) + (size_t)layer * 16 * 6 * D; const float* modc = (const float*)(a.ws + WS_SM + SM_MODC) + (size_t)layer * 6 * D;
    constexpr int APITCH = 2 * D + 16;
    constexpr int PPITCH = 36;
    LAS unsigned char* Ahi = lds; LAS unsigned char* Alo = lds + 16 * APITCH;
    LAS float* P = (LAS float*)(lds + 32 * APITCH);
    LAS int* cntL = (LAS int*)(lds + LDS_TAB);
    LAS int* baseL = cntL + 32;
    LAS int* infoL = baseL + 32;
    int* slot = (int*)(a.ws + WS_SLOT); float* gate = (float*)(a.ws + WS_GATE); int* rte = (int*)(a.ws + WS_RTE);
    unsigned* cntG = (unsigned*)(a.ws + WS_CTL) + CW_CNT + 64 * layer;
    const float* rw = a.in[I_RW] + (size_t)layer * D * NE; const float* rb = a.in[I_RB] + layer * NE;
    bf16x8 Bh[4][2], Bl[4][2];
#pragma unroll
    for (int kk = 0; kk < 4; ++kk)
#pragma unroll
        for (int nt = 0; nt < 2; ++nt) { v4u h, l;
#pragma unroll
            for (int j = 0; j < 4; ++j) { const float* wp = rw + (size_t)(32 * (4 * wave + kk) + 8 * fq + 2 * j) * NE + 16 * nt + fr; const float w0v = wp[0], w1v = wp[NE];
                const unsigned hh = pk2(w0v, w1v); h[j] = hh; l[j] = pk2(w0v - bf2f(hh & 0xffffu), w1v - bf2f(hh >> 16)); }
            Bh[kk][nt] = __builtin_bit_cast(bf16x8, h); Bl[kk][nt] = __builtin_bit_cast(bf16x8, l); }
    if (tid < 32) cntL[tid] = 0;
    const int nrows = R1 - R0, per = (nrows + G - 1) / G;
    const int w0 = R0 + blockIdx.x * per, w1 = (w0 + per < R1) ? w0 + per : R1;
    const int ntile = (w1 > w0) ? (w1 - w0 + 15) >> 4 : 0;
    __syncthreads();
    v2u xq[2][4]; f32x4 shq[2][4], scq[2][4];
    if (ntile > 0) {
#pragma unroll
        for (int rr = 0; rr < 2; ++rr) { const int R = (w0 + 2 * wave + rr < w1) ? w0 + 2 * wave + rr : w1 - 1;
            const float* mod = (R < NTC) ? modc : modl + (size_t)((R - NTC) / SEQ) * 6 * D;
#pragma unroll
            for (int j = 0; j < 4; ++j) { xq[rr][j] = ((const v2u*)(X + (size_t)R * D))[64 * j + lane]; shq[rr][j] = ((const f32x4*)(mod + 3 * D))[64 * j + lane]; scq[rr][j] = ((const f32x4*)(mod + 4 * D))[64 * j + lane]; } }
    }
    for (int ti = 0; ti < ntile; ++ti) {
        const int r = w0 + 16 * ti + 2 * wave;
#pragma unroll
        for (int rr = 0; rr < 2; ++rr) {
            const int R = (r + rr < w1) ? r + rr : w1 - 1;
            f32x4 v[4]; float ss = 0.f;
#pragma unroll
            for (int j = 0; j < 4; ++j) { const v2u xw = xq[rr][j]; v[j] = (f32x4){bf2f(xw.x & 0xffffu), bf2f(xw.x >> 16), bf2f(xw.y & 0xffffu), bf2f(xw.y >> 16)}; ss += (v[j][0] * v[j][0] + v[j][1] * v[j][1]) + (v[j][2] * v[j][2] + v[j][3] * v[j][3]); }
            const float rs = 1.0f / sqrtf(wave_sum(ss) * (1.0f / D) + EPS);
            unsigned* o8 = (unsigned*)((unsigned char*)Fout + (size_t)R * D);
            LAS unsigned char* ah = Ahi + (2 * wave + rr) * APITCH + 8 * lane; LAS unsigned char* al = Alo + (2 * wave + rr) * APITCH + 8 * lane;
#pragma unroll
            for (int j = 0; j < 4; ++j) { const f32x4 f = v[j] * rs * scq[rr][j] + shq[rr][j];
                if (r + rr < w1) o8[64 * j + lane] = pk4_fp8(f[0], f[1], f[2], f[3]);
                const unsigned h0 = pk2(f[0], f[1]), h1 = pk2(f[2], f[3]);
                *(LAS v2u*)(ah + 512 * j) = (v2u){h0, h1};
                *(LAS v2u*)(al + 512 * j) = (v2u){pk2(f[0] - bf2f(h0 & 0xffffu), f[1] - bf2f(h0 >> 16)), pk2(f[2] - bf2f(h1 & 0xffffu), f[3] - bf2f(h1 >> 16))}; }
            if (ti + 1 < ntile) { const int Rn = (r + 16 + rr < w1) ? r + 16 + rr : w1 - 1;
                const float* mod = (Rn < NTC) ? modc : modl + (size_t)((Rn - NTC) / SEQ) * 6 * D;
#pragma unroll
                for (int j = 0; j < 4; ++j) { xq[rr][j] = ((const v2u*)(X + (size_t)Rn * D))[64 * j + lane]; shq[rr][j] = ((const f32x4*)(mod + 3 * D))[64 * j + lane]; scq[rr][j] = ((const f32x4*)(mod + 4 * D))[64 * j + lane]; } }
        }
        __syncthreads();
        f32x4 acc[2] = {(f32x4){0.f, 0.f, 0.f, 0.f}, (f32x4){0.f, 0.f, 0.f, 0.f}};
#pragma unroll
        for (int kk = 0; kk < 4; ++kk) {
            const bf16x8 ahf = *(const LAS bf16x8*)(Ahi + fr * APITCH + 64 * (4 * wave + kk) + 16 * fq);
            const bf16x8 alf = *(const LAS bf16x8*)(Alo + fr * APITCH + 64 * (4 * wave + kk) + 16 * fq);
#pragma unroll
            for (int nt = 0; nt < 2; ++nt) {
                acc[nt] = __builtin_amdgcn_mfma_f32_16x16x32_bf16(alf, Bh[kk][nt], acc[nt], 0, 0, 0);
                acc[nt] = __builtin_amdgcn_mfma_f32_16x16x32_bf16(ahf, Bl[kk][nt], acc[nt], 0, 0, 0);
                acc[nt] = __builtin_amdgcn_mfma_f32_16x16x32_bf16(ahf, Bh[kk][nt], acc[nt], 0, 0, 0); }
        }
#pragma unroll
        for (int nt = 0; nt < 2; ++nt)
#pragma unroll
            for (int i = 0; i < 4; ++i) P[(wave * 16 + 4 * fq + i) * PPITCH + 16 * nt + fr] = acc[nt][i];
        __syncthreads();
        const int ex = lane & 31;
        float val = rb[ex];
#pragma unroll
        for (int w = 0; w < 8; ++w) val += P[(w * 16 + 2 * wave + (lane >> 5)) * PPITCH + ex];
        const unsigned bits = __float_as_uint(val);
        unsigned key = ((bits ^ ((unsigned)((int)bits >> 31) | 0x80000000u)) & ~31u) | (unsigned)(31 - ex);
        int te[4];
#pragma unroll
        for (int k = 0; k < 4; ++k) { unsigned m = key;
            m = max(m, (unsigned)__builtin_amdgcn_update_dpp((int)m, (int)m, 0x128, 0xf, 0xf, false));
            m = max(m, (unsigned)__builtin_amdgcn_update_dpp((int)m, (int)m, 0x124, 0xf, 0xf, false));
            m = max(m, (unsigned)__builtin_amdgcn_update_dpp((int)m, (int)m, 0x122, 0xf, 0xf, false));
            m = max(m, (unsigned)__builtin_amdgcn_update_dpp((int)m, (int)m, 0x121, 0xf, 0xf, false));
            const auto sw = __builtin_amdgcn_permlane16_swap(m, m, false, false); m = max((unsigned)sw[0], (unsigned)sw[1]);
            te[k] = 31 - (int)(m & 31u); if (ex == te[k]) key = 0u; }
        float tv[4];
#pragma unroll
        for (int k = 0; k < 4; ++k) tv[k] = __shfl(val, (lane & 32) | te[k]);
        const float e1 = __expf(tv[1] - tv[0]), e2 = __expf(tv[2] - tv[0]), e3 = __expf(tv[3] - tv[0]); const float inv = 1.0f / (1.0f + e1 + e2 + e3);
        const int R = r + (lane >> 5);
        if (ex < 4 && R < w1) {
            const int es = ex == 0 ? te[0] : ex == 1 ? te[1] : ex == 2 ? te[2] : te[3];
            const float gs = (ex == 0 ? 1.0f : ex == 1 ? e1 : ex == 2 ? e2 : e3) * inv;
            const int lr = __hip_atomic_fetch_add(cntL + es, 1, __ATOMIC_RELAXED, __HIP_MEMORY_SCOPE_WORKGROUP);
            infoL[(R - w0) * 4 + ex] = es | (lr << 8);
            gate[(size_t)R * 4 + ex] = gs;
        }
    }
    __syncthreads();
    if (tid < 32) baseL[tid] = (int)__hip_atomic_fetch_add(cntG + tid, (unsigned)cntL[tid], __ATOMIC_RELAXED, __HIP_MEMORY_SCOPE_AGENT);
    __syncthreads();
    for (int idx = tid; idx < (w1 - w0) * 4; idx += NTHREADS) { const int info = infoL[idx], e = info & 255, rk = baseL[e] + (info >> 8); const int R = w0 + (idx >> 2);
        slot[(size_t)R * 4 + (idx & 3)] = e | (rk << 8); rte[(size_t)e * NT + rk] = R; }
    __syncthreads();
}
constexpr int LDS_TOK = 131072;
__device__ __forceinline__ void moe_tok_table(ArgsRef a, const pg8::MoeOrder& S, LAS unsigned char* lds) {
    const MoeTab t = moe_tab(lds); LAS int* tokL = (LAS int*)(lds + LDS_TOK); const int* rte = (const int*)(a.ws + WS_RTE);
    const int tid = threadIdx.x;
    int val[14]; bool has[14];
#pragma unroll
    for (int q = 0; q < 14; ++q) { const int i = 2 * q + (tid >> 8); pg8::Unit u; has[q] = S.next(i, u); val[q] = 0;
        if (has[q]) { const int dest = u.pm * 256 + (tid & 255), e = t.blkE[u.pm], rk = dest - t.pstart[e];
            if (rk < t.cnt[e]) val[q] = rte[(size_t)e * NT + rk]; } }
#pragma unroll
    for (int q = 0; q < 14; ++q) { const int i = 2 * q + (tid >> 8); if (has[q]) tokL[i * 256 + (tid & 255)] = val[q]; }
    __syncthreads();
}

template <bool FINAL>
__device__ __forceinline__ void ph_combine(ArgsRef a, int layer, const bf16* Xin, const bf16* Ys, int R0, int R1, bf16* Xout, bf16* Hout, float* outF, LAS unsigned char* lds) {
    moe_tables(a, layer, lds); const MoeTab t = moe_tab(lds);
    const int tid = threadIdx.x, lane = tid & 63, wave = __builtin_amdgcn_readfirstlane(tid >> 6);
    const float* modl = (const float*)(a.ws + WS_SM + SM_MODL) + (size_t)layer * 16 * 6 * D; const float* modc = (const float*)(a.ws + WS_SM + SM_MODC) + (size_t)layer * 6 * D;
    const float* modl2 = (const float*)(a.ws + WS_SM + SM_MODL) + (size_t)1 * 16 * 6 * D; const float* modc2 = (const float*)(a.ws + WS_SM + SM_MODC) + (size_t)1 * 6 * D;
    const int* slot = (const int*)(a.ws + WS_SLOT); const float* gate = (const float*)(a.ws + WS_GATE);
    const int gw = blockIdx.x * NWAVES + wave, NGW = gridDim.x * NWAVES;
    for (int Rq = R0 + gw; Rq < R1; Rq += 2 * NGW) {
        unsigned yv[2][4][4]; v2u xv[2][4]; float gk[2][4];
#pragma unroll
        for (int u = 0; u < 2; ++u) { const int R = (Rq + u * NGW < R1) ? Rq + u * NGW : Rq;
#pragma unroll
            for (int k = 0; k < 4; ++k) { const int info = slot[(size_t)R * 4 + k]; gk[u][k] = gate[(size_t)R * 4 + k] * 0.0625f; const int dest = t.pstart[info & 255] + (info >> 8);
                const unsigned* yr = (const unsigned*)((const unsigned char*)Ys + (size_t)dest * D);
#pragma unroll
                for (int j = 0; j < 4; ++j) yv[u][k][j] = yr[64 * j + lane]; }
#pragma unroll
            for (int j = 0; j < 4; ++j) xv[u][j] = ((const v2u*)(Xin + (size_t)R * D))[64 * j + lane]; }
        __builtin_amdgcn_sched_barrier(0);
#pragma unroll
        for (int u = 0; u < 2; ++u) { const int R = Rq + u * NGW;
            const int Rc = (R < R1) ? R : Rq; const bool isctx = Rc < NTC; const int bidx = isctx ? 0 : (Rc - NTC) / SEQ;
            const float* mod = isctx ? modc : modl + (size_t)bidx * 6 * D;
            f32x4 v[4]; float ss = 0.f;
#pragma unroll
            for (int j = 0; j < 4; ++j) { f32x4 m = (f32x4){0.f, 0.f, 0.f, 0.f};
#pragma unroll
                for (int k = 0; k < 4; ++k) { const unsigned w = yv[u][k][j]; const float g = gk[u][k]; const auto lo = __builtin_amdgcn_cvt_pk_f32_fp8((int)w, false), hi = __builtin_amdgcn_cvt_pk_f32_fp8((int)w, true); m[0] += g * lo[0]; m[1] += g * lo[1]; m[2] += g * hi[0]; m[3] += g * hi[1]; }
                const v2u xw = xv[u][j]; const f32x4 xi = (f32x4){bf2f(xw.x & 0xffffu), bf2f(xw.x >> 16), bf2f(xw.y & 0xffffu), bf2f(xw.y >> 16)};
                v[j] = xi + ((const f32x4*)(mod + 5 * D))[64 * j + lane] * m; ss += (v[j][0] * v[j][0] + v[j][1] * v[j][1]) + (v[j][2] * v[j][2] + v[j][3] * v[j][3]); }
            const float rs = 1.0f / sqrtf(wave_sum(ss) * (1.0f / D) + EPS);
            if (R < R1) {
                if (FINAL) {
                    f32x4* o = (f32x4*)(outF + (size_t)(R - NTC) * D);
#pragma unroll
                    for (int j = 0; j < 4; ++j) o[64 * j + lane] = v[j] * rs * ((const f32x4*)a.in[I_FNG])[64 * j + lane];
                } else {
                    const float* mod2 = isctx ? modc2 : modl2 + (size_t)bidx * 6 * D;
                    v2u* xo = (v2u*)(Xout + (size_t)R * D); v2u* o8 = (v2u*)(Hout + (size_t)R * D);
#pragma unroll
                    for (int j = 0; j < 4; ++j) { { v2u xq; xq.x = pk2(v[j][0], v[j][1]); xq.y = pk2(v[j][2], v[j][3]); xo[64 * j + lane] = xq; }
                        const f32x4 sh = ((const f32x4*)(mod2))[64 * j + lane], sc = ((const f32x4*)(mod2 + D))[64 * j + lane];
                        const f32x4 y = v[j] * rs * sc + sh; v2u w; w.x = pk2(y[0], y[1]); w.y = pk2(y[2], y[3]); o8[64 * j + lane] = w; }
                }
            }
        }
    }
}

__device__ __forceinline__ void ph_conv(ArgsRef a, const bf16* QKR, bf16* QK) {
    const int tid = threadIdx.x;
    const float* cw = a.in[I_MLCW]; const float* cb = a.in[I_MLCB];
    const int c8 = (tid & 127) * 8;
    float w[9][8], bb[8];
#pragma unroll
    for (int t = 0; t < 9; ++t)
#pragma unroll
        for (int j = 0; j < 8; ++j) w[t][j] = cw[t * 1024 + c8 + j];
#pragma unroll
    for (int j = 0; j < 8; ++j) bb[j] = cb[c8 + j];
    const float osc = c8 < 512 ? 0.125f : 1.0f;
    constexpr int NLAT = 16 * 32 * 16, NITEM = NLAT + 16 * 64;
    for (int item = blockIdx.x * 4 + (tid >> 7); item < NITEM; item += gridDim.x * 4) {
        const bool isctx = item >= NLAT;
        int y, x0, rowbase, W;
        if (!isctx) { const int b = item >> 9; y = (item >> 4) & 31; x0 = (item & 15) * 4; rowbase = NTC + b * SEQ + y * 64; W = 64; }
        else { const int it2 = item - NLAT; y = 0; x0 = (it2 & 63) * 4; rowbase = (it2 >> 6) * CTX; W = CTX; }
        if (isctx && c8 < 512) {
#pragma unroll
            for (int pp = 0; pp < 4; ++pp) *(v4u*)(QK + (size_t)(rowbase + x0 + pp) * D + c8) = (v4u){0u, 0u, 0u, 0u};
            continue; }
        v4u win[3][6];
#pragma unroll
        for (int ky = 0; ky < 3; ++ky) { const int yy = y + ky - 1; const bool rv = isctx ? (ky == 1) : (yy >= 0 && yy < 32);
            const int yc = isctx ? 0 : (yy < 0 ? 0 : yy > 31 ? 31 : yy); const int rb = rowbase + (isctx ? 0 : (yc - y) * 64);
#pragma unroll
            for (int c = 0; c < 6; ++c) { const int xx = x0 - 1 + c; const int xc = xx < 0 ? 0 : xx >= W ? W - 1 : xx;
                const v4u x = *(const v4u*)(QKR + (size_t)(rb + xc) * D + c8);
                win[ky][c] = (rv && xx >= 0 && xx < W) ? x : (v4u){0u, 0u, 0u, 0u}; } }
        __builtin_amdgcn_sched_barrier(0);
#pragma unroll
        for (int pp = 0; pp < 4; ++pp) {
            float acc[8];
#pragma unroll
            for (int j = 0; j < 8; ++j) acc[j] = bb[j];
#pragma unroll
            for (int ky = 0; ky < 3; ++ky)
#pragma unroll
                for (int kx = 0; kx < 3; ++kx) { const v4u x = win[ky][pp + kx]; const unsigned xs[4] = {x.x, x.y, x.z, x.w};
#pragma unroll
                    for (int j = 0; j < 4; ++j) { acc[2 * j] += w[ky * 3 + kx][2 * j] * bf2f(xs[j] & 0xffffu); acc[2 * j + 1] += w[ky * 3 + kx][2 * j + 1] * bf2f(xs[j] >> 16); } }
            float yv[8];
#pragma unroll
            for (int j = 0; j < 8; ++j) yv[j] = siluf(acc[j]) * osc;
            v4u o; o.x = pk2(yv[0], yv[1]); o.y = pk2(yv[2], yv[3]); o.z = pk2(yv[4], yv[5]); o.w = pk2(yv[6], yv[7]);
            *(v4u*)(QK + (size_t)(rowbase + x0 + pp) * D + c8) = o; }
    }
}


constexpr int N_PHASES = 21;
__global__ void __launch_bounds__(NTHREADS, 2) fwd(Args a_unused) {
    ArgsRef a = *(const volatile __attribute__((address_space(4))) Args*)__builtin_amdgcn_kernarg_segment_ptr();
    extern __shared__ __attribute__((aligned(16))) unsigned char lds_raw[];
    LAS unsigned char* lds = (LAS unsigned char*)lds_raw;
    const int tid = threadIdx.x, G = gridDim.x;
    unsigned char* ws = a.ws;
    if (tid < 16) ((LAS unsigned*)(lds + LDS_MISC))[tid] = 0u;
    __syncthreads();
    XcdBarrier bar; bar.bar = (unsigned*)(ws + WS_CTL) + CW_BAR; bar.x = 0; bar.st = nullptr;
    const int lo = a.ph_lo, hi = a.ph_hi;
    if (hi - lo > 1) bar = xcd_barrier_post((unsigned*)(ws + WS_CTL) + CW_BAR, (volatile LAS unsigned*)(lds + LDS_MISC));
#ifndef PH_MASK
#define PH_MASK 0xFFFFFFFFu
#endif
#define IN(k) (((PH_MASK >> (k)) & 1u) && lo <= (k) && (k) < hi)
#define SEAM(k) do { if (IN(k) && IN((k) + 1)) xcd_barrier(bar); } while (0)

    bf16* ACT = (bf16*)(ws + WS_ACT);
    bf16* X1 = (bf16*)(ws + WS_X1); bf16* X2 = (bf16*)(ws + WS_X2);
    bf16* BIG = (bf16*)(ws + WS_BIG);
    const float* modl = (const float*)(ws + WS_SM + SM_MODL); const float* modc = (const float*)(ws + WS_SM + SM_MODC); const float* oml = (const float*)(ws + WS_SM + SM_OML);
    bf16* XS = BIG; bf16* HM = (bf16*)(ws + WS_BIG + 304 * MiB);

    if (IN(0)) { {  ph_prologue(a, lds);  } } SEAM(0);
    if (IN(1)) { {  ph_modulate(a, a.in[I_CTX], a.in[I_X], a.in[I_NMIXG], 0, 0, 0, NT, ACT);  } } SEAM(1);
    if (IN(2)) { {  pg8::Gemm g{ACT, (const bf16*)(ws + WS_WHGIN), D}; pg8::StaticOrder S; S.init(NT, HG_N, G, (int)blockIdx.x);
        pg8::EpiHgIn E{BIG, (size_t)NT * D, oml, oml + D}; pg8::gemm_phase<pg8::EpiHgIn, pg8::StaticOrder>(lds, g, S, E);
        if (idle_last_round(S)) expert_tiles<1>(a, lds, 2);  } } SEAM(2);
    if (IN(3)) { {  ph_hg_scan(a, lds);
          } } SEAM(3);
    if (IN(4)) { {  ph_readout<OUTPROJ_FP8>(BIG + (size_t)5 * NT * D, BIG + (size_t)6 * NT * D, BIG + (size_t)4 * NT * D, a.in[I_HGNG], 0, NT, ACT);  } } SEAM(4);
    if (IN(5)) { {  pg8::Gemm g{ACT, (const bf16*)(ws + WS_WHGOUT), D}; pg8::StaticOrder S; S.init(NT, D, G, (int)blockIdx.x);
        pg8::EpiResid<false> E{a.in[I_CTX], a.in[I_X], X1, modc + 2 * D, modl + 2 * D, 0, OUTPROJ_FP8 ? 0.0625f : 1.0f}; pg8::gemm_phase<pg8::EpiResid<false>, pg8::StaticOrder, true, true, false, OUTPROJ_FP8 != 0>(lds, g, S, E);
        if (idle_last_round(S)) expert_tiles<1>(a, lds, OUTPROJ_FP8 ? 1 : 2);  } } SEAM(5);
    if (IN(6)) { {  ph_router(a, X1, a.in[I_NFFNG], 0, 0, NT, ACT, lds);  } } SEAM(6);
    if (IN(8)) { {  moe_tables(a, 0, lds); const MoeTab t = moe_tab(lds);
        pg8::Gemm g{ACT, (const bf16*)(ws + WS_W1), D}; pg8::MoeOrder S{t.nblk[0], 8, G, (int)blockIdx.x, t.blkE}; moe_tok_table(a, S, lds);
        pg8::EpiSwiglu E{HM, a.in[I_B1]}; pg8::gemm_phase<pg8::EpiSwiglu, pg8::MoeOrder, true, true, true, true>(lds, g, S, E, (const LAS int*)(lds + LDS_TOK));
        if (idle_last_round(S)) expert_tiles<1>(a, lds, 1);  } } SEAM(8);
    if (IN(9)) { {  moe_tables(a, 0, lds); const MoeTab t = moe_tab(lds);
        pg8::Gemm g{HM, (const bf16*)(ws + WS_W2), D}; pg8::MoeOrder S{t.nblk[0], 4, G, (int)blockIdx.x, t.blkE};
        pg8::EpiW2 E{XS, a.in[I_B2]}; pg8::gemm_phase<pg8::EpiW2, pg8::MoeOrder, true, true, false, true>(lds, g, S, E);
        if (idle_last_round(S)) expert_tiles<1>(a, lds, 1);  } } SEAM(9);
    if (IN(10)) { {  ph_combine<false>(a, 0, X1, XS, 0, NT, X2, ACT, nullptr, lds);  } } SEAM(10);
    if (IN(11)) { {  pg8::Gemm g{ACT, (const bf16*)(ws + WS_WMLIN), D}; pg8::MlInOrder S; S.init(G, (int)blockIdx.x);
        pg8::EpiMlIn E{BIG, (size_t)NT * D, (float*)(ws + WS_GT), a.in[I_MLBG]}; pg8::gemm_phase<pg8::EpiMlIn, pg8::MlInOrder>(lds, g, S, E);
        expert_tiles<1>(a, lds, 1 << 30);  } } SEAM(11);
    if (IN(12)) { {  ph_conv(a, BIG, BIG + (size_t)3 * NT * D);  } } SEAM(12);
    if (IN(13)) { {  ph_ml_scan(a, lds);  } } SEAM(13);
    if (IN(14)) { {  ph_readout<OUTPROJ_FP8>(BIG + (size_t)4 * NT * D, BIG + (size_t)5 * NT * D, BIG + (size_t)2 * NT * D, a.in[I_MLNG], NTC, NT, ACT);  } } SEAM(14);
    if (IN(15)) { {  pg8::Gemm g{OUTPROJ_FP8 ? (const bf16*)((const unsigned char*)ACT + (size_t)NTC * D) : ACT + (size_t)NTC * D, (const bf16*)(ws + WS_WMLOUT), D}; pg8::StaticOrder S; S.init(NTL, D, G, (int)blockIdx.x);
        pg8::EpiResid<true> E{X2, X2 + (size_t)NTC * D, X1, modc + 6 * D + 2 * D, modl + (size_t)16 * 6 * D + 2 * D, NTC, OUTPROJ_FP8 ? 0.0625f : 1.0f}; pg8::gemm_phase<pg8::EpiResid<true>, pg8::StaticOrder, true, true, false, OUTPROJ_FP8 != 0>(lds, g, S, E);  } } SEAM(15);
    if (IN(16)) { {  ph_router(a, X1, a.in[I_NFFNG] + D, 1, NTC, NT, ACT, lds);  } } SEAM(16);
    if (IN(18)) { {  moe_tables(a, 1, lds); const MoeTab t = moe_tab(lds);
        pg8::Gemm g{ACT, (const bf16*)(ws + WS_W1 + (size_t)32 * 2048 * D), D}; pg8::MoeOrder S{t.nblk[0], 8, G, (int)blockIdx.x, t.blkE}; moe_tok_table(a, S, lds);
        pg8::EpiSwiglu E{HM, a.in[I_B1] + 32 * 2048}; pg8::gemm_phase<pg8::EpiSwiglu, pg8::MoeOrder, true, true, true, true>(lds, g, S, E, (const LAS int*)(lds + LDS_TOK));  } } SEAM(18);
    if (IN(19)) { {  moe_tables(a, 1, lds); const MoeTab t = moe_tab(lds);
        pg8::Gemm g{HM, (const bf16*)(ws + WS_W2 + (size_t)32 * D * D), D}; pg8::MoeOrder S{t.nblk[0], 4, G, (int)blockIdx.x, t.blkE};
        pg8::EpiW2 E{XS, a.in[I_B2] + 32 * D}; pg8::gemm_phase<pg8::EpiW2, pg8::MoeOrder, true, true, false, true>(lds, g, S, E);  } } SEAM(19);
    if (IN(20)) { {  ph_combine<true>(a, 1, X1, XS, NTC, NT, nullptr, nullptr, a.out, lds);  } }
#undef IN
#undef SEAM
}

extern "C" void kernel_launch(void* const* d_in, const int* in_sizes, int n_in, void* d_out, int out_size, void* d_ws, size_t ws_size, hipStream_t stream) {
    static int grid = 0;
    if (grid == 0) {
        if (n_in != 25 || out_size != NTL * D || ws_size < WS_END) { fprintf(stderr, "kernel_launch: unexpected problem (n_in %d, out %d, ws %zu < %zu)\n", n_in, out_size, ws_size, (size_t)WS_END); grid = -1; return; }
        int dev = 0, cus = 0, per_cu = 0;
        if (hipGetDevice(&dev) != hipSuccess || hipDeviceGetAttribute(&cus, hipDeviceAttributeMultiprocessorCount, dev) != hipSuccess) { grid = -1; return; }
        if (hipFuncSetAttribute((const void*)fwd, hipFuncAttributeMaxDynamicSharedMemorySize, LDS_BYTES) != hipSuccess) { fprintf(stderr, "kernel_launch: hipFuncSetAttribute failed\n"); grid = -1; return; }
        if (hipOccupancyMaxActiveBlocksPerMultiprocessor(&per_cu, (const void*)fwd, NTHREADS, LDS_BYTES) != hipSuccess || per_cu < 1) { fprintf(stderr, "kernel_launch: occupancy query says %d blocks per CU\n", per_cu); }
        (void)hipGetLastError();
        grid = cus < 256 ? cus : 256;
    }
    if (grid < 0) return;
    if (hipMemsetAsync((char*)d_ws + WS_CTL, 0, CTL_ZERO_BYTES, stream) != hipSuccess) return;
    Args a{};
    for (int i = 0; i < 25; ++i) a.in[i] = (const float*)d_in[i];
    a.out = (float*)d_out; a.ws = (unsigned char*)d_ws;
#if MK_ONE_LAUNCH
    a.ph_lo = 0; a.ph_hi = N_PHASES;
    hipLaunchKernelGGL(fwd, dim3(grid), dim3(NTHREADS), LDS_BYTES, stream, a);
#else
    for (int p = 0; p < N_PHASES; ++p) { a.ph_lo = p; a.ph_hi = p + 1; hipLaunchKernelGGL(fwd, dim3(grid), dim3(NTHREADS), LDS_BYTES, stream, a); }
#endif
}
```

```cpp
#include <hip/hip_runtime.h>
#include <cstdio>
#include <cstdint>

#ifndef OUTPROJ_FP8
#define OUTPROJ_FP8 1
#endif
#ifndef MK_ONE_LAUNCH
#define MK_ONE_LAUNCH 1
#endif

#define LAS __attribute__((address_space(3)))
#define GAS __attribute__((address_space(1)))
typedef unsigned short bf16;
typedef unsigned v4u __attribute__((ext_vector_type(4)));
typedef unsigned v2u __attribute__((ext_vector_type(2)));
typedef float f32x4 __attribute__((ext_vector_type(4)));
typedef float f32x2 __attribute__((ext_vector_type(2)));
typedef short bf16x8 __attribute__((ext_vector_type(8)));

constexpr int NB = 16, SEQ = 2048, D = 1024, CTX = 256;
constexpr int NTC = NB * CTX, NTL = NB * SEQ, NT = NTC + NTL;
constexpr int NE = 32, TOPK = 4;
constexpr int HG_N = 5 * D;
constexpr int ML_N = 3104, ML_NP = 3328;
constexpr int NPADMAX = 155648;
constexpr float EPS = 1e-6f;
constexpr int NWAVES = 8, NTHREADS = 512;

constexpr size_t MiB = 1u << 20;
constexpr size_t WS_CTL = 0, CTL_ZERO_BYTES = 32 * 1024;
constexpr size_t WS_SM = 1 * MiB;
constexpr size_t SM_MODL = 0, SM_MODC = 786432, SM_OML = 835584;
constexpr size_t WS_SLOT = 2 * MiB;
constexpr size_t WS_GATE = 3 * MiB;
constexpr size_t WS_RTE = 4 * MiB;
constexpr size_t WS_GT = 10 * MiB;
constexpr size_t WS_WHGIN = 16 * MiB, WS_WHGOUT = 26 * MiB, WS_WMLIN = 28 * MiB, WS_WMLOUT = 35 * MiB;
constexpr size_t WS_W1 = 40 * MiB, WS_W2 = 296 * MiB;
constexpr size_t WS_X1 = 424 * MiB, WS_X2 = 568 * MiB, WS_ACT = 712 * MiB, WS_BIG = 784 * MiB;
constexpr size_t T72 = 72 * MiB;
constexpr size_t WS_END = WS_BIG + 608 * MiB;
constexpr int CW_CNT = 1024;
constexpr int CW_TILE = 2048, CW_BAR = 4096;

constexpr int LDS_BYTES = 160 * 1024;
constexpr int LDS_MISC = LDS_BYTES - 4096;
constexpr int LDS_TAB = LDS_MISC + 64;

__device__ __forceinline__ float bf2f(unsigned v) { return __uint_as_float(v << 16); }
typedef __bf16 bf2_t __attribute__((ext_vector_type(2)));
__device__ __forceinline__ unsigned pk2(float lo, float hi) { bf2_t v; v[0] = (__bf16)lo; v[1] = (__bf16)hi; return __builtin_bit_cast(unsigned, v); }
__device__ __forceinline__ unsigned f2bf(float f) { return pk2(f, f) & 0xffffu; }
__device__ __forceinline__ float fexp(float x) { return __builtin_amdgcn_exp2f(x * 1.44269504089f); }
__device__ __forceinline__ float frcp(float x) { return __builtin_amdgcn_rcpf(x); }
__device__ __forceinline__ float siluf(float v) { return v * frcp(1.0f + fexp(-v)); }
#define LDS_WAIT() asm volatile("s_waitcnt lgkmcnt(0)" ::: "memory")
__device__ __forceinline__ unsigned pk4_fp8(float a, float b, float c, float d) { int w = 0; w = __builtin_amdgcn_cvt_pk_fp8_f32(a, b, w, false); w = __builtin_amdgcn_cvt_pk_fp8_f32(c, d, w, true); return (unsigned)w; }
template <int CTRL, int RMASK> __device__ __forceinline__ float dppf(float old, float src) { return __int_as_float(__builtin_amdgcn_update_dpp(__float_as_int(old), __float_as_int(src), CTRL, RMASK, 0xf, false)); }

namespace pg8 {
#define PG8_LAS __attribute__((address_space(3)))
typedef unsigned short bf16_t;
typedef unsigned u32x4 __attribute__((ext_vector_type(4)));
constexpr int BM = 256, BK = 64, HALF = 128, HTB = HALF * BK * 2, STAGE_BYTES = 8 * HTB, NXCD = 8, WGM = 8;
__host__ __device__ __forceinline__ int lds_byte(int r, int c) { const int st = (r >> 4) * 2 + (c >> 5), rr = r & 15, cc = c & 31, ob = rr * 64 + cc * 2; return st * 1024 + (ob ^ (((ob >> 9) & 1) << 5)); }
__host__ __device__ __forceinline__ void stage_rc(int b, int& R, int& C) { const int st = b / 1024, sb = b % 1024, swz = sb ^ (((sb >> 9) & 1) << 5); R = (st >> 1) * 16 + swz / 64; C = (st & 1) * 32 + (swz % 64) / 2; }
__host__ __device__ __forceinline__ int perm32(int rho) { const int n = rho >> 4, i = rho & 15; return 8 * (i >> 2) + 4 * n + (i & 3); }

__device__ __forceinline__ int lane_now() { int l; asm volatile("v_mbcnt_lo_u32_b32 %0, -1, 0\n\tv_mbcnt_hi_u32_b32 %0, -1, %0" : "=v"(l)); return l; }
struct Unit { int pm, pn, bt; };
struct Gemm { const bf16_t* A; const bf16_t* Bt; int K; };

struct StaticOrder {
    int nM, nN, nwg, G, c;
    __device__ void init(int M, int N, int G_, int c_) { nM = M / BM; nN = N / BM; nwg = nM * nN; G = G_; c = c_; }
    __device__ bool next(int i, Unit& u) const {
        const long L = (long)i * G + c; if (L >= nwg) return false;
        int wgid = (int)L; { const int q = nwg / NXCD, r = nwg % NXCD, xcd = wgid % NXCD, off = wgid / NXCD; wgid = (xcd < r ? xcd * (q + 1) : r * (q + 1) + (xcd - r) * q) + off; }
        const int nig = WGM * nN, gid = wgid / nig, fm = gid * WGM, gsz = (nM - fm) < WGM ? (nM - fm) : WGM;
        u.pm = fm + ((wgid % nig) % gsz); u.pn = (wgid % nig) / gsz; u.bt = u.pn; return true;
    }
};
struct MlInOrder {
    StaticOrder lat; int G, c;
    __device__ void init(int G_, int c_) { lat.init(NTL, ML_NP, G_, 0); G = G_; c = c_; }
    __device__ bool next(int i, Unit& u) const {
        const long L = (long)i * G + c;
        if (L < lat.nwg) { StaticOrder t = lat; t.G = 1; t.c = 0; t.next((int)L, u); u.pm += NTC / BM; return true; }
        const int r = (int)(L - lat.nwg); if (r >= 16 * 7) return false;
        const int j = r % 7; u.pm = r / 7; u.pn = j < 2 ? 2 + j : j < 6 ? 2 + j : 12; u.bt = u.pn; return true;
    }
};
struct MoeOrder {
    int nblk, tilesN, G, c; const LAS int* blkE;
    __device__ bool next(int i, Unit& u) const {
        int pm, pn;
        const int J = G / 8;
        if ((G % 8) == 0 && (J % tilesN) == 0) { const int x = c % 8, j = c / 8, RB = J / tilesN; pm = (i * 8 + x) * RB + j / tilesN; pn = j % tilesN; }
        else { const long L = (long)i * G + c; pm = (int)(L / tilesN); pn = (int)(L % tilesN); }
        if (pm >= nblk) return false;
        u.pm = pm; u.pn = pn; u.bt = blkE[pm] * tilesN + pn; return true;
    }
};

__device__ __forceinline__ unsigned cvt_pk_bf16(float lo, float hi) { return pk2(lo, hi); }

__device__ __forceinline__ __attribute__((ext_vector_type(8))) int pk8(bf16x8 lo, bf16x8 hi) { typedef int v4i __attribute__((ext_vector_type(4))); const v4i a = __builtin_bit_cast(v4i, lo), b = __builtin_bit_cast(v4i, hi);
    return (__attribute__((ext_vector_type(8))) int){a[0], a[1], a[2], a[3], b[0], b[1], b[2], b[3]}; }
typedef int v8i_t __attribute__((ext_vector_type(8)));
typedef int v4i_q __attribute__((ext_vector_type(4)));
__device__ __forceinline__ int pg8_x16(int v) { int r; asm volatile("v_xor_b32 %0, 16, %1" : "=v"(r) : "v"(v)); return r; }
__device__ __forceinline__ v8i_t pk8q(v4i_q a, v4i_q b) { return __builtin_shufflevector(a, b, 0, 1, 2, 3, 4, 5, 6, 7); }
template <class Epi, class Sched, bool ALIGN_EPI = true, bool SP2 = true, bool GATHER = false, bool FP8 = false>
__device__ __forceinline__ void gemm_phase(PG8_LAS unsigned char* lds, const Gemm g, const Sched& S, const Epi& E, const PG8_LAS int* tokL = nullptr) {
    const int tid = threadIdx.x, wid = __builtin_amdgcn_readfirstlane(tid >> 6), lane = tid & 63, wr = wid >> 2, wc = wid & 3, fr = lane & 15, fq = lane >> 4;
    const int K = FP8 ? g.K / 2 : g.K, nt = K / BK;
    unsigned voffA[2], voffB[2];
#pragma unroll
    for (int i = 0; i < 2; ++i) { int R, C; stage_rc(tid * 16 + i * 8192, R, C); const int Rb = Epi::PERM ? ((R & ~31) + perm32(R & 31)) : R;
        voffA[i] = (unsigned)(R * K + C) * 2u; voffB[i] = (unsigned)(Rb * K + C) * 2u; }
    unsigned gA[2][2], gU[2][2];
#define PG8_GTOK(dst, uidx) do { const int _t = wid * 64 + lane_now(); _Pragma("unroll") for (int _i = 0; _i < 2; ++_i) { int _R, _C; stage_rc(_t * 16 + _i * 8192, _R, _C); _Pragma("unroll") for (int _h = 0; _h < 2; ++_h) dst[_h][_i] = (unsigned)tokL[(uidx) * 256 + _h * HALF + _R] * (unsigned)(K * 2) + (unsigned)(_C * 2); } } while (0)
    const unsigned kstep = (unsigned)(BK * 2);
    const unsigned pstep = 64u * (unsigned)K * 2u;
    const unsigned hstep = (unsigned)HALF * K * 2;
    const unsigned tstep = 2 * hstep;
    const __amdgpu_buffer_rsrc_t rsA = __builtin_amdgcn_make_buffer_rsrc((void*)g.A, 0, -1, 0x00020000), rsB = __builtin_amdgcn_make_buffer_rsrc((void*)g.Bt, 0, -1, 0x00020000);
    const unsigned ldsw = (unsigned)wid * 1024u;
    const int aoff = FP8 ? (lds_byte(wr * 64 + fr, fq * 16) | ((fq & 1) << 4)) : lds_byte(wr * 64 + fr, fq * 8), boff = FP8 ? (lds_byte(wc * 32 + fr, fq * 16) | ((fq & 1) << 4)) : lds_byte(wc * 32 + fr, fq * 8);
    const int aoffH = aoff ^ 16, boffH = boff ^ 16;
    constexpr int aoff1 = FP8 ? 16 : 1024, boff1 = FP8 ? 16 : 1024;
#define PG8_SA(b, h) (((b) * 2 + (h)) * HTB)
#define PG8_SB(b, h) ((4 + (b) * 2 + (h)) * HTB)
#define PG8_STAGE_R(bufoff, rs, soff, voff) do { _Pragma("unroll") for (int _i = 0; _i < 2; ++_i) \
        __builtin_amdgcn_raw_ptr_buffer_load_lds(rs, (PG8_LAS void*)(lds + (bufoff) + ldsw + _i * 8192), 16, (int)(voff)[_i], (int)(soff), 0, 0); } while (0)
#define PG8_STAGE_S(bufoff, rs, soff, voff0) do { _Pragma("unroll") for (int _i = 0; _i < 2; ++_i) \
        __builtin_amdgcn_raw_ptr_buffer_load_lds(rs, (PG8_LAS void*)(lds + (bufoff) + ldsw + _i * 8192), 16, (int)(voff0), (int)((soff) + _i * pstep), 0, 0); } while (0)
#define PG8_STAGE_B(bufoff, soff) PG8_STAGE_S(bufoff, rsB, soff, voffB[0])
#define PG8_STAGE_A1(b, h, ptr) do { if constexpr (GATHER) { PG8_STAGE_R(PG8_SA(b, h), rsA, ptr, gA[h]); } else { PG8_STAGE_S(PG8_SA(b, h), rsA, (ptr) + (h) * hstep, voffA[0]); } } while (0)
#define PG8_STAGE_A2(b, h, ptr) do { if constexpr (GATHER) { PG8_STAGE_R(PG8_SA(b, h), rsA, ptr, gU[h]); } else { PG8_STAGE_S(PG8_SA(b, h), rsA, (ptr) + (h) * hstep, voffA[0]); } } while (0)
#define PG8_LDA(dst, b, h) do { if constexpr (FP8) { _Pragma("unroll") for (int m = 0; m < 4; ++m) dst##8[m] = pk8q(*(const PG8_LAS v4i_q*)(lds + PG8_SA(b, h) + aoff + m * 2048), *(const PG8_LAS v4i_q*)(lds + PG8_SA(b, h) + aoffH + m * 2048)); } else { _Pragma("unroll") for (int m = 0; m < 4; ++m) _Pragma("unroll") for (int k = 0; k < 2; ++k) dst[m][k] = *(const PG8_LAS bf16x8*)(lds + PG8_SA(b, h) + aoff + m * 2048 + k * aoff1); } } while (0)
#define PG8_LDB(dst, b, h) do { if constexpr (FP8) { _Pragma("unroll") for (int n = 0; n < 2; ++n) dst##8[n] = pk8q(*(const PG8_LAS v4i_q*)(lds + PG8_SB(b, h) + boff + n * 2048), *(const PG8_LAS v4i_q*)(lds + PG8_SB(b, h) + boffH + n * 2048)); } else { _Pragma("unroll") for (int n = 0; n < 2; ++n) _Pragma("unroll") for (int k = 0; k < 2; ++k) dst[n][k] = *(const PG8_LAS bf16x8*)(lds + PG8_SB(b, h) + boff + n * 2048 + k * boff1); } } while (0)
#define PG8_MMA(ai, bj, At, Bt) do { __builtin_amdgcn_s_setprio(1); if constexpr (FP8) { _Pragma("unroll") for (int m = 0; m < 4; ++m) _Pragma("unroll") for (int n = 0; n < 2; ++n) \
        acc[ai][bj][m][n] = __builtin_amdgcn_mfma_scale_f32_16x16x128_f8f6f4(Bt##8[n], At##8[m], acc[ai][bj][m][n], 0, 0, 0, 0, 0, 0); } \
        else { _Pragma("unroll") for (int m = 0; m < 4; ++m) _Pragma("unroll") for (int n = 0; n < 2; ++n) _Pragma("unroll") for (int k = 0; k < 2; ++k) \
        acc[ai][bj][m][n] = __builtin_amdgcn_mfma_f32_16x16x32_bf16(Bt[n][k], At[m][k], acc[ai][bj][m][n], 0, 0, 0); } __builtin_amdgcn_s_setprio(0); } while (0)
#define PG8_WAIT_V(n) asm volatile("s_waitcnt vmcnt(" #n ")" ::: "memory")
#define PG8_WAIT_L(n) asm volatile("s_waitcnt lgkmcnt(" #n ")" ::: "memory")
#define PG8_BAR __builtin_amdgcn_s_barrier()
#define PG8_SCHED __builtin_amdgcn_sched_barrier(0)
    Unit cur, nxt; int ui = 0;
    if (!S.next(0, cur)) return;
    f32x4 acc[2][2][4][2];
#pragma unroll
    for (int a = 0; a < 2; ++a)
#pragma unroll
        for (int b = 0; b < 2; ++b)
#pragma unroll
            for (int m = 0; m < 4; ++m)
#pragma unroll
                for (int n = 0; n < 2; ++n) acc[a][b][m][n] = (f32x4){0.f, 0.f, 0.f, 0.f};
    bf16x8 At[4][2], B0[2][2], B1[2][2]; v8i_t At8[4], B08[2], B18[2];
    unsigned cA = GATHER ? 0u : (unsigned)cur.pm * tstep, cB = (unsigned)cur.bt * tstep;
    if constexpr (GATHER) { PG8_GTOK(gA, 0); }
    if constexpr (SP2) {
        PG8_STAGE_B(PG8_SB(0, 0), cB); PG8_STAGE_B(PG8_SB(0, 1), cB + hstep); PG8_STAGE_A1(0, 0, cA); PG8_STAGE_A1(0, 1, cA);
        if (wr == 1) PG8_BAR;
        PG8_WAIT_V(2); PG8_BAR;
        PG8_STAGE_B(PG8_SB(1, 0), cB + kstep); PG8_STAGE_A1(1, 0, cA + kstep); PG8_STAGE_B(PG8_SB(1, 1), cB + hstep + kstep);
        PG8_WAIT_V(6); PG8_BAR;
    } else {
        static_assert(SP2 || !GATHER, "gathered A rows: SP2 loop only");
        PG8_STAGE_B(PG8_SB(0, 0), cB); PG8_STAGE_S(PG8_SA(0, 0), rsA, cA, voffA[0]); PG8_STAGE_B(PG8_SB(0, 1), cB + hstep); PG8_STAGE_S(PG8_SA(0, 1), rsA, cA + hstep, voffA[0]);
        if (wr == 1) PG8_BAR;
        PG8_WAIT_V(4); PG8_BAR;
        PG8_STAGE_B(PG8_SB(1, 0), cB + kstep); PG8_STAGE_S(PG8_SA(1, 0), rsA, cA + kstep, voffA[0]); PG8_STAGE_B(PG8_SB(1, 1), cB + hstep + kstep);
        PG8_WAIT_V(6); PG8_BAR;
    }
    for (;;) {
        const bool has_next = S.next(ui + 1, nxt);
        const unsigned nA = GATHER ? cA : (has_next ? (unsigned)nxt.pm * tstep : cA), nB = has_next ? (unsigned)nxt.bt * tstep : cB;
#pragma unroll 1
        for (int t = 0; t < nt; t += 2) {
            const bool last = (t == nt - 2);
            if constexpr (GATHER) {
#pragma unroll
                for (int _h = 0; _h < 2; ++_h)
#pragma unroll
                    for (int _i = 0; _i < 2; ++_i) gU[_h][_i] = gA[_h][_i];
                if (last && has_next) { PG8_GTOK(gU, ui + 1); } }

            const unsigned a1 = cA + (unsigned)(t + 1) * kstep;
            const unsigned a2 = last ? nA : cA + (unsigned)(t + 2) * kstep, b2 = last ? nB : cB + (unsigned)(t + 2) * kstep;
            const unsigned a3 = a2 + kstep, b3 = b2 + kstep;
            if constexpr (SP2) {
            const bool relax = (t == 0) && (ui > 0);
#define PG8_WAIT_VR() do { if (relax) { if constexpr (Epi::NST == 16) { PG8_WAIT_V(24); } else if constexpr (Epi::NST == 8) { PG8_WAIT_V(16); } else { PG8_WAIT_V(8); } } else { PG8_WAIT_V(8); } } while (0)
            PG8_LDB(B0, 0, 0); PG8_LDB(B1, 0, 1); PG8_SCHED; PG8_LDA(At, 0, 0); PG8_STAGE_A1(1, 1, a1);
            PG8_WAIT_VR(); PG8_WAIT_L(0); PG8_BAR; PG8_MMA(0, 0, At, B0); PG8_MMA(0, 1, At, B1); PG8_BAR; PG8_SCHED;
            PG8_LDA(At, 0, 1); PG8_STAGE_B(PG8_SB(0, 0), b2); PG8_STAGE_B(PG8_SB(0, 1), b2 + hstep); PG8_STAGE_A2(0, 0, a2);
            PG8_WAIT_VR(); PG8_WAIT_L(0); PG8_BAR; PG8_MMA(1, 0, At, B0); PG8_MMA(1, 1, At, B1); PG8_BAR; PG8_SCHED;
            PG8_LDB(B0, 1, 0); PG8_LDB(B1, 1, 1); PG8_SCHED; PG8_LDA(At, 1, 0); PG8_STAGE_A2(0, 1, a2);
            PG8_WAIT_V(8); PG8_WAIT_L(0); PG8_BAR; PG8_MMA(0, 0, At, B0); PG8_MMA(0, 1, At, B1); PG8_BAR; PG8_SCHED;
            PG8_LDA(At, 1, 1); PG8_STAGE_B(PG8_SB(1, 0), b3); PG8_STAGE_B(PG8_SB(1, 1), b3 + hstep); PG8_STAGE_A2(1, 0, a3);
            PG8_WAIT_V(8); PG8_WAIT_L(0); PG8_BAR; PG8_MMA(1, 0, At, B0); PG8_MMA(1, 1, At, B1); PG8_BAR; PG8_SCHED;
            } else {
            PG8_LDB(B0, 0, 0); PG8_SCHED; PG8_LDA(At, 0, 0); PG8_STAGE_S(PG8_SA(1, 1), rsA, a1 + hstep, voffA[0]);
            PG8_WAIT_L(8); PG8_BAR; PG8_WAIT_L(0); PG8_MMA(0, 0, At, B0); PG8_BAR; PG8_SCHED;
            PG8_LDB(B1, 0, 1); PG8_STAGE_B(PG8_SB(0, 0), b2);
            PG8_BAR; PG8_WAIT_L(0); PG8_MMA(0, 1, At, B1); PG8_BAR;
            PG8_LDA(At, 0, 1); PG8_STAGE_S(PG8_SA(0, 0), rsA, a2, voffA[0]);
            PG8_BAR; PG8_WAIT_L(0); PG8_MMA(1, 0, At, B0); PG8_BAR; PG8_SCHED;
            PG8_STAGE_B(PG8_SB(0, 1), b2 + hstep);
            PG8_WAIT_V(6); PG8_BAR; PG8_MMA(1, 1, At, B1); PG8_BAR;
            PG8_LDB(B0, 1, 0); PG8_SCHED; PG8_LDA(At, 1, 0); PG8_STAGE_S(PG8_SA(0, 1), rsA, a2 + hstep, voffA[0]);
            PG8_WAIT_L(8); PG8_BAR; PG8_WAIT_L(0); PG8_MMA(0, 0, At, B0); PG8_BAR; PG8_SCHED;
            PG8_LDB(B1, 1, 1); PG8_STAGE_B(PG8_SB(1, 0), b3);
            PG8_BAR; PG8_WAIT_L(0); PG8_MMA(0, 1, At, B1); PG8_BAR;
            PG8_LDA(At, 1, 1); PG8_STAGE_S(PG8_SA(1, 0), rsA, a3, voffA[0]);
            PG8_BAR; PG8_WAIT_L(0); PG8_MMA(1, 0, At, B0); PG8_BAR; PG8_SCHED;
            PG8_STAGE_B(PG8_SB(1, 1), b3 + hstep);
            PG8_WAIT_V(6); PG8_BAR; PG8_MMA(1, 1, At, B1); PG8_BAR;
            }
        }
        if constexpr (ALIGN_EPI) { if (wr == 0) PG8_BAR; }
        E(acc, cur, wr, wc, fr, fq);
        if (!has_next) break;
#pragma unroll
        for (int a = 0; a < 2; ++a)
#pragma unroll
            for (int b = 0; b < 2; ++b)
#pragma unroll
                for (int m = 0; m < 4; ++m)
#pragma unroll
                    for (int n = 0; n < 2; ++n) { f32x2 z0, z1; asm volatile("v_mov_b64 %0, 0\n\tv_mov_b64 %1, 0" : "=v"(z0), "=v"(z1)); acc[a][b][m][n] = (f32x4){z0[0], z0[1], z1[0], z1[1]}; }
        cur = nxt; cA = nA; cB = nB; ++ui;
        if constexpr (GATHER) { PG8_GTOK(gA, ui); }
        if constexpr (ALIGN_EPI) { if (wr == 1) PG8_BAR; }
    }
    PG8_WAIT_V(0);
    if constexpr (!ALIGN_EPI) { if (wr == 0) PG8_BAR; }
    PG8_BAR;
#undef PG8_SA
#undef PG8_SB
#undef PG8_STAGE_R
#undef PG8_STAGE_S
#undef PG8_WAIT_VR
#undef PG8_STAGE_B
#undef PG8_LDA
#undef PG8_STAGE_A1
#undef PG8_STAGE_A2
#undef PG8_GTOK
#undef PG8_LDB
#undef PG8_MMA
#undef PG8_WAIT_V
#undef PG8_WAIT_L
#undef PG8_BAR
#undef PG8_SCHED
}

struct EpiHgIn {
    static constexpr bool PERM = true; static constexpr int NST = 16;
    bf16_t* out0; size_t seg_stride; const float* omlF; const float* omlB;
    __device__ __forceinline__ void operator()(const f32x4 (&acc)[2][2][4][2], const Unit& u, int wr, int wc, int fr, int fq) const {
        const int seg = u.pn >> 2, colt = (u.pn & 3) * BM;
        bf16_t* base = out0 + (size_t)seg * seg_stride;
        const int row0 = u.pm * BM + wr * 64 + fr, col0 = colt + wc * 32 + 8 * fq;
        f32x4 ov[2][2];
        const float* oml = (seg == 2) ? omlF : omlB;
#pragma unroll
        for (int bj = 0; bj < 2; ++bj)
#pragma unroll
            for (int n = 0; n < 2; ++n) ov[bj][n] = (seg == 2 || seg == 3) ? *(const f32x4*)(oml + col0 + bj * HALF + 4 * n) : (f32x4){1.f, 1.f, 1.f, 1.f};
        auto body = [&](auto act) {
#pragma unroll
            for (int ai = 0; ai < 2; ++ai)
#pragma unroll
                for (int m = 0; m < 4; ++m) { bf16_t* rowp = base + (size_t)(row0 + ai * HALF + m * 16) * D + col0;
#pragma unroll
                    for (int bj = 0; bj < 2; ++bj) { f32x4 v[2] = {acc[ai][bj][m][0], acc[ai][bj][m][1]};
#pragma unroll
                        for (int n = 0; n < 2; ++n)
#pragma unroll
                            for (int j = 0; j < 4; ++j) v[n][j] = act(v[n][j], ov[bj][n][j]);
                        u32x4 w; w.x = cvt_pk_bf16(v[0][0], v[0][1]); w.y = cvt_pk_bf16(v[0][2], v[0][3]); w.z = cvt_pk_bf16(v[1][0], v[1][1]); w.w = cvt_pk_bf16(v[1][2], v[1][3]);
                        *(u32x4*)(rowp + bj * HALF) = w; } } };
        if (seg == 0 || seg == 4) body([](float x, float) { return siluf(x); });
        else if (seg == 1) body([](float x, float) { return x; });
        else body([](float x, float o) { return o * frcp(1.0f + fexp(x)); });
    }
};
struct EpiMlIn {
    static constexpr bool PERM = true; static constexpr int NST = 0;
    bf16_t* out0; size_t seg_stride; float* gt; const float* bgate;
    __device__ __forceinline__ void operator()(const f32x4 (&acc)[2][2][4][2], const Unit& u, int wr, int wc, int fr, int fq) const {
        const int seg = u.pn >> 2, colt = (u.pn & 3) * BM;
        const int row0 = u.pm * BM + wr * 64 + fr, col0 = colt + wc * 32 + 8 * fq;
        if (seg == 3) {
            if (wc == 0) {
                const f32x4 b0 = *(const f32x4*)(bgate + 8 * fq), b1 = *(const f32x4*)(bgate + 8 * fq + 4);
#pragma unroll
                for (int ai = 0; ai < 2; ++ai)
#pragma unroll
                    for (int m = 0; m < 4; ++m) { float* rowp = gt + (size_t)(row0 + ai * HALF + m * 16) * 32 + 8 * fq; f32x4 v[2] = {acc[ai][0][m][0] + b0, acc[ai][0][m][1] + b1};
#pragma unroll
                        for (int n = 0; n < 2; ++n)
#pragma unroll
                            for (int j = 0; j < 4; ++j) { const float y = v[n][j] * (1.0f / 15.0f); float t = 15.0f * (1.0f - 2.0f * frcp(1.0f + fexp(2.0f * y)));
                                if (fq >= 2) t = fminf(t, 0.f) - __logf(1.0f + fexp(-fabsf(t)));
                                v[n][j] = t; }
                        *(f32x4*)(rowp) = v[0]; *(f32x4*)(rowp + 4) = v[1]; }
            }
            return;
        }
        bf16_t* base = out0 + (size_t)seg * seg_stride;
        auto body = [&](auto act) {
#pragma unroll
            for (int ai = 0; ai < 2; ++ai)
#pragma unroll
                for (int m = 0; m < 4; ++m) { bf16_t* rowp = base + (size_t)(row0 + ai * HALF + m * 16) * D + col0;
#pragma unroll
                    for (int bj = 0; bj < 2; ++bj) { f32x4 v[2] = {acc[ai][bj][m][0], acc[ai][bj][m][1]};
#pragma unroll
                        for (int n = 0; n < 2; ++n)
#pragma unroll
                            for (int j = 0; j < 4; ++j) v[n][j] = act(v[n][j]);
                        u32x4 w; w.x = cvt_pk_bf16(v[0][0], v[0][1]); w.y = cvt_pk_bf16(v[0][2], v[0][3]); w.z = cvt_pk_bf16(v[1][0], v[1][1]); w.w = cvt_pk_bf16(v[1][2], v[1][3]);
                        *(u32x4*)(rowp + bj * HALF) = w; } } };
        if (seg == 2) body([](float x) { return frcp(1.0f + fexp(-x)); });
        else body([](float x) { return x; });
    }
};
template <bool IN_BF16> struct EpiResid {
    static constexpr bool PERM = true; static constexpr int NST = 8;
    const void* in_ctx; const void* in_lat; bf16_t* out; const float* mod_ctx; const float* mod_lat; int row_off; float asc;
    __device__ __forceinline__ void operator()(const f32x4 (&acc)[2][2][4][2], const Unit& u, int wr, int wc, int, int) const {
        const int ln = lane_now(), fr = ln & 15, fq = ln >> 4;
        const int R0 = u.pm * BM + row_off;
        const bool isctx = R0 < NTC;
        const float* mod = isctx ? mod_ctx : mod_lat + (size_t)((R0 - NTC) / SEQ) * (6 * D);
        const size_t inrow0 = isctx ? (size_t)R0 : (size_t)(R0 - NTC);
        const int rl0 = wr * 64 + fr, col0 = u.pn * BM + wc * 32 + 8 * fq;
        const unsigned long long inb = (isctx ? (unsigned long long)in_ctx : (unsigned long long)in_lat) + (unsigned long long)(inrow0 * D) * (IN_BF16 ? 2u : 4u);
        f32x4 mv[2][2];
#pragma unroll
        for (int bj = 0; bj < 2; ++bj)
#pragma unroll
            for (int n = 0; n < 2; ++n) mv[bj][n] = *(const f32x4*)(mod + col0 + bj * HALF + 4 * n) * asc;
#pragma unroll
        for (int ai = 0; ai < 2; ++ai) {
            if constexpr (IN_BF16) {
                u32x4 rb[4][2];
#pragma unroll
                for (int m = 0; m < 4; ++m)
#pragma unroll
                    for (int bj = 0; bj < 2; ++bj) rb[m][bj] = *(const __attribute__((address_space(1))) u32x4*)(inb + ((unsigned long long)(rl0 + ai * HALF + m * 16) * D + col0 + bj * HALF) * 2u);
                __builtin_amdgcn_sched_barrier(0);
#pragma unroll
                for (int m = 0; m < 4; ++m)
#pragma unroll
                    for (int bj = 0; bj < 2; ++bj) { const u32x4 w = rb[m][bj];
                        const f32x4 x0 = (f32x4){__uint_as_float(w.x << 16), __uint_as_float(w.x & 0xffff0000u), __uint_as_float(w.y << 16), __uint_as_float(w.y & 0xffff0000u)};
                        const f32x4 x1 = (f32x4){__uint_as_float(w.z << 16), __uint_as_float(w.z & 0xffff0000u), __uint_as_float(w.w << 16), __uint_as_float(w.w & 0xffff0000u)};
                        const f32x4 v0 = x0 + mv[bj][0] * acc[ai][bj][m][0], v1 = x1 + mv[bj][1] * acc[ai][bj][m][1];
                        u32x4 o; o.x = cvt_pk_bf16(v0[0], v0[1]); o.y = cvt_pk_bf16(v0[2], v0[3]); o.z = cvt_pk_bf16(v1[0], v1[1]); o.w = cvt_pk_bf16(v1[2], v1[3]);
                        *(u32x4*)(out + (size_t)(R0 + rl0 + ai * HALF + m * 16) * D + col0 + bj * HALF) = o; }
            } else {
                f32x4 rf[4][2][2];
#pragma unroll
                for (int m = 0; m < 4; ++m)
#pragma unroll
                    for (int bj = 0; bj < 2; ++bj) { const __attribute__((address_space(1))) f32x4* ip = (const __attribute__((address_space(1))) f32x4*)(inb + ((unsigned long long)(rl0 + ai * HALF + m * 16) * D + col0 + bj * HALF) * 4u); rf[m][bj][0] = ip[0]; rf[m][bj][1] = ip[1]; }
                __builtin_amdgcn_sched_barrier(0);
#pragma unroll
                for (int m = 0; m < 4; ++m)
#pragma unroll
                    for (int bj = 0; bj < 2; ++bj) { const f32x4 v0 = rf[m][bj][0] + mv[bj][0] * acc[ai][bj][m][0], v1 = rf[m][bj][1] + mv[bj][1] * acc[ai][bj][m][1];
                        u32x4 o; o.x = cvt_pk_bf16(v0[0], v0[1]); o.y = cvt_pk_bf16(v0[2], v0[3]); o.z = cvt_pk_bf16(v1[0], v1[1]); o.w = cvt_pk_bf16(v1[2], v1[3]);
                        *(u32x4*)(out + (size_t)(R0 + rl0 + ai * HALF + m * 16) * D + col0 + bj * HALF) = o; }
            }
            __builtin_amdgcn_sched_barrier(0);
        }
    }
};
struct EpiSwiglu {
    static constexpr bool PERM = true; static constexpr int NST = 8;
    bf16_t* H; const float* b1;
    __device__ __forceinline__ void operator()(const f32x4 (&acc)[2][2][4][2], const Unit& u, int wr, int wc, int, int) const {
        const int e = u.bt >> 3; const int ln = lane_now(), fr = ln & 15, fq = ln >> 4;
        const int row0 = u.pm * BM + wr * 64 + fr, col0 = u.pn * HALF + wc * 32 + 8 * fq;
        const float* bb = b1 + (size_t)e * 2048 + col0;
        f32x4 bg[2], bl[2];
#pragma unroll
        for (int n = 0; n < 2; ++n) { bg[n] = *(const f32x4*)(bb + 4 * n); bl[n] = *(const f32x4*)(bb + 1024 + 4 * n) + 1.0f; }
#pragma unroll
        for (int ai = 0; ai < 2; ++ai)
#pragma unroll
            for (int m = 0; m < 4; ++m) { unsigned char* rowp = (unsigned char*)H + (size_t)(row0 + ai * HALF + m * 16) * D + col0;
                f32x2 v[2][2];
#pragma unroll
                for (int n = 0; n < 2; ++n)
#pragma unroll
                    for (int jp = 0; jp < 2; ++jp) {
                        const f32x2 ag = (f32x2){acc[ai][0][m][n][2 * jp], acc[ai][0][m][n][2 * jp + 1]}, al = (f32x2){acc[ai][1][m][n][2 * jp], acc[ai][1][m][n][2 * jp + 1]};
                        const f32x2 g2 = __builtin_elementwise_fma(ag, (f32x2){0.0625f, 0.0625f}, (f32x2){bg[n][2 * jp], bg[n][2 * jp + 1]});
                        const f32x2 l2 = __builtin_elementwise_fma(al, (f32x2){0.0625f, 0.0625f}, (f32x2){bl[n][2 * jp], bl[n][2 * jp + 1]});
                        const f32x2 gl = (f32x2){fminf(g2[0], 7.0f), fminf(g2[1], 7.0f)};
                        const f32x2 lc = (f32x2){__builtin_amdgcn_fmed3f(l2[0], -6.0f, 8.0f), __builtin_amdgcn_fmed3f(l2[1], -6.0f, 8.0f)};
                        const f32x2 t2 = gl * (f32x2){-1.702f * 1.44269504089f, -1.702f * 1.44269504089f};
                        const f32x2 d2 = (f32x2){__builtin_amdgcn_exp2f(t2[0]), __builtin_amdgcn_exp2f(t2[1])} + (f32x2){1.0f, 1.0f};
                        const f32x2 r2 = (f32x2){frcp(d2[0]), frcp(d2[1])};
                        v[n][jp] = (gl * lc) * r2; }
                v2u w; w.x = pk4_fp8(v[0][0][0], v[0][0][1], v[0][1][0], v[0][1][1]); w.y = pk4_fp8(v[1][0][0], v[1][0][1], v[1][1][0], v[1][1][1]);
                *(v2u*)(rowp) = w; }
    }
};
struct EpiW2 {
    static constexpr bool PERM = true; static constexpr int NST = 16;
    bf16_t* Y; const float* b2;
    __device__ __forceinline__ void operator()(const f32x4 (&acc)[2][2][4][2], const Unit& u, int wr, int wc, int fr, int fq) const {
        const int e = u.bt >> 2;
        const int row0 = u.pm * BM + wr * 64 + fr, col0 = u.pn * BM + wc * 32 + 8 * fq;
        const float* bb = b2 + (size_t)e * 1024 + col0;
        f32x4 bv[2][2];
#pragma unroll
        for (int bj = 0; bj < 2; ++bj)
#pragma unroll
            for (int n = 0; n < 2; ++n) bv[bj][n] = *(const f32x4*)(bb + bj * HALF + 4 * n) * 16.0f;
#pragma unroll
        for (int ai = 0; ai < 2; ++ai)
#pragma unroll
            for (int m = 0; m < 4; ++m) { unsigned char* rowp = (unsigned char*)Y + (size_t)(row0 + ai * HALF + m * 16) * D + col0;
#pragma unroll
                for (int bj = 0; bj < 2; ++bj) { f32x4 v0 = acc[ai][bj][m][0] + bv[bj][0], v1 = acc[ai][bj][m][1] + bv[bj][1];
#pragma unroll
                    for (int j = 0; j < 4; ++j) { v0[j] = __builtin_amdgcn_fmed3f(v0[j], -448.0f, 448.0f); v1[j] = __builtin_amdgcn_fmed3f(v1[j], -448.0f, 448.0f); }
                    v2u w; w.x = pk4_fp8(v0[0], v0[1], v0[2], v0[3]); w.y = pk4_fp8(v1[0], v1[1], v1[2], v1[3]);
                    *(v2u*)(rowp + bj * HALF) = w; } }
    }
};
}

#define XB_TMO      128
#define XB_XCNT(j)  (256  + 64 * (j))
#define XB_XSUB(j)  (1280 + 64 * (j))
#define XB_XGEN(j)  (2304 + 64 * (j))
#define XB_TOP      3328
#define XB_TOPGEN   3392
#define XCD_BAR_WORDS 3456
#define XB_SPIN_CAP (1u << 18)
__device__ __forceinline__ unsigned xb_ld(unsigned* p)              { return __hip_atomic_load(p, __ATOMIC_RELAXED, __HIP_MEMORY_SCOPE_AGENT); }
__device__ __forceinline__ unsigned xb_add(unsigned* p, unsigned v) { return __hip_atomic_fetch_add(p, v, __ATOMIC_RELAXED, __HIP_MEMORY_SCOPE_AGENT); }
__device__ __forceinline__ unsigned xb_xcc_id() { return (unsigned)__builtin_amdgcn_s_getreg((3 << 11) | 20) & 0xFu; }
#define XB_SPIN(cond, bar) do { unsigned _sp = 0; while (cond) { __builtin_amdgcn_s_sleep(1); \
    if ((++_sp & 255u) == 0u) { if (xb_ld(&(bar)[XB_TMO])) break; if (_sp > XB_SPIN_CAP) { atomicAdd(&(bar)[XB_TMO], 1u); break; } } } } while (0)
struct XcdBarrier { unsigned* bar; unsigned x; volatile LAS unsigned* st; };
__device__ __forceinline__ XcdBarrier xcd_barrier_post(unsigned* bar, volatile LAS unsigned* st) {
    XcdBarrier b; b.bar = bar; b.x = xb_xcc_id(); b.st = st;
    if (threadIdx.x == 0) (void)xb_add(&bar[XB_XCNT(b.x)], 1u);
    return b;
}
__device__ __forceinline__ void xcd_barrier_complete(unsigned* bar, unsigned x, unsigned& nloc, unsigned& nx) {
    const unsigned G = gridDim.x * gridDim.y * gridDim.z;
    unsigned sum, cnt, mine, sp = 0u;
    for (;;) {
        sum = 0u; cnt = 0u; mine = 0u;
#pragma unroll
        for (unsigned j = 0; j < 16; ++j) { const unsigned c = xb_ld(&bar[XB_XCNT(j)]); sum += c; cnt += (c > 0u) ? 1u : 0u; mine = (j == x) ? c : mine; }
        if (sum == G) break;
        __builtin_amdgcn_s_sleep(1);
        if ((++sp & 255u) == 0u) { if (xb_ld(&bar[XB_TMO])) break; if (sp > XB_SPIN_CAP) { atomicAdd(&bar[XB_TMO], 1u); break; } }
    }
    nloc = mine > 0u ? mine : 1u; nx = cnt > 0u ? cnt : 1u;
}
__device__ __forceinline__ void xcd_barrier(const XcdBarrier& b) {
    asm volatile("s_waitcnt vmcnt(0)" ::: "memory");
    __syncthreads();
    if (threadIdx.x == 0) {
        unsigned* bar = b.bar;
        __builtin_amdgcn_s_waitcnt(0);
        unsigned nloc = b.st[0], nx = b.st[1];
        if (nloc == 0u) { xcd_barrier_complete(bar, b.x, nloc, nx); b.st[0] = nloc; b.st[1] = nx; }
        const unsigned old = xb_add(&bar[XB_XSUB(b.x)], 1u);
        const unsigned gen = old / nloc;
        if (old + 1u == (gen + 1u) * nloc) {
            __builtin_amdgcn_fence(__ATOMIC_RELEASE, "agent");
            asm volatile("s_waitcnt vmcnt(0)" ::: "memory");
            const unsigned og = xb_add(&bar[XB_TOP], 1u);
            const unsigned tg = og / nx;
            if (og + 1u == (tg + 1u) * nx) xb_add(&bar[XB_TOPGEN], 1u);
            else XB_SPIN(xb_ld(&bar[XB_TOPGEN]) == tg, bar);
            __builtin_amdgcn_fence(__ATOMIC_ACQUIRE, "agent");
            xb_add(&bar[XB_XGEN(b.x)], 1u);
            asm volatile("s_waitcnt vmcnt(0)" ::: "memory");
        } else {
            XB_SPIN(xb_ld(&bar[XB_XGEN(b.x)]) == gen, bar);
            __builtin_amdgcn_fence(__ATOMIC_ACQUIRE, "agent");
            asm volatile("s_waitcnt vmcnt(0)" ::: "memory");
        }
    }
    __syncthreads();
}

struct Args { const float* in[25]; float* out; unsigned char* ws; int ph_lo, ph_hi; };
typedef const volatile __attribute__((address_space(4))) Args& ArgsRef;
enum { I_X = 0, I_C, I_CTX, I_CCTX, I_ADAW, I_ADAB, I_NMIXG, I_NFFNG, I_HGWIN, I_HGLB, I_HGNG, I_HGWOUT, I_MLWIN, I_MLBG, I_MLCW, I_MLCB, I_MLNG, I_MLWOUT, I_RW, I_RB, I_W1, I_B1, I_W2, I_B2, I_FNG };

__device__ __forceinline__ float wave_sum(float v) {
#pragma unroll
    for (int o = 1; o < 64; o <<= 1) v += __shfl_xor(v, o);
    return v;
}

struct TItem { const float* W; bf16* WT; int N, drow, k0, n0, f8; };
__device__ __forceinline__ void titem_load(const TItem& t, float (&tv)[32], int lane) {
#pragma unroll
    for (int i = 0; i < 32; ++i) tv[i] = t.W[(size_t)(t.k0 + 2 * i + (lane >> 5)) * t.N + t.n0 + (lane & 31)];
}

template <int LAYER> __device__ __forceinline__ void expert_tiles(ArgsRef a, LAS unsigned char* lds, int max_tiles) {
    const int tid = threadIdx.x, lane = tid & 63, wave = __builtin_amdgcn_readfirstlane(tid >> 6);
    constexpr int TP = 260;
    LAS float* T = (LAS float*)lds;
    const float* W1 = a.in[I_W1] + (size_t)LAYER * 32 * D * 2048; const float* W2 = a.in[I_W2] + (size_t)LAYER * 32 * D * D;
    unsigned char* W1T = a.ws + WS_W1 + (size_t)LAYER * 32 * 2048 * D; unsigned char* W2T = a.ws + WS_W2 + (size_t)LAYER * 32 * D * D;
    constexpr int NT1 = 32 * 64, NL = NT1 + 32 * 32;
    auto tsrc = [&](int t, int& N) -> const float* { if (t < NT1) { const int mat = t >> 6, r = t & 63; N = 2048; return W1 + ((size_t)mat * D + 128 * (r >> 3)) * 2048 + 256 * (r & 7); }
        const int t2 = t - NT1, mat = t2 >> 5, r = t2 & 31; N = D; return W2 + ((size_t)mat * D + 128 * (r >> 2)) * D + 256 * (r & 3); };
    unsigned* tcnt = (unsigned*)(a.ws + WS_CTL) + CW_TILE + LAYER; LAS int* tq = (LAS int*)(lds + LDS_MISC + 16);
    __syncthreads();
    if (tid == 0) { tq[1] = max_tiles >= 1 ? (int)__hip_atomic_fetch_add(tcnt, 1u, __ATOMIC_RELAXED, __HIP_MEMORY_SCOPE_AGENT) : NL;
                    tq[0] = max_tiles >= 2 ? (int)__hip_atomic_fetch_add(tcnt, 1u, __ATOMIC_RELAXED, __HIP_MEMORY_SCOPE_AGENT) : NL; }
    __syncthreads();
    int t = tq[1];
    if (t < NL) {
        f32x4 v[16]; { int N; const float* sp = tsrc(t, N) + (size_t)(16 * wave) * N + 4 * lane;
#pragma unroll
            for (int i = 0; i < 16; ++i) v[i] = *(const f32x4*)(sp + (size_t)i * N); }
        for (int k = 1; ; ++k) {
#pragma unroll
            for (int i = 0; i < 16; ++i) *(LAS f32x4*)(T + (16 * wave + i) * TP + ((4 * lane + 8 * wave) & 255)) = v[i];
            __syncthreads();
            const int tn = tq[(k + 1) & 1]; unsigned tnn = 0u; const bool want = (k + 2 <= max_tiles) && tn < NL;
            if (tid == 0 && want) tnn = __hip_atomic_fetch_add(tcnt, 1u, __ATOMIC_RELAXED, __HIP_MEMORY_SCOPE_AGENT);
            if (tn < NL) { int N2; const float* sp = tsrc(tn, N2) + (size_t)(16 * wave) * N2 + 4 * lane;
#pragma unroll
                for (int i = 0; i < 16; ++i) v[i] = *(const f32x4*)(sp + (size_t)i * N2); }
            __builtin_amdgcn_sched_barrier(0);
            const int ks = lane & 7, nl = lane >> 3;
#pragma unroll
            for (int q = 0; q < 4; ++q) { const int n = 32 * wave + 8 * q + nl; unsigned char* dp;
                if (t < NT1) { const int mat = t >> 6, r = t & 63, ng = 256 * (r & 7) + n, cc = ng & 1023, bj = ng >> 10; dp = W1T + ((size_t)mat * 2048 + 256 * (cc >> 7) + 128 * bj + (cc & 127)) * D + 128 * (r >> 3); }
                else { const int t2 = t - NT1, mat = t2 >> 5, r = t2 & 31; dp = W2T + ((size_t)mat * D + 256 * (r & 3) + n) * D + 128 * (r >> 2); }
                const LAS float* tp = T + (16 * ks) * TP + ((n + 8 * ks) & 255); float x[16];
#pragma unroll
                for (int i = 0; i < 16; ++i) x[i] = 16.f * tp[i * TP];
                v4u o; o.x = pk4_fp8(x[0], x[1], x[2], x[3]); o.y = pk4_fp8(x[4], x[5], x[6], x[7]); o.z = pk4_fp8(x[8], x[9], x[10], x[11]); o.w = pk4_fp8(x[12], x[13], x[14], x[15]);
                *(v4u*)(dp + 16 * ks) = o; }
            if (tid == 0) tq[k & 1] = want ? (int)tnn : NL;
            __syncthreads();
            if (tn >= NL) break;
            t = tn;
        }
    }
}
template <class Sched> __device__ __forceinline__ bool idle_last_round(const Sched& S) { pg8::Unit u; Sched S0 = S; S0.c = 0; int n = 0, n0 = 0; while (S.next(n, u)) ++n; while (S0.next(n0, u)) ++n0; return n < n0; }

__device__ __forceinline__ void ph_prologue(ArgsRef a, LAS unsigned char* lds) {
    const int tid = threadIdx.x, lane = tid & 63, wave = __builtin_amdgcn_readfirstlane(tid >> 6), G = gridDim.x;
    unsigned char* ws = a.ws;
    float* modl = (float*)(ws + WS_SM + SM_MODL); float* modc = (float*)(ws + WS_SM + SM_MODC); float* oml = (float*)(ws + WS_SM + SM_OML);
    {
        LAS float* actT = (LAS float*)lds;
        LAS float* red = (LAS float*)(lds + 81920);
        bool staged = false;
        for (int it = blockIdx.x; it < 192; it += G) {
            if (!staged) {
                { float cv[34];
#pragma unroll
                    for (int i = 0; i < 34; ++i) { const int r = i >> 1, k = tid + 512 * (i & 1); cv[i] = r < 16 ? a.in[I_C][r * 1024 + k] : a.in[I_CCTX][k]; }
                    __builtin_amdgcn_sched_barrier(0);
#pragma unroll
                    for (int i = 0; i < 34; ++i) { const int r = i >> 1, k = tid + 512 * (i & 1); actT[k * 20 + r] = siluf(cv[i]); } }
                __syncthreads(); staged = true;
            }
            const int layer = it / 96, n0 = (it % 96) * 64;
            const float* W = a.in[I_ADAW] + (size_t)layer * D * 6 * D + n0 + lane;
            float acc[17];
#pragma unroll
            for (int r = 0; r < 17; ++r) acc[r] = 0.f;
#pragma unroll 1
            for (int kb = wave * 128; kb < wave * 128 + 128; kb += 32) {
              float wv[32];
#pragma unroll
              for (int i = 0; i < 32; ++i) wv[i] = W[(size_t)(kb + i) * (6 * D)];
              __builtin_amdgcn_sched_barrier(0);
#pragma unroll
              for (int i = 0; i < 32; ++i) { const int k = kb + i; const float w = wv[i];
                const LAS f32x4* ap = (const LAS f32x4*)(actT + k * 20);
                const f32x4 a0 = ap[0], a1 = ap[1], a2 = ap[2], a3 = ap[3]; const float a16 = actT[k * 20 + 16];
                acc[0] += a0[0] * w; acc[1] += a0[1] * w; acc[2] += a0[2] * w; acc[3] += a0[3] * w;
                acc[4] += a1[0] * w; acc[5] += a1[1] * w; acc[6] += a1[2] * w; acc[7] += a1[3] * w;
                acc[8] += a2[0] * w; acc[9] += a2[1] * w; acc[10] += a2[2] * w; acc[11] += a2[3] * w;
                acc[12] += a3[0] * w; acc[13] += a3[1] * w; acc[14] += a3[2] * w; acc[15] += a3[3] * w;
                acc[16] += a16 * w;
              }
            }
#pragma unroll
            for (int r = 0; r < 17; ++r) red[(wave * 17 + r) * 64 + lane] = acc[r];
            __syncthreads();
            for (int idx = tid; idx < 17 * 64; idx += NTHREADS) { const int r = idx >> 6, l = idx & 63; float s = a.in[I_ADAB][layer * 6 * D + n0 + l];
#pragma unroll
                for (int w = 0; w < 8; ++w) s += red[(w * 17 + r) * 64 + l];
                const int sl = (n0 + l) >> 10, dcol = (n0 + l) & 1023;
                if (sl == 1) s = a.in[I_NMIXG][layer * D + dcol] * (1.0f + s); else if (sl == 4) s = a.in[I_NFFNG][layer * D + dcol] * (1.0f + s);
                if (r < 16) modl[((size_t)layer * 16 + r) * (6 * D) + n0 + l] = s; else modc[(size_t)layer * (6 * D) + n0 + l] = s; }
            __syncthreads();
        }
        __syncthreads();
    }
    {
        const int gt = blockIdx.x * NTHREADS + tid;
        if (gt < 2 * D) { const int dir = gt >> 10, c = gt & 1023; const float* lg = a.in[I_HGLB] + (size_t)dir * 3 * D + c;
            const float l0 = lg[0], l1 = lg[D], l2 = lg[2 * D]; const float mx = fmaxf(l0, fmaxf(l1, l2));
            const float e0 = __expf(l0 - mx), e1 = __expf(l1 - mx), e2 = __expf(l2 - mx);
            oml[gt] = (e1 + e2) / (e0 + e1 + e2); }
    }
    {
        LAS float* scr = (LAS float*)(lds + wave * 16384);
        const int gw = blockIdx.x * NWAVES + wave, NGW = G * NWAVES;
        bf16* WHGIN = (bf16*)(ws + WS_WHGIN); bf16* WHGOUT = (bf16*)(ws + WS_WHGOUT); bf16* WMLIN = (bf16*)(ws + WS_WMLIN); bf16* WMLOUT = (bf16*)(ws + WS_WMLOUT);
        bf16* W1T = (bf16*)(ws + WS_W1); bf16* W2T = (bf16*)(ws + WS_W2);
        constexpr int S0 = 16 * 160, S1 = 16 * 32, S2 = 16 * 97, S3 = 16 * 32, S4 = 64 * 16 * 64, S5 = 64 * 16 * 32;
        constexpr int NITEMS = S0 + S1 + S2 + S3;
        auto decode = [&](int it) -> TItem { int r = it; TItem t;
            if (r < S0) { t.f8 = 0; t.W = a.in[I_HGWIN]; t.N = HG_N; t.WT = WHGIN; t.drow = (r % 160) * 32; t.k0 = (r / 160) * 64; t.n0 = (r % 160) * 32; return t; } r -= S0;
            if (r < S1) { t.f8 = OUTPROJ_FP8; t.W = a.in[I_HGWOUT]; t.N = D; t.WT = WHGOUT; t.drow = (r % 32) * 32; t.k0 = (r / 32) * 64; t.n0 = (r % 32) * 32; return t; } r -= S1;
            if (r < S2) { t.f8 = 0; t.W = a.in[I_MLWIN]; t.N = ML_N; t.WT = WMLIN; t.drow = (r % 97) * 32; t.k0 = (r / 97) * 64; t.n0 = (r % 97) * 32; return t; } r -= S2;
            if (r < S3) { t.f8 = OUTPROJ_FP8; t.W = a.in[I_MLWOUT]; t.N = D; t.WT = WMLOUT; t.drow = (r % 32) * 32; t.k0 = (r / 32) * 64; t.n0 = (r % 32) * 32; return t; } r -= S3;
            if (r < S4) { const int mat = r >> 10, q = r & 1023, nb = q & 63, kb = q >> 6; const int n0 = nb * 32, cc = n0 & 1023, bj = n0 >> 10;
                t.f8 = 1; t.W = a.in[I_W1] + (size_t)mat * D * 2048; t.N = 2048; t.WT = (bf16*)((unsigned char*)W1T + (size_t)mat * 2048 * D); t.drow = 256 * (cc >> 7) + 128 * bj + (cc & 127); t.k0 = kb * 64; t.n0 = n0; return t; } r -= S4;
            { const int mat = r >> 9, q = r & 511, nb = q & 31, kb = q >> 5;
                t.f8 = 1; t.W = a.in[I_W2] + (size_t)mat * D * D; t.N = D; t.WT = (bf16*)((unsigned char*)W2T + (size_t)mat * D * D); t.drow = nb * 32; t.k0 = kb * 64; t.n0 = nb * 32; return t; } };
        float tv[32]; TItem cur = decode(gw < NITEMS ? gw : 0);
        titem_load(cur, tv, lane);
        for (int it = gw; it < NITEMS; it += NGW) {
#pragma unroll
            for (int i = 0; i < 32; ++i) scr[(2 * i + (lane >> 5)) * 33 + (lane & 31)] = tv[i];
            LDS_WAIT(); asm volatile("" ::: "memory");
            const TItem nxt = decode(it + NGW < NITEMS ? it + NGW : it);
            if (it + NGW < NITEMS) titem_load(nxt, tv, lane);
            const int c = lane & 7;
#pragma unroll
            for (int j = 0; j < 4; ++j) { const int n = (lane >> 3) + 8 * j; const LAS float* sp = scr + (8 * c) * 33 + n;
                if (cur.f8) { v2u o8; o8.x = pk4_fp8(16.f * sp[0 * 33], 16.f * sp[1 * 33], 16.f * sp[2 * 33], 16.f * sp[3 * 33]); o8.y = pk4_fp8(16.f * sp[4 * 33], 16.f * sp[5 * 33], 16.f * sp[6 * 33], 16.f * sp[7 * 33]);
                    *(v2u*)((unsigned char*)cur.WT + (size_t)(cur.drow + n) * D + cur.k0 + 8 * c) = o8; }
                else { v4u o; o.x = pk2(sp[0 * 33], sp[1 * 33]); o.y = pk2(sp[2 * 33], sp[3 * 33]); o.z = pk2(sp[4 * 33], sp[5 * 33]); o.w = pk2(sp[6 * 33], sp[7 * 33]);
                    *(v4u*)(cur.WT + (size_t)(cur.drow + n) * D + cur.k0 + 8 * c) = o; } }
            LDS_WAIT(); asm volatile("" ::: "memory");
            cur = nxt;
        }
        for (size_t i = (size_t)blockIdx.x * NTHREADS + tid; i < (size_t)(ML_NP - ML_N) * D / 8; i += (size_t)G * NTHREADS) ((v4u*)(WMLIN + (size_t)ML_N * D))[i] = (v4u){0u, 0u, 0u, 0u};
    }
    expert_tiles<0>(a, lds, 1 << 30);
}

__device__ __forceinline__ void ph_modulate(ArgsRef a, const float* src_ctx, const float* src_lat, const float* g, int layer, int shift_idx, int R0, int R1, bf16* out) {
    const int tid = threadIdx.x, lane = tid & 63, wave = __builtin_amdgcn_readfirstlane(tid >> 6);
    const float* modl = (const float*)(a.ws + WS_SM + SM_MODL) + (size_t)layer * 16 * 6 * D; const float* modc = (const float*)(a.ws + WS_SM + SM_MODC) + (size_t)layer * 6 * D;
    const int gw = blockIdx.x * NWAVES + wave, NGW = gridDim.x * NWAVES;
    for (int Rq = R0 + gw; Rq < R1; Rq += 3 * NGW) {
        f32x4 v[3][4], sh[3][4], sc[3][4];
#pragma unroll
        for (int u = 0; u < 3; ++u) { const int R = (Rq + u * NGW < R1) ? Rq + u * NGW : Rq;
            const bool isctx = R < NTC;
            const float* xr = isctx ? src_ctx + (size_t)R * D : src_lat + (size_t)(R - NTC) * D;
            const float* mod = isctx ? modc : modl + (size_t)((R - NTC) / SEQ) * 6 * D;
#pragma unroll
            for (int j = 0; j < 4; ++j) { v[u][j] = ((const f32x4*)xr)[64 * j + lane]; sh[u][j] = ((const f32x4*)(mod + shift_idx * D))[64 * j + lane]; sc[u][j] = ((const f32x4*)(mod + (shift_idx + 1) * D))[64 * j + lane]; } }
        __builtin_amdgcn_sched_barrier(0);
#pragma unroll
        for (int u = 0; u < 3; ++u) { const int R = Rq + u * NGW;
            float ss = 0.f;
#pragma unroll
            for (int j = 0; j < 4; ++j) ss += (v[u][j][0] * v[u][j][0] + v[u][j][1] * v[u][j][1]) + (v[u][j][2] * v[u][j][2] + v[u][j][3] * v[u][j][3]);
            const float rs = 1.0f / sqrtf(wave_sum(ss) * (1.0f / D) + EPS);
            if (R < R1) { v2u* o8 = (v2u*)(out + (size_t)R * D);
#pragma unroll
                for (int j = 0; j < 4; ++j) { const f32x4 y = v[u][j] * rs * sc[u][j] + sh[u][j];
                    v2u w; w.x = pk2(y[0], y[1]); w.y = pk2(y[2], y[3]); o8[64 * j + lane] = w; } } }
    }
}

__device__ __forceinline__ int seq_row(int b, int dir, int p) {
    if (p < CTX) { const int t = dir ? CTX - 1 - p : p; return b * CTX + t; }
    const int pl = p - CTX; const int t = dir ? SEQ - 1 - pl : pl; return NTC + b * SEQ + t;
}


typedef short s16x4 __attribute__((ext_vector_type(4)));
typedef float f32x16 __attribute__((ext_vector_type(16)));
__device__ __forceinline__ unsigned offb(unsigned row, unsigned ch) { return 256u * row + 16u * (ch ^ (((row & 3u) << 2) | ((row >> 2) & 3u))); }
__device__ __forceinline__ s16x4 tr16(const LAS unsigned char* p) { return __builtin_amdgcn_ds_read_tr16_b64_v4i16((LAS s16x4*)p); }
__device__ __forceinline__ bf16x8 rd_row_b(const LAS unsigned char* tile, int lane, int rb, int kk) { return *(const LAS bf16x8*)(tile + offb(32 * rb + (lane & 31), 2 * kk + (lane >> 5))); }
__device__ __forceinline__ bf16x8 rd_tr_b(const LAS unsigned char* tile, int lane, int c, int ks) {
    const unsigned h = lane >> 5, blk = (lane >> 4) & 1, q = (lane & 15) >> 2, p = lane & 3;
    const s16x4 x = tr16(tile + offb(16 * ks + 8 * h + q, 4 * c + 2 * blk + (p >> 1)) + 8 * (p & 1));
    const s16x4 y = tr16(tile + offb(16 * ks + 8 * h + 4 + q, 4 * c + 2 * blk + (p >> 1)) + 8 * (p & 1));
    return (bf16x8){x[0], x[1], x[2], x[3], y[0], y[1], y[2], y[3]};
}
__device__ __forceinline__ bf16x8 rd_row_p(const LAS unsigned char* tile, int st, int lane, int rb, int kk) { return *(const LAS bf16x8*)(tile + (32 * rb + (lane & 31)) * st + (16 * kk + 8 * (lane >> 5)) * 2); }
__device__ __forceinline__ bf16x8 rd_tr_p(const LAS unsigned char* tile, int st, int lane, int c, int ks) {
    const unsigned h = lane >> 5, blk = (lane >> 4) & 1, q = (lane & 15) >> 2, p = lane & 3;
    const LAS unsigned char* b = tile + (16 * ks + 8 * h + q) * st + (32 * c + 16 * blk + 4 * p) * 2;
    const s16x4 x = tr16(b), y = tr16(b + 4 * st);
    return (bf16x8){x[0], x[1], x[2], x[3], y[0], y[1], y[2], y[3]};
}
__device__ __forceinline__ void tri_tile(int idx, int& ti4, int& si4) {
    ti4 = idx < 1 ? 0 : idx < 3 ? 1 : idx < 6 ? 2 : 3; si4 = idx - (ti4 * (ti4 + 1)) / 2;
}

__device__ __forceinline__ void ph_hg_scan(ArgsRef a, LAS unsigned char* lds) {
    const int tid = threadIdx.x, lane = tid & 63, w = __builtin_amdgcn_readfirstlane(tid >> 6), hh = lane >> 5, r32 = lane & 31;
    const bf16* QS = (const bf16*)(a.ws + WS_BIG); const bf16* VI = QS + (size_t)NT * D; const bf16* KF = VI + (size_t)NT * D; const bf16* KB = KF + (size_t)NT * D;
    bf16* OF = (bf16*)(a.ws + WS_BIG + 5 * T72); bf16* OB = OF + (size_t)NT * D;
    constexpr int SQ = 272, SV = 320, SA = 144;
    constexpr int O_QA = 0, O_KA = 17408, O_V = 34816, O_ST = 55296, O_ATT = 90112, O_OST = 99328, O_TOT = 116736, O_FIRST = 120832, O_EB = 124928, O_EG = 125440;
    LAS unsigned char* QA = lds + O_QA; LAS unsigned char* KA = lds + O_KA; LAS unsigned char* VT = lds + O_V; LAS unsigned char* ST = lds + O_ST;
    LAS unsigned char* ATT = lds + O_ATT; LAS unsigned char* OST = lds + O_OST;
    LAS float* TOT = (LAS float*)(lds + O_TOT); LAS float* FIRST = (LAS float*)(lds + O_FIRST); LAS float* EB = (LAS float*)(lds + O_EB); LAS float* EG = (LAS float*)(lds + O_EG);
    for (int i = tid; i < 64 * SA / 4; i += NTHREADS) ((LAS unsigned*)ATT)[i] = 0u;
    const int ls = tid >> 4, lc = tid & 15;
    const int tq = (lane & 15) >> 2, tp = lane & 3, tblk = (lane >> 4) & 1;
    const LAS unsigned char* rQA = QA + r32 * SQ + hh * 16;
    const LAS unsigned char* rST = ST + r32 * SQ + hh * 16;
    const LAS unsigned char* rATT = ATT + r32 * SA + hh * 16;
    const LAS unsigned char* tV = VT + (8 * hh + tq) * SV + (16 * tblk + 4 * tp) * 2;
    const LAS unsigned char* tK = KA + (8 * hh + tq) * SQ + (16 * tblk + 4 * tp) * 2;
    const int fr = lane & 15, fq = lane >> 4;
    const int ti = w >> 2, ej = w & 3, di = w >> 1, e2 = 2 * (w & 1);
    for (int item = blockIdx.x; item < 256; item += gridDim.x) {
        const int dir = item & 1, h = (item >> 1) & 7, b = item >> 4;
        const bf16* Kd = dir ? KB : KF; bf16* Od = dir ? OB : OF;
        f32x16 S0, S1;
#pragma unroll
        for (int i = 0; i < 16; ++i) { S0[i] = 0.f; S1[i] = 0.f; }
        v4u pq[2], pk[2], pv[2];
#pragma unroll
        for (int x = 0; x < 2; ++x) { const size_t off = (size_t)seq_row(b, dir, ls + 32 * x) * D + h * 128 + lc * 8; pq[x] = *(const v4u*)(QS + off); pk[x] = *(const v4u*)(Kd + off); pv[x] = *(const v4u*)(VI + off); }
#pragma unroll
        for (int x = 0; x < 2; ++x) { *(LAS v4u*)(QA + (ls + 32 * x) * SQ + lc * 16) = pq[x]; *(LAS v4u*)(KA + (ls + 32 * x) * SQ + lc * 16) = pk[x]; *(LAS v4u*)(VT + (ls + 32 * x) * SV + lc * 16) = pv[x]; }
        for (int ch = 0; ch < (CTX + SEQ) / 64; ++ch) {
            __syncthreads();
            if (ch + 1 < (CTX + SEQ) / 64) {
#pragma unroll
                for (int x = 0; x < 2; ++x) { const size_t off = (size_t)seq_row(b, dir, (ch + 1) * 64 + ls + 32 * x) * D + h * 128 + lc * 8; pq[x] = *(const v4u*)(QS + off); pk[x] = *(const v4u*)(Kd + off); pv[x] = *(const v4u*)(VI + off); }
            }
            unsigned kwv[8], qwv[8]; float l0[8], l1[8];
#pragma unroll
            for (int i = 0; i < 8; ++i) { kwv[i] = *(const LAS unsigned*)(KA + (8 * w + i) * SQ + lane * 4); qwv[i] = *(const LAS unsigned*)(QA + (8 * w + i) * SQ + lane * 4); }
            { float r0 = 0.f, r1 = 0.f;
#pragma unroll
                for (int i = 0; i < 8; ++i) { l0[i] = __builtin_amdgcn_logf(fmaxf(1.0f - bf2f(kwv[i] & 0xffffu), 1e-30f)); l1[i] = __builtin_amdgcn_logf(fmaxf(1.0f - bf2f(kwv[i] >> 16), 1e-30f)); r0 += l0[i]; r1 += l1[i]; }
                *(LAS f32x2*)(TOT + w * 128 + 2 * lane) = (f32x2){r0, r1}; *(LAS f32x2*)(FIRST + w * 128 + 2 * lane) = (f32x2){l0[0], l1[0]}; }
            __syncthreads();
            { float p0 = 0.f, p1 = 0.f, br0 = 0.f, br1 = 0.f, be0 = 0.f, be1 = 0.f; f32x2 tt[8];
#pragma unroll
                for (int o = 0; o < 8; ++o) tt[o] = *(const LAS f32x2*)(TOT + o * 128 + 2 * lane);
                const f32x2 ff = *(const LAS f32x2*)(FIRST + 4 * 128 + 2 * lane);
#pragma unroll
                for (int o = 0; o < 8; ++o) { if (o < w) { p0 += tt[o][0]; p1 += tt[o][1]; } if (o < 4) { br0 += tt[o][0]; br1 += tt[o][1]; } be0 += tt[o][0]; be1 += tt[o][1]; }
                br0 += ff[0]; br1 += ff[1];
#pragma unroll
                for (int i = 0; i < 8; ++i) { p0 += l0[i]; p1 += l1[i];
                    const float ea0 = __builtin_amdgcn_exp2f(p0 - br0), ea1 = __builtin_amdgcn_exp2f(p1 - br1), ek0 = __builtin_amdgcn_exp2f(br0 - p0), ek1 = __builtin_amdgcn_exp2f(br1 - p1);
                    *(LAS unsigned*)(QA + (8 * w + i) * SQ + lane * 4) = pk2(bf2f(qwv[i] & 0xffffu) * ea0, bf2f(qwv[i] >> 16) * ea1);
                    *(LAS unsigned*)(KA + (8 * w + i) * SQ + lane * 4) = pk2(bf2f(kwv[i] & 0xffffu) * ek0, bf2f(kwv[i] >> 16) * ek1); }
                if (w == 0) { *(LAS f32x2*)(EB + 2 * lane) = (f32x2){__builtin_amdgcn_exp2f(br0), __builtin_amdgcn_exp2f(br1)}; *(LAS f32x2*)(EG + 2 * lane) = (f32x2){__builtin_amdgcn_exp2f(be0 - br0), __builtin_amdgcn_exp2f(be1 - br1)}; } }
            __syncthreads();
            {
                f32x4 eb[4], eg[4];
#pragma unroll
                for (int g = 0; g < 4; ++g) { eb[g] = *(const LAS f32x4*)(EB + 32 * di + 8 * g + 4 * hh); eg[g] = *(const LAS f32x4*)(EG + 32 * di + 8 * g + 4 * hh); }
                bf16x8 kA[4], vB0[4], vB1[4];
#pragma unroll
                for (int kk = 0; kk < 4; ++kk) { const LAS unsigned char* pa = tK + kk * 16 * SQ + di * 64; const s16x4 x = tr16(pa), y = tr16(pa + 4 * SQ); kA[kk] = (bf16x8){x[0], x[1], x[2], x[3], y[0], y[1], y[2], y[3]}; }
#pragma unroll
                for (int kk = 0; kk < 4; ++kk) { const LAS unsigned char* pb = tV + kk * 16 * SV + e2 * 64; const s16x4 x = tr16(pb), y = tr16(pb + 4 * SV), x2 = tr16(pb + 64), y2 = tr16(pb + 64 + 4 * SV);
                    vB0[kk] = (bf16x8){x[0], x[1], x[2], x[3], y[0], y[1], y[2], y[3]}; vB1[kk] = (bf16x8){x2[0], x2[1], x2[2], x2[3], y2[0], y2[1], y2[2], y2[3]}; }
#pragma unroll
                for (int rep = 0; rep < 2; ++rep) { const int idx = w + 8 * rep; if (idx < 10) { int ti4, si4; tri_tile(idx, ti4, si4);
                    bf16x8 A[4], Bm[4];
#pragma unroll
                    for (int kk = 0; kk < 4; ++kk) { A[kk] = *(const LAS bf16x8*)(QA + (16 * ti4 + fr) * SQ + fq * 16 + kk * 64); Bm[kk] = *(const LAS bf16x8*)(KA + (16 * si4 + fr) * SQ + fq * 16 + kk * 64); }
                    f32x4 acc = (f32x4){0.f, 0.f, 0.f, 0.f};
#pragma unroll
                    for (int kk = 0; kk < 4; ++kk) acc = __builtin_amdgcn_mfma_f32_16x16x32_bf16(A[kk], Bm[kk], acc, 0, 0, 0);
                    const int scol = 16 * si4 + fr;
#pragma unroll
                    for (int r = 0; r < 4; ++r) { const int trow = 16 * ti4 + 4 * fq + r; *(LAS unsigned short*)(ATT + trow * SA + scol * 2) = (unsigned short)f2bf(scol <= trow ? acc[r] : 0.f); } } }
#pragma unroll
                for (int g = 0; g < 4; ++g) {
#pragma unroll
                    for (int j = 0; j < 4; ++j) { S0[4 * g + j] *= eb[g][j]; S1[4 * g + j] *= eb[g][j]; }
                    v2u w0, w1; w0.x = pk2(S0[4 * g], S0[4 * g + 1]); w0.y = pk2(S0[4 * g + 2], S0[4 * g + 3]); w1.x = pk2(S1[4 * g], S1[4 * g + 1]); w1.y = pk2(S1[4 * g + 2], S1[4 * g + 3]);
                    *(LAS v2u*)(ST + (32 * e2 + r32) * SQ + (32 * di + 8 * g + 4 * hh) * 2) = w0; *(LAS v2u*)(ST + (32 * e2 + 32 + r32) * SQ + (32 * di + 8 * g + 4 * hh) * 2) = w1; }
#pragma unroll
                for (int kk = 0; kk < 4; ++kk) { S0 = __builtin_amdgcn_mfma_f32_32x32x16_bf16(kA[kk], vB0[kk], S0, 0, 0, 0); S1 = __builtin_amdgcn_mfma_f32_32x32x16_bf16(kA[kk], vB1[kk], S1, 0, 0, 0); }
#pragma unroll
                for (int g = 0; g < 4; ++g)
#pragma unroll
                    for (int j = 0; j < 4; ++j) { S0[4 * g + j] *= eg[g][j]; S1[4 * g + j] *= eg[g][j]; }
            }
            __syncthreads();
            { f32x16 o;
#pragma unroll
                for (int i = 0; i < 16; ++i) o[i] = 0.f;
                bf16x8 A[4], Bm[4];
#pragma unroll
                for (int kk = 0; kk < 4; ++kk) { A[kk] = *(const LAS bf16x8*)(rATT + ti * 32 * SA + kk * 32); const LAS unsigned char* pb = tV + kk * 16 * SV + ej * 64; const s16x4 x = tr16(pb), y = tr16(pb + 4 * SV); Bm[kk] = (bf16x8){x[0], x[1], x[2], x[3], y[0], y[1], y[2], y[3]}; }
                bf16x8 A2[4], B2[4];
#pragma unroll
                for (int kk = 0; kk < 4; ++kk) { A2[kk] = *(const LAS bf16x8*)(rQA + ti * 32 * SQ + kk * 32); B2[kk] = *(const LAS bf16x8*)(rST + ej * 32 * SQ + kk * 32); }
#pragma unroll
                for (int kk = 0; kk < 4; ++kk) o = __builtin_amdgcn_mfma_f32_32x32x16_bf16(A[kk], Bm[kk], o, 0, 0, 0);
#pragma unroll
                for (int kk = 0; kk < 4; ++kk) { A[kk] = *(const LAS bf16x8*)(rQA + ti * 32 * SQ + (kk + 4) * 32); Bm[kk] = *(const LAS bf16x8*)(rST + ej * 32 * SQ + (kk + 4) * 32); }
#pragma unroll
                for (int kk = 0; kk < 4; ++kk) o = __builtin_amdgcn_mfma_f32_32x32x16_bf16(A2[kk], B2[kk], o, 0, 0, 0);
#pragma unroll
                for (int kk = 0; kk < 4; ++kk) o = __builtin_amdgcn_mfma_f32_32x32x16_bf16(A[kk], Bm[kk], o, 0, 0, 0);
                const int ecol = 32 * ej + r32;
#pragma unroll
                for (int r = 0; r < 16; ++r) { const int trow = 32 * ti + (r & 3) + 8 * (r >> 2) + 4 * hh; *(LAS unsigned short*)(OST + trow * SQ + ecol * 2) = (unsigned short)f2bf(o[r]); } }
            __syncthreads();
            if (ch + 1 < (CTX + SEQ) / 64) {
#pragma unroll
                for (int x = 0; x < 2; ++x) { *(LAS v4u*)(QA + (ls + 32 * x) * SQ + lc * 16) = pq[x]; *(LAS v4u*)(KA + (ls + 32 * x) * SQ + lc * 16) = pk[x]; *(LAS v4u*)(VT + (ls + 32 * x) * SV + lc * 16) = pv[x]; } }
#pragma unroll
            for (int x = 0; x < 2; ++x) { const int row = ls + 32 * x; const v4u val = *(const LAS v4u*)(OST + row * SQ + lc * 16);
                *(v4u*)(Od + (size_t)seq_row(b, dir, ch * 64 + row) * D + h * 128 + lc * 8) = val; }
        }
        __syncthreads();
    }
}


__device__ __forceinline__ float wave_incl_sum(float v) {
    v += dppf<0x111, 0xf>(0.f, v); v += dppf<0x112, 0xf>(0.f, v); v += dppf<0x114, 0xf>(0.f, v); v += dppf<0x118, 0xf>(0.f, v);
    v += dppf<0x142, 0xa>(0.f, v); v += dppf<0x143, 0xc>(0.f, v); return v;
}
__device__ __forceinline__ float wave_incl_max(float v) {
    const float ninf = -3.0e38f;
    v = fmaxf(v, dppf<0x111, 0xf>(ninf, v)); v = fmaxf(v, dppf<0x112, 0xf>(ninf, v)); v = fmaxf(v, dppf<0x114, 0xf>(ninf, v)); v = fmaxf(v, dppf<0x118, 0xf>(ninf, v));
    v = fmaxf(v, dppf<0x142, 0xa>(ninf, v)); v = fmaxf(v, dppf<0x143, 0xc>(ninf, v)); return v;
}
__device__ __forceinline__ void ph_ml_scan(ArgsRef a, LAS unsigned char* lds) {
    const int tid = threadIdx.x, lane = tid & 63, w = __builtin_amdgcn_readfirstlane(tid >> 6), hh = lane >> 5, r32 = lane & 31;
    const bf16* QK = (const bf16*)(a.ws + WS_BIG + 3 * T72); const bf16* VV = (const bf16*)(a.ws + WS_BIG + 1 * T72);
    bf16* HF = (bf16*)(a.ws + WS_BIG + 4 * T72); bf16* HB = (bf16*)(a.ws + WS_BIG + 5 * T72);
    const float* Gt = (const float*)(a.ws + WS_GT);
    constexpr int SA = 144, SO = 272, SV = 320;
    constexpr int O_Q = 0, O_K = 9216, O_KW = 18432, O_SC = 27648, O_V = 36864, O_CT = 57344, O_OST = 75776, O_VEC = 93184, O_NP = 95488;
    LAS unsigned char* Qt = lds + O_Q; LAS unsigned char* Kt = lds + O_K; LAS unsigned char* KW = lds + O_KW; LAS unsigned char* SC = lds + O_SC;
    LAS unsigned char* VT = lds + O_V; LAS unsigned char* CT = lds + O_CT; LAS unsigned char* OST = lds + O_OST;
    LAS float* vA = (LAS float*)(lds + O_VEC); LAS float* vM = vA + 64; LAS float* vWI = vM + 64; LAS float* vEMM = vWI + 64; LAS float* vWK = vEMM + 64;
    LAS float* vRI = vWK + 64; LAS float* vWIRI = vRI + 64; LAS float* vN = vWIRI + 64; LAS float* vSC = vN + 64;
    LAS float* NP = (LAS float*)(lds + O_NP);
    for (int i = tid; i < 64 * SA / 4; i += NTHREADS) ((LAS unsigned*)SC)[i] = 0u;
    const int ls = tid >> 4, lc = tid & 15;
    const int qs = tid >> 3, qc = tid & 7;
    const int tq = (lane & 15) >> 2, tp = lane & 3, tblk = (lane >> 4) & 1;
    const LAS unsigned char* tV = VT + (8 * hh + tq) * SV + (16 * tblk + 4 * tp) * 2;
    const LAS unsigned char* tKW = KW + (8 * hh + tq) * SA + (16 * tblk + 4 * tp) * 2;
    const int fr = lane & 15, fq = lane >> 4;
    const int ti = w >> 2, ej = w & 3, di = w >> 2;
    for (int item = blockIdx.x; item < 256; item += gridDim.x) {
        const int dir = item & 1, h = (item >> 1) & 7, b = item >> 4;
        bf16* Hd = dir ? HB : HF;
        const int ci = dir * 8 + h, cf = 16 + dir * 8 + h;
        f32x16 Cs;
#pragma unroll
        for (int i = 0; i < 16; ++i) Cs[i] = 0.f;
        for (int i = tid; i < 128 * SA / 4; i += NTHREADS) ((LAS unsigned*)CT)[i] = 0u;
        if (tid < 64) vN[tid] = 0.f;
        NP[tid] = 0.f;
        float m0 = 0.f, m0n = 0.f, dec_prev = 0.f;
        v4u pq, pk, pv[2]; float pgi = 0.f, pgf = 0.f;
        { const size_t ro = (size_t)seq_row(b, dir, qs) * D; pq = *(const v4u*)(QK + ro + h * 64 + qc * 8); pk = *(const v4u*)(QK + ro + 512 + h * 64 + qc * 8);
#pragma unroll
            for (int x = 0; x < 2; ++x) pv[x] = *(const v4u*)(VV + (size_t)seq_row(b, dir, ls + 32 * x) * D + h * 128 + lc * 8);
            if (tid < 64) { const float* gr = Gt + (size_t)seq_row(b, dir, tid) * 32; pgi = gr[ci]; pgf = gr[cf]; } }
        __syncthreads();
#define ML_S0() do { \
            *(LAS v4u*)(Qt + qs * SA + qc * 16) = pq; *(LAS v4u*)(Kt + qs * SA + qc * 16) = pk; \
            _Pragma("unroll") for (int x = 0; x < 2; ++x) *(LAS v4u*)(VT + (ls + 32 * x) * SV + lc * 16) = pv[x]; \
            if (w == 0) { \
                float np[8]; \
                _Pragma("unroll") for (int o = 0; o < 8; ++o) np[o] = NP[o * 64 + lane]; \
                const float nold = vN[lane]; \
                const float bb = wave_incl_sum(pgf); \
                const float aa = pgi - bb; const float cm = wave_incl_max(aa); \
                const float M = fmaxf(m0, cm), M63 = __shfl(M, 63), bend = __shfl(bb, 63); \
                vA[lane] = aa; vM[lane] = M; vWI[lane] = __expf(m0 - M); vEMM[lane] = __expf(-(bb + M)); vWK[lane] = __expf(aa - M63); \
                const float dec = __expf(m0 - M63); \
                if (lane == 0) vSC[0] = dec; \
                vN[lane] = dec_prev * nold + (((np[0] + np[1]) + (np[2] + np[3])) + ((np[4] + np[5]) + (np[6] + np[7]))); \
                dec_prev = dec; m0n = bend + M63; \
            } } while (0)
        ML_S0();
        for (int ch = 0; ch < (CTX + SEQ) / 64; ++ch) {
            __syncthreads();
            if (ch + 1 < (CTX + SEQ) / 64) { const size_t ro = (size_t)seq_row(b, dir, (ch + 1) * 64 + qs) * D; pq = *(const v4u*)(QK + ro + h * 64 + qc * 8); pk = *(const v4u*)(QK + ro + 512 + h * 64 + qc * 8);
#pragma unroll
                for (int x = 0; x < 2; ++x) pv[x] = *(const v4u*)(VV + (size_t)seq_row(b, dir, (ch + 1) * 64 + ls + 32 * x) * D + h * 128 + lc * 8);
                if (tid < 64) { const float* gr = Gt + (size_t)seq_row(b, dir, (ch + 1) * 64 + tid) * 32; pgi = gr[ci]; pgf = gr[cf]; } }
            {
                const v4u kv = *(const LAS v4u*)(Kt + qs * SA + qc * 16); const float wk = vWK[qs];
#pragma unroll
                for (int rep = 0; rep < 2; ++rep) { const int idx = w + 8 * rep; if (idx < 10) { int ti4, si4; tri_tile(idx, ti4, si4);
                    const bf16x8 A0 = *(const LAS bf16x8*)(Qt + (16 * ti4 + fr) * SA + fq * 16), A1 = *(const LAS bf16x8*)(Qt + (16 * ti4 + fr) * SA + fq * 16 + 64);
                    const bf16x8 B0 = *(const LAS bf16x8*)(Kt + (16 * si4 + fr) * SA + fq * 16), B1 = *(const LAS bf16x8*)(Kt + (16 * si4 + fr) * SA + fq * 16 + 64);
                    const int scol = 16 * si4 + fr; const float as = vA[scol]; const f32x4 M4 = *(const LAS f32x4*)(vM + 16 * ti4 + 4 * fq);
                    f32x4 acc = (f32x4){0.f, 0.f, 0.f, 0.f};
                    acc = __builtin_amdgcn_mfma_f32_16x16x32_bf16(A0, B0, acc, 0, 0, 0); acc = __builtin_amdgcn_mfma_f32_16x16x32_bf16(A1, B1, acc, 0, 0, 0);
#pragma unroll
                    for (int r = 0; r < 4; ++r) { const int trow = 16 * ti4 + 4 * fq + r; *(LAS unsigned short*)(SC + trow * SA + scol * 2) = (unsigned short)f2bf(scol <= trow ? acc[r] * __expf(as - M4[r]) : 0.f); } } }
                const unsigned kx[4] = {kv.x, kv.y, kv.z, kv.w}; v4u o; float kf[8];
#pragma unroll
                for (int j = 0; j < 4; ++j) { kf[2 * j] = bf2f(kx[j] & 0xffffu) * wk; kf[2 * j + 1] = bf2f(kx[j] >> 16) * wk; }
                o.x = pk2(kf[0], kf[1]); o.y = pk2(kf[2], kf[3]); o.z = pk2(kf[4], kf[5]); o.w = pk2(kf[6], kf[7]);
                *(LAS v4u*)(KW + qs * SA + qc * 16) = o; }
            __syncthreads();
            f32x16 accA, accB;
            { const v4u sv = *(const LAS v4u*)(SC + qs * SA + qc * 16), qv = *(const LAS v4u*)(Qt + qs * SA + qc * 16); const f32x4 n0 = *(const LAS f32x4*)(vN + 8 * qc), n1 = *(const LAS f32x4*)(vN + 8 * qc + 4);
                const float wi = vWI[qs], emm = vEMM[qs], dec = vSC[0];
                unsigned short kwc[8];
#pragma unroll
                for (int i = 0; i < 8; ++i) kwc[i] = *(const LAS unsigned short*)(KW + (8 * w + i) * SA + lane * 2);
                bf16x8 A[4], Bm[4], A2[4], B2[4];
#pragma unroll
                for (int kk = 0; kk < 4; ++kk) { A[kk] = *(const LAS bf16x8*)(SC + (32 * ti + r32) * SA + hh * 16 + kk * 32); const LAS unsigned char* pb = tV + kk * 16 * SV + ej * 64; const s16x4 x = tr16(pb), y = tr16(pb + 4 * SV); Bm[kk] = (bf16x8){x[0], x[1], x[2], x[3], y[0], y[1], y[2], y[3]}; }
#pragma unroll
                for (int kk = 0; kk < 4; ++kk) { A2[kk] = *(const LAS bf16x8*)(Qt + (32 * ti + r32) * SA + hh * 16 + kk * 32); B2[kk] = *(const LAS bf16x8*)(CT + (32 * ej + r32) * SA + hh * 16 + kk * 32); }
                const unsigned sx[4] = {sv.x, sv.y, sv.z, sv.w}, qx[4] = {qv.x, qv.y, qv.z, qv.w};
                float ssum = 0.f;
#pragma unroll
                for (int j = 0; j < 4; ++j) { ssum += bf2f(sx[j] & 0xffffu) + bf2f(sx[j] >> 16); }
                const float dot = bf2f(qx[0] & 0xffffu) * n0[0] + bf2f(qx[0] >> 16) * n0[1] + bf2f(qx[1] & 0xffffu) * n0[2] + bf2f(qx[1] >> 16) * n0[3]
                    + bf2f(qx[2] & 0xffffu) * n1[0] + bf2f(qx[2] >> 16) * n1[1] + bf2f(qx[3] & 0xffffu) * n1[2] + bf2f(qx[3] >> 16) * n1[3];
                float part = ssum + wi * dot;
                part += __shfl_xor(part, 1); part += __shfl_xor(part, 2); part += __shfl_xor(part, 4);
                if (qc == 0) { const float rinv = 1.0f / fmaxf(fabsf(part), emm); vRI[qs] = rinv; vWIRI[qs] = wi * rinv; }
                { float cs = 0.f;
#pragma unroll
                    for (int i = 0; i < 8; ++i) cs += bf2f(kwc[i]);
                    NP[w * 64 + lane] = cs; }
#pragma unroll
                for (int i = 0; i < 16; ++i) { accA[i] = 0.f; accB[i] = 0.f; }
#pragma unroll
                for (int kk = 0; kk < 4; ++kk) accA = __builtin_amdgcn_mfma_f32_32x32x16_bf16(A[kk], Bm[kk], accA, 0, 0, 0);
#pragma unroll
                for (int kk = 0; kk < 4; ++kk) { const LAS unsigned char* pa = tKW + kk * 16 * SA + di * 64; const s16x4 x = tr16(pa), y = tr16(pa + 4 * SA); A[kk] = (bf16x8){x[0], x[1], x[2], x[3], y[0], y[1], y[2], y[3]}; }
#pragma unroll
                for (int kk = 0; kk < 4; ++kk) accB = __builtin_amdgcn_mfma_f32_32x32x16_bf16(A2[kk], B2[kk], accB, 0, 0, 0);
#pragma unroll
                for (int i = 0; i < 16; ++i) Cs[i] *= dec;
#pragma unroll
                for (int kk = 0; kk < 4; ++kk) Cs = __builtin_amdgcn_mfma_f32_32x32x16_bf16(A[kk], Bm[kk], Cs, 0, 0, 0); }
            __syncthreads();
            { const int ecol = 32 * ej + r32;
                f32x4 ri[4], wr[4];
#pragma unroll
                for (int g = 0; g < 4; ++g) { ri[g] = *(const LAS f32x4*)(vRI + 32 * ti + 8 * g + 4 * hh); wr[g] = *(const LAS f32x4*)(vWIRI + 32 * ti + 8 * g + 4 * hh); }
#pragma unroll
                for (int g = 0; g < 4; ++g) {
#pragma unroll
                    for (int j = 0; j < 4; ++j) { const int trow = 32 * ti + 8 * g + 4 * hh + j; *(LAS unsigned short*)(OST + trow * SO + ecol * 2) = (unsigned short)f2bf(accA[4 * g + j] * ri[g][j] + accB[4 * g + j] * wr[g][j]); }
                    v2u cw; cw.x = pk2(Cs[4 * g], Cs[4 * g + 1]); cw.y = pk2(Cs[4 * g + 2], Cs[4 * g + 3]);
                    *(LAS v2u*)(CT + ecol * SA + (32 * di + 8 * g + 4 * hh) * 2) = cw; }
                m0 = m0n; }
            __syncthreads();
            if (ch + 1 < (CTX + SEQ) / 64) ML_S0();
            if (ch >= CTX / 64) {
#pragma unroll
                for (int x = 0; x < 2; ++x) { const int row = ls + 32 * x; const v4u val = *(const LAS v4u*)(OST + row * SO + lc * 16);
                    *(v4u*)(Hd + (size_t)seq_row(b, dir, ch * 64 + row) * D + h * 128 + lc * 8) = val; } }
        }
#undef ML_S0
        __syncthreads();
    }
}

template <bool F8> __device__ __forceinline__ void ph_readout(const bf16* Oa, const bf16* Ob, const bf16* gate, const float* g, int R0, int R1, bf16* Y) {
    const int tid = threadIdx.x, lane = tid & 63, wave = __builtin_amdgcn_readfirstlane(tid >> 6);
    const int gw = blockIdx.x * NWAVES + wave, NGW = gridDim.x * NWAVES;
    f32x4 gg[4];
#pragma unroll
    for (int j4 = 0; j4 < 4; ++j4) gg[j4] = *(const f32x4*)(g + lane * 16 + j4 * 4);
    for (int Rq = R0 + gw; Rq < R1; Rq += 2 * NGW) {
        v4u x[2][2], y[2][2], z[2][2];
#pragma unroll
        for (int u = 0; u < 2; ++u) { const int R = (Rq + u * NGW < R1) ? Rq + u * NGW : Rq; const size_t off = (size_t)R * D + lane * 16;
#pragma unroll
            for (int hh = 0; hh < 2; ++hh) { x[u][hh] = *(const v4u*)(Oa + off + hh * 8); y[u][hh] = *(const v4u*)(Ob + off + hh * 8); z[u][hh] = *(const v4u*)(gate + off + hh * 8); } }
        __builtin_amdgcn_sched_barrier(0);
#pragma unroll
        for (int u = 0; u < 2; ++u) { const int R = Rq + u * NGW; const size_t off = (size_t)R * D + lane * 16;
            float o[16], gt[16]; float ss = 0.f;
#pragma unroll
            for (int hh = 0; hh < 2; ++hh) {
                const unsigned xx[4] = {x[u][hh].x, x[u][hh].y, x[u][hh].z, x[u][hh].w}, yy[4] = {y[u][hh].x, y[u][hh].y, y[u][hh].z, y[u][hh].w}, zz[4] = {z[u][hh].x, z[u][hh].y, z[u][hh].z, z[u][hh].w};
#pragma unroll
                for (int j = 0; j < 4; ++j) { o[hh * 8 + 2 * j] = bf2f(xx[j] & 0xffffu) + bf2f(yy[j] & 0xffffu); o[hh * 8 + 2 * j + 1] = bf2f(xx[j] >> 16) + bf2f(yy[j] >> 16);
                    gt[hh * 8 + 2 * j] = bf2f(zz[j] & 0xffffu); gt[hh * 8 + 2 * j + 1] = bf2f(zz[j] >> 16); } }
#pragma unroll
            for (int j = 0; j < 16; ++j) ss += o[j] * o[j];
            ss += __shfl_xor(ss, 1); ss += __shfl_xor(ss, 2); ss += __shfl_xor(ss, 4);
            const float rs = 1.0f / sqrtf(ss * (1.0f / 128.0f) + EPS);
            float yv[16];
#pragma unroll
            for (int j4 = 0; j4 < 4; ++j4)
#pragma unroll
                for (int j = 0; j < 4; ++j) yv[j4 * 4 + j] = o[j4 * 4 + j] * rs * gg[j4][j] * gt[j4 * 4 + j];
            if (F8) { if (R < R1) {
#pragma unroll
                    for (int j = 0; j < 16; ++j) yv[j] = __builtin_amdgcn_fmed3f(yv[j], -448.0f, 448.0f);
                    v4u w; w.x = pk4_fp8(yv[0], yv[1], yv[2], yv[3]); w.y = pk4_fp8(yv[4], yv[5], yv[6], yv[7]); w.z = pk4_fp8(yv[8], yv[9], yv[10], yv[11]); w.w = pk4_fp8(yv[12], yv[13], yv[14], yv[15]);
                    *(v4u*)((unsigned char*)Y + (size_t)R * D + lane * 16) = w; } }
            else if (R < R1) { v4u w0, w1; w0.x = pk2(yv[0], yv[1]); w0.y = pk2(yv[2], yv[3]); w0.z = pk2(yv[4], yv[5]); w0.w = pk2(yv[6], yv[7]);
                w1.x = pk2(yv[8], yv[9]); w1.y = pk2(yv[10], yv[11]); w1.z = pk2(yv[12], yv[13]); w1.w = pk2(yv[14], yv[15]);
                *(v4u*)(Y + off) = w0; *(v4u*)(Y + off + 8) = w1; } }
    }
}

struct MoeTab { LAS int* pstart; LAS int* cnt; LAS int* nblk; LAS int* blkE; };
__device__ __forceinline__ MoeTab moe_tab(LAS unsigned char* lds) { MoeTab t; t.pstart = (LAS int*)(lds + LDS_TAB); t.cnt = t.pstart + 36; t.nblk = t.cnt + 32; t.blkE = t.nblk + 4; return t; }
__device__ __forceinline__ void moe_tables(ArgsRef a, int layer, LAS unsigned char* lds) {
    const MoeTab t = moe_tab(lds);
    const unsigned* cnt = (const unsigned*)(a.ws + WS_CTL) + CW_CNT + 64 * layer;
    __syncthreads();
    if (threadIdx.x < 32) t.cnt[threadIdx.x] = (int)__hip_atomic_load(cnt + threadIdx.x, __ATOMIC_RELAXED, __HIP_MEMORY_SCOPE_AGENT);
    __syncthreads();
    if (threadIdx.x < 64) { const int e = threadIdx.x & 31; const int nb = (t.cnt[e] + 255) >> 8; int incl = nb;
#pragma unroll
        for (int o = 1; o < 32; o <<= 1) { const int v = __shfl_up(incl, o, 32); if (e >= o) incl += v; }
        const int p0 = incl - nb;
        if (threadIdx.x < 32) { t.pstart[e] = p0 * 256; for (int j = 0; j < nb; ++j) t.blkE[p0 + j] = e; if (e == 31) { t.pstart[32] = incl * 256; t.nblk[0] = incl; } } }
    __syncthreads();
}

__device__ __forceinline__ void ph_router(ArgsRef a, const bf16* X, const float* g, int layer, int R0, int R1, bf16* Fout, LAS unsigned char* lds) {
    const int tid = threadIdx.x, lane = tid & 63, wave = __builtin_amdgcn_readfirstlane(tid >> 6), G = gridDim.x;
    const int fr = lane & 15, fq = lane >> 4;
    const float* modl = (const float*)(a.ws + WS_SM + SM_MODL) + (size_t)layer * 16 * 6 * D; const float* modc = (const float*)(a.ws + WS_SM + SM_MODC) + (size_t)layer * 6 * D;
    constexpr int APITCH = 2 * D + 16;
    constexpr int PPITCH = 36;
    LAS unsigned char* Ahi = lds; LAS unsigned char* Alo = lds + 16 * APITCH;
    LAS float* P = (LAS float*)(lds + 32 * APITCH);
    LAS int* cntL = (LAS int*)(lds + LDS_TAB);
    LAS int* baseL = cntL + 32;
    LAS int* infoL = baseL + 32;
    int* slot = (int*)(a.ws + WS_SLOT); float* gate = (float*)(a.ws + WS_GATE); int* rte = (int*)(a.ws + WS_RTE);
    unsigned* cntG = (unsigned*)(a.ws + WS_CTL) + CW_CNT + 64 * layer;
    const float* rw = a.in[I_RW] + (size_t)layer * D * NE; const float* rb = a.in[I_RB] + layer * NE;
    bf16x8 Bh[4][2], Bl[4][2];
#pragma unroll
    for (int kk = 0; kk < 4; ++kk)
#pragma unroll
        for (int nt = 0; nt < 2; ++nt) { v4u h, l;
#pragma unroll
            for (int j = 0; j < 4; ++j) { const float* wp = rw + (size_t)(32 * (4 * wave + kk) + 8 * fq + 2 * j) * NE + 16 * nt + fr; const float w0v = wp[0], w1v = wp[NE];
                const unsigned hh = pk2(w0v, w1v); h[j] = hh; l[j] = pk2(w0v - bf2f(hh & 0xffffu), w1v - bf2f(hh >> 16)); }
            Bh[kk][nt] = __builtin_bit_cast(bf16x8, h); Bl[kk][nt] = __builtin_bit_cast(bf16x8, l); }
    if (tid < 32) cntL[tid] = 0;
    const int nrows = R1 - R0, per = (nrows + G - 1) / G;
    const int w0 = R0 + blockIdx.x * per, w1 = (w0 + per < R1) ? w0 + per : R1;
    const int ntile = (w1 > w0) ? (w1 - w0 + 15) >> 4 : 0;
    __syncthreads();
    v2u xq[2][4]; f32x4 shq[2][4], scq[2][4];
    if (ntile > 0) {
#pragma unroll
        for (int rr = 0; rr < 2; ++rr) { const int R = (w0 + 2 * wave + rr < w1) ? w0 + 2 * wave + rr : w1 - 1;
            const float* mod = (R < NTC) ? modc : modl + (size_t)((R - NTC) / SEQ) * 6 * D;
#pragma unroll
            for (int j = 0; j < 4; ++j) { xq[rr][j] = ((const v2u*)(X + (size_t)R * D))[64 * j + lane]; shq[rr][j] = ((const f32x4*)(mod + 3 * D))[64 * j + lane]; scq[rr][j] = ((const f32x4*)(mod + 4 * D))[64 * j + lane]; } }
    }
    for (int ti = 0; ti < ntile; ++ti) {
        const int r = w0 + 16 * ti + 2 * wave;
#pragma unroll
        for (int rr = 0; rr < 2; ++rr) {
            const int R = (r + rr < w1) ? r + rr : w1 - 1;
            f32x4 v[4]; float ss = 0.f;
#pragma unroll
            for (int j = 0; j < 4; ++j) { const v2u xw = xq[rr][j]; v[j] = (f32x4){bf2f(xw.x & 0xffffu), bf2f(xw.x >> 16), bf2f(xw.y & 0xffffu), bf2f(xw.y >> 16)}; ss += (v[j][0] * v[j][0] + v[j][1] * v[j][1]) + (v[j][2] * v[j][2] + v[j][3] * v[j][3]); }
            const float rs = 1.0f / sqrtf(wave_sum(ss) * (1.0f / D) + EPS);
            unsigned* o8 = (unsigned*)((unsigned char*)Fout + (size_t)R * D);
            LAS unsigned char* ah = Ahi + (2 * wave + rr) * APITCH + 8 * lane; LAS unsigned char* al = Alo + (2 * wave + rr) * APITCH + 8 * lane;
#pragma unroll
            for (int j = 0; j < 4; ++j) { const f32x4 f = v[j] * rs * scq[rr][j] + shq[rr][j];
                if (r + rr < w1) o8[64 * j + lane] = pk4_fp8(f[0], f[1], f[2], f[3]);
                const unsigned h0 = pk2(f[0], f[1]), h1 = pk2(f[2], f[3]);
                *(LAS v2u*)(ah + 512 * j) = (v2u){h0, h1};
                *(LAS v2u*)(al + 512 * j) = (v2u){pk2(f[0] - bf2f(h0 & 0xffffu), f[1] - bf2f(h0 >> 16)), pk2(f[2] - bf2f(h1 & 0xffffu), f[3] - bf2f(h1 >> 16))}; }
            if (ti + 1 < ntile) { const int Rn = (r + 16 + rr < w1) ? r + 16 + rr : w1 - 1;
                const float* mod = (Rn < NTC) ? modc : modl + (size_t)((Rn - NTC) / SEQ) * 6 * D;
#pragma unroll
                for (int j = 0; j < 4; ++j) { xq[rr][j] = ((const v2u*)(X + (size_t)Rn * D))[64 * j + lane]; shq[rr][j] = ((const f32x4*)(mod + 3 * D))[64 * j + lane]; scq[rr][j] = ((const f32x4*)(mod + 4 * D))[64 * j + lane]; } }
        }
        __syncthreads();
        f32x4 acc[2] = {(f32x4){0.f, 0.f, 0.f, 0.f}, (f32x4){0.f, 0.f, 0.f, 0.f}};
#pragma unroll
        for (int kk = 0; kk < 4; ++kk) {
            const bf16x8 ahf = *(const LAS bf16x8*)(Ahi + fr * APITCH + 64 * (4 * wave + kk) + 16 * fq);
            const bf16x8 alf = *(const LAS bf16x8*)(Alo + fr * APITCH + 64 * (4 * wave + kk) + 16 * fq);
#pragma unroll
            for (int nt = 0; nt < 2; ++nt) {
                acc[nt] = __builtin_amdgcn_mfma_f32_16x16x32_bf16(alf, Bh[kk][nt], acc[nt], 0, 0, 0);
                acc[nt] = __builtin_amdgcn_mfma_f32_16x16x32_bf16(ahf, Bl[kk][nt], acc[nt], 0, 0, 0);
                acc[nt] = __builtin_amdgcn_mfma_f32_16x16x32_bf16(ahf, Bh[kk][nt], acc[nt], 0, 0, 0); }
        }
#pragma unroll
        for (int nt = 0; nt < 2; ++nt)
#pragma unroll
            for (int i = 0; i < 4; ++i) P[(wave * 16 + 4 * fq + i) * PPITCH + 16 * nt + fr] = acc[nt][i];
        __syncthreads();
        const int ex = lane & 31;
        float val = rb[ex];
#pragma unroll
        for (int w = 0; w < 8; ++w) val += P[(w * 16 + 2 * wave + (lane >> 5)) * PPITCH + ex];
        const unsigned bits = __float_as_uint(val);
        unsigned key = ((bits ^ ((unsigned)((int)bits >> 31) | 0x80000000u)) & ~31u) | (unsigned)(31 - ex);
        int te[4];
#pragma unroll
        for (int k = 0; k < 4; ++k) { unsigned m = key;
            m = max(m, (unsigned)__builtin_amdgcn_update_dpp((int)m, (int)m, 0x128, 0xf, 0xf, false));
            m = max(m, (unsigned)__builtin_amdgcn_update_dpp((int)m, (int)m, 0x124, 0xf, 0xf, false));
            m = max(m, (unsigned)__builtin_amdgcn_update_dpp((int)m, (int)m, 0x122, 0xf, 0xf, false));
            m = max(m, (unsigned)__builtin_amdgcn_update_dpp((int)m, (int)m, 0x121, 0xf, 0xf, false));
            const auto sw = __builtin_amdgcn_permlane16_swap(m, m, false, false); m = max((unsigned)sw[0], (unsigned)sw[1]);
            te[k] = 31 - (int)(m & 31u); if (ex == te[k]) key = 0u; }
        float tv[4];
#pragma unroll
        for (int k = 0; k < 4; ++k) tv[k] = __shfl(val, (lane & 32) | te[k]);
        const float e1 = __expf(tv[1] - tv[0]), e2 = __expf(tv[2] - tv[0]), e3 = __expf(tv[3] - tv[0]); const float inv = 1.0f / (1.0f + e1 + e2 + e3);
        const int R = r + (lane >> 5);
        if (ex < 4 && R < w1) {
            const int es = ex == 0 ? te[0] : ex == 1 ? te[1] : ex == 2 ? te[2] : te[3];
            const float gs = (ex == 0 ? 1.0f : ex == 1 ? e1 : ex == 2 ? e2 : e3) * inv;
            const int lr = __hip_atomic_fetch_add(cntL + es, 1, __ATOMIC_RELAXED, __HIP_MEMORY_SCOPE_WORKGROUP);
            infoL[(R - w0) * 4 + ex] = es | (lr << 8);
            gate[(size_t)R * 4 + ex] = gs;
        }
    }
    __syncthreads();
    if (tid < 32) baseL[tid] = (int)__hip_atomic_fetch_add(cntG + tid, (unsigned)cntL[tid], __ATOMIC_RELAXED, __HIP_MEMORY_SCOPE_AGENT);
    __syncthreads();
    for (int idx = tid; idx < (w1 - w0) * 4; idx += NTHREADS) { const int info = infoL[idx], e = info & 255, rk = baseL[e] + (info >> 8); const int R = w0 + (idx >> 2);
        slot[(size_t)R * 4 + (idx & 3)] = e | (rk << 8); rte[(size_t)e * NT + rk] = R; }
    __syncthreads();
}
constexpr int LDS_TOK = 131072;
__device__ __forceinline__ void moe_tok_table(ArgsRef a, const pg8::MoeOrder& S, LAS unsigned char* lds) {
    const MoeTab t = moe_tab(lds); LAS int* tokL = (LAS int*)(lds + LDS_TOK); const int* rte = (const int*)(a.ws + WS_RTE);
    const int tid = threadIdx.x;
    int val[14]; bool has[14];
#pragma unroll
    for (int q = 0; q < 14; ++q) { const int i = 2 * q + (tid >> 8); pg8::Unit u; has[q] = S.next(i, u); val[q] = 0;
        if (has[q]) { const int dest = u.pm * 256 + (tid & 255), e = t.blkE[u.pm], rk = dest - t.pstart[e];
            if (rk < t.cnt[e]) val[q] = rte[(size_t)e * NT + rk]; } }
#pragma unroll
    for (int q = 0; q < 14; ++q) { const int i = 2 * q + (tid >> 8); if (has[q]) tokL[i * 256 + (tid & 255)] = val[q]; }
    __syncthreads();
}

template <bool FINAL>
__device__ __forceinline__ void ph_combine(ArgsRef a, int layer, const bf16* Xin, const bf16* Ys, int R0, int R1, bf16* Xout, bf16* Hout, float* outF, LAS unsigned char* lds) {
    moe_tables(a, layer, lds); const MoeTab t = moe_tab(lds);
    const int tid = threadIdx.x, lane = tid & 63, wave = __builtin_amdgcn_readfirstlane(tid >> 6);
    const float* modl = (const float*)(a.ws + WS_SM + SM_MODL) + (size_t)layer * 16 * 6 * D; const float* modc = (const float*)(a.ws + WS_SM + SM_MODC) + (size_t)layer * 6 * D;
    const float* modl2 = (const float*)(a.ws + WS_SM + SM_MODL) + (size_t)1 * 16 * 6 * D; const float* modc2 = (const float*)(a.ws + WS_SM + SM_MODC) + (size_t)1 * 6 * D;
    const int* slot = (const int*)(a.ws + WS_SLOT); const float* gate = (const float*)(a.ws + WS_GATE);
    const int gw = blockIdx.x * NWAVES + wave, NGW = gridDim.x * NWAVES;
    for (int Rq = R0 + gw; Rq < R1; Rq += 2 * NGW) {
        unsigned yv[2][4][4]; v2u xv[2][4]; float gk[2][4];
#pragma unroll
        for (int u = 0; u < 2; ++u) { const int R = (Rq + u * NGW < R1) ? Rq + u * NGW : Rq;
#pragma unroll
            for (int k = 0; k < 4; ++k) { const int info = slot[(size_t)R * 4 + k]; gk[u][k] = gate[(size_t)R * 4 + k] * 0.0625f; const int dest = t.pstart[info & 255] + (info >> 8);
                const unsigned* yr = (const unsigned*)((const unsigned char*)Ys + (size_t)dest * D);
#pragma unroll
                for (int j = 0; j < 4; ++j) yv[u][k][j] = yr[64 * j + lane]; }
#pragma unroll
            for (int j = 0; j < 4; ++j) xv[u][j] = ((const v2u*)(Xin + (size_t)R * D))[64 * j + lane]; }
        __builtin_amdgcn_sched_barrier(0);
#pragma unroll
        for (int u = 0; u < 2; ++u) { const int R = Rq + u * NGW;
            const int Rc = (R < R1) ? R : Rq; const bool isctx = Rc < NTC; const int bidx = isctx ? 0 : (Rc - NTC) / SEQ;
            const float* mod = isctx ? modc : modl + (size_t)bidx * 6 * D;
            f32x4 v[4]; float ss = 0.f;
#pragma unroll
            for (int j = 0; j < 4; ++j) { f32x4 m = (f32x4){0.f, 0.f, 0.f, 0.f};
#pragma unroll
                for (int k = 0; k < 4; ++k) { const unsigned w = yv[u][k][j]; const float g = gk[u][k]; const auto lo = __builtin_amdgcn_cvt_pk_f32_fp8((int)w, false), hi = __builtin_amdgcn_cvt_pk_f32_fp8((int)w, true); m[0] += g * lo[0]; m[1] += g * lo[1]; m[2] += g * hi[0]; m[3] += g * hi[1]; }
                const v2u xw = xv[u][j]; const f32x4 xi = (f32x4){bf2f(xw.x & 0xffffu), bf2f(xw.x >> 16), bf2f(xw.y & 0xffffu), bf2f(xw.y >> 16)};
                v[j] = xi + ((const f32x4*)(mod + 5 * D))[64 * j + lane] * m; ss += (v[j][0] * v[j][0] + v[j][1] * v[j][1]) + (v[j][2] * v[j][2] + v[j][3] * v[j][3]); }
            const float rs = 1.0f / sqrtf(wave_sum(ss) * (1.0f / D) + EPS);
            if (R < R1) {
                if (FINAL) {
                    f32x4* o = (f32x4*)(outF + (size_t)(R - NTC) * D);
#pragma unroll
                    for (int j = 0; j < 4; ++j) o[64 * j + lane] = v[j] * rs * ((const f32x4*)a.in[I_FNG])[64 * j + lane];
                } else {
                    const float* mod2 = isctx ? modc2 : modl2 + (size_t)bidx * 6 * D;
                    v2u* xo = (v2u*)(Xout + (size_t)R * D); v2u* o8 = (v2u*)(Hout + (size_t)R * D);
#pragma unroll
                    for (int j = 0; j < 4; ++j) { { v2u xq; xq.x = pk2(v[j][0], v[j][1]); xq.y = pk2(v[j][2], v[j][3]); xo[64 * j + lane] = xq; }
                        const f32x4 sh = ((const f32x4*)(mod2))[64 * j + lane], sc = ((const f32x4*)(mod2 + D))[64 * j + lane];
                        const f32x4 y = v[j] * rs * sc + sh; v2u w; w.x = pk2(y[0], y[1]); w.y = pk2(y[2], y[3]); o8[64 * j + lane] = w; }
                }
            }
        }
    }
}

__device__ __forceinline__ void ph_conv(ArgsRef a, const bf16* QKR, bf16* QK) {
    const int tid = threadIdx.x;
    const float* cw = a.in[I_MLCW]; const float* cb = a.in[I_MLCB];
    const int c8 = (tid & 127) * 8;
    float w[9][8], bb[8];
#pragma unroll
    for (int t = 0; t < 9; ++t)
#pragma unroll
        for (int j = 0; j < 8; ++j) w[t][j] = cw[t * 1024 + c8 + j];
#pragma unroll
    for (int j = 0; j < 8; ++j) bb[j] = cb[c8 + j];
    const float osc = c8 < 512 ? 0.125f : 1.0f;
    constexpr int NLAT = 16 * 32 * 16, NITEM = NLAT + 16 * 64;
    for (int item = blockIdx.x * 4 + (tid >> 7); item < NITEM; item += gridDim.x * 4) {
        const bool isctx = item >= NLAT;
        int y, x0, rowbase, W;
        if (!isctx) { const int b = item >> 9; y = (item >> 4) & 31; x0 = (item & 15) * 4; rowbase = NTC + b * SEQ + y * 64; W = 64; }
        else { const int it2 = item - NLAT; y = 0; x0 = (it2 & 63) * 4; rowbase = (it2 >> 6) * CTX; W = CTX; }
        if (isctx && c8 < 512) {
#pragma unroll
            for (int pp = 0; pp < 4; ++pp) *(v4u*)(QK + (size_t)(rowbase + x0 + pp) * D + c8) = (v4u){0u, 0u, 0u, 0u};
            continue; }
        v4u win[3][6];
#pragma unroll
        for (int ky = 0; ky < 3; ++ky) { const int yy = y + ky - 1; const bool rv = isctx ? (ky == 1) : (yy >= 0 && yy < 32);
            const int yc = isctx ? 0 : (yy < 0 ? 0 : yy > 31 ? 31 : yy); const int rb = rowbase + (isctx ? 0 : (yc - y) * 64);
#pragma unroll
            for (int c = 0; c < 6; ++c) { const int xx = x0 - 1 + c; const int xc = xx < 0 ? 0 : xx >= W ? W - 1 : xx;
                const v4u x = *(const v4u*)(QKR + (size_t)(rb + xc) * D + c8);
                win[ky][c] = (rv && xx >= 0 && xx < W) ? x : (v4u){0u, 0u, 0u, 0u}; } }
        __builtin_amdgcn_sched_barrier(0);
#pragma unroll
        for (int pp = 0; pp < 4; ++pp) {
            float acc[8];
#pragma unroll
            for (int j = 0; j < 8; ++j) acc[j] = bb[j];
#pragma unroll
            for (int ky = 0; ky < 3; ++ky)
#pragma unroll
                for (int kx = 0; kx < 3; ++kx) { const v4u x = win[ky][pp + kx]; const unsigned xs[4] = {x.x, x.y, x.z, x.w};
#pragma unroll
                    for (int j = 0; j < 4; ++j) { acc[2 * j] += w[ky * 3 + kx][2 * j] * bf2f(xs[j] & 0xffffu); acc[2 * j + 1] += w[ky * 3 + kx][2 * j + 1] * bf2f(xs[j] >> 16); } }
            float yv[8];
#pragma unroll
            for (int j = 0; j < 8; ++j) yv[j] = siluf(acc[j]) * osc;
            v4u o; o.x = pk2(yv[0], yv[1]); o.y = pk2(yv[2], yv[3]); o.z = pk2(yv[4], yv[5]); o.w = pk2(yv[6], yv[7]);
            *(v4u*)(QK + (size_t)(rowbase + x0 + pp) * D + c8) = o; }
    }
}


constexpr int N_PHASES = 21;
__global__ void __launch_bounds__(NTHREADS, 2) fwd(Args a_unused) {
    ArgsRef a = *(const volatile __attribute__((address_space(4))) Args*)__builtin_amdgcn_kernarg_segment_ptr();
    extern __shared__ __attribute__((aligned(16))) unsigned char lds_raw[];
    LAS unsigned char* lds = (LAS unsigned char*)lds_raw;
    const int tid = threadIdx.x, G = gridDim.x;
    unsigned char* ws = a.ws;
    if (tid < 16) ((LAS unsigned*)(lds + LDS_MISC))[tid] = 0u;
    __syncthreads();
    XcdBarrier bar; bar.bar = (unsigned*)(ws + WS_CTL) + CW_BAR; bar.x = 0; bar.st = nullptr;
    const int lo = a.ph_lo, hi = a.ph_hi;
    if (hi - lo > 1) bar = xcd_barrier_post((unsigned*)(ws + WS_CTL) + CW_BAR, (volatile LAS unsigned*)(lds + LDS_MISC));
#ifndef PH_MASK
#define PH_MASK 0xFFFFFFFFu
#endif
#define IN(k) (((PH_MASK >> (k)) & 1u) && lo <= (k) && (k) < hi)
#define SEAM(k) do { if (IN(k) && IN((k) + 1)) xcd_barrier(bar); } while (0)

    bf16* ACT = (bf16*)(ws + WS_ACT);
    bf16* X1 = (bf16*)(ws + WS_X1); bf16* X2 = (bf16*)(ws + WS_X2);
    bf16* BIG = (bf16*)(ws + WS_BIG);
    const float* modl = (const float*)(ws + WS_SM + SM_MODL); const float* modc = (const float*)(ws + WS_SM + SM_MODC); const float* oml = (const float*)(ws + WS_SM + SM_OML);
    bf16* XS = BIG; bf16* HM = (bf16*)(ws + WS_BIG + 304 * MiB);

    if (IN(0)) { {  ph_prologue(a, lds);  } } SEAM(0);
    if (IN(1)) { {  ph_modulate(a, a.in[I_CTX], a.in[I_X], a.in[I_NMIXG], 0, 0, 0, NT, ACT);  } } SEAM(1);
    if (IN(2)) { {  pg8::Gemm g{ACT, (const bf16*)(ws + WS_WHGIN), D}; pg8::StaticOrder S; S.init(NT, HG_N, G, (int)blockIdx.x);
        pg8::EpiHgIn E{BIG, (size_t)NT * D, oml, oml + D}; pg8::gemm_phase<pg8::EpiHgIn, pg8::StaticOrder>(lds, g, S, E);
        if (idle_last_round(S)) expert_tiles<1>(a, lds, 2);  } } SEAM(2);
    if (IN(3)) { {  ph_hg_scan(a, lds);
          } } SEAM(3);
    if (IN(4)) { {  ph_readout<OUTPROJ_FP8>(BIG + (size_t)5 * NT * D, BIG + (size_t)6 * NT * D, BIG + (size_t)4 * NT * D, a.in[I_HGNG], 0, NT, ACT);  } } SEAM(4);
    if (IN(5)) { {  pg8::Gemm g{ACT, (const bf16*)(ws + WS_WHGOUT), D}; pg8::StaticOrder S; S.init(NT, D, G, (int)blockIdx.x);
        pg8::EpiResid<false> E{a.in[I_CTX], a.in[I_X], X1, modc + 2 * D, modl + 2 * D, 0, OUTPROJ_FP8 ? 0.0625f : 1.0f}; pg8::gemm_phase<pg8::EpiResid<false>, pg8::StaticOrder, true, true, false, OUTPROJ_FP8 != 0>(lds, g, S, E);
        if (idle_last_round(S)) expert_tiles<1>(a, lds, OUTPROJ_FP8 ? 1 : 2);  } } SEAM(5);
    if (IN(6)) { {  ph_router(a, X1, a.in[I_NFFNG], 0, 0, NT, ACT, lds);  } } SEAM(6);
    if (IN(8)) { {  moe_tables(a, 0, lds); const MoeTab t = moe_tab(lds);
        pg8::Gemm g{ACT, (const bf16*)(ws + WS_W1), D}; pg8::MoeOrder S{t.nblk[0], 8, G, (int)blockIdx.x, t.blkE}; moe_tok_table(a, S, lds);
        pg8::EpiSwiglu E{HM, a.in[I_B1]}; pg8::gemm_phase<pg8::EpiSwiglu, pg8::MoeOrder, true, true, true, true>(lds, g, S, E, (const LAS int*)(lds + LDS_TOK));
        if (idle_last_round(S)) expert_tiles<1>(a, lds, 1);  } } SEAM(8);
    if (IN(9)) { {  moe_tables(a, 0, lds); const MoeTab t = moe_tab(lds);
        pg8::Gemm g{HM, (const bf16*)(ws + WS_W2), D}; pg8::MoeOrder S{t.nblk[0], 4, G, (int)blockIdx.x, t.blkE};
        pg8::EpiW2 E{XS, a.in[I_B2]}; pg8::gemm_phase<pg8::EpiW2, pg8::MoeOrder, true, true, false, true>(lds, g, S, E);
        if (idle_last_round(S)) expert_tiles<1>(a, lds, 1);  } } SEAM(9);
    if (IN(10)) { {  ph_combine<false>(a, 0, X1, XS, 0, NT, X2, ACT, nullptr, lds);  } } SEAM(10);
    if (IN(11)) { {  pg8::Gemm g{ACT, (const bf16*)(ws + WS_WMLIN), D}; pg8::MlInOrder S; S.init(G, (int)blockIdx.x);
        pg8::EpiMlIn E{BIG, (size_t)NT * D, (float*)(ws + WS_GT), a.in[I_MLBG]}; pg8::gemm_phase<pg8::EpiMlIn, pg8::MlInOrder>(lds, g, S, E);
        expert_tiles<1>(a, lds, 1 << 30);  } } SEAM(11);
    if (IN(12)) { {  ph_conv(a, BIG, BIG + (size_t)3 * NT * D);  } } SEAM(12);
    if (IN(13)) { {  ph_ml_scan(a, lds);  } } SEAM(13);
    if (IN(14)) { {  ph_readout<OUTPROJ_FP8>(BIG + (size_t)4 * NT * D, BIG + (size_t)5 * NT * D, BIG + (size_t)2 * NT * D, a.in[I_MLNG], NTC, NT, ACT);  } } SEAM(14);
    if (IN(15)) { {  pg8::Gemm g{OUTPROJ_FP8 ? (const bf16*)((const unsigned char*)ACT + (size_t)NTC * D) : ACT + (size_t)NTC * D, (const bf16*)(ws + WS_WMLOUT), D}; pg8::StaticOrder S; S.init(NTL, D, G, (int)blockIdx.x);
        pg8::EpiResid<true> E{X2, X2 + (size_t)NTC * D, X1, modc + 6 * D + 2 * D, modl + (size_t)16 * 6 * D + 2 * D, NTC, OUTPROJ_FP8 ? 0.0625f : 1.0f}; pg8::gemm_phase<pg8::EpiResid<true>, pg8::StaticOrder, true, true, false, OUTPROJ_FP8 != 0>(lds, g, S, E);  } } SEAM(15);
    if (IN(16)) { {  ph_router(a, X1, a.in[I_NFFNG] + D, 1, NTC, NT, ACT, lds);  } } SEAM(16);
    if (IN(18)) { {  moe_tables(a, 1, lds); const MoeTab t = moe_tab(lds);
        pg8::Gemm g{ACT, (const bf16*)(ws + WS_W1 + (size_t)32 * 2048 * D), D}; pg8::MoeOrder S{t.nblk[0], 8, G, (int)blockIdx.x, t.blkE}; moe_tok_table(a, S, lds);
        pg8::EpiSwiglu E{HM, a.in[I_B1] + 32 * 2048}; pg8::gemm_phase<pg8::EpiSwiglu, pg8::MoeOrder, true, true, true, true>(lds, g, S, E, (const LAS int*)(lds + LDS_TOK));  } } SEAM(18);
    if (IN(19)) { {  moe_tables(a, 1, lds); const MoeTab t = moe_tab(lds);
        pg8::Gemm g{HM, (const bf16*)(ws + WS_W2 + (size_t)32 * D * D), D}; pg8::MoeOrder S{t.nblk[0], 4, G, (int)blockIdx.x, t.blkE};
        pg8::EpiW2 E{XS, a.in[I_B2] + 32 * D}; pg8::gemm_phase<pg8::EpiW2, pg8::MoeOrder, true, true, false, true>(lds, g, S, E);  } } SEAM(19);
    if (IN(20)) { {  ph_combine<true>(a, 1, X1, XS, NTC, NT, nullptr, nullptr, a.out, lds);  } }
#undef IN
#undef SEAM
}

extern "C" void kernel_launch(void* const* d_in, const int* in_sizes, int n_in, void* d_out, int out_size, void* d_ws, size_t ws_size, hipStream_t stream) {
    static int grid = 0;
    if (grid == 0) {
        if (n_in != 25 || out_size != NTL * D || ws_size < WS_END) { fprintf(stderr, "kernel_launch: unexpected problem (n_in %d, out %d, ws %zu < %zu)\n", n_in, out_size, ws_size, (size_t)WS_END); grid = -1; return; }
        int dev = 0, cus = 0, per_cu = 0;
        if (hipGetDevice(&dev) != hipSuccess || hipDeviceGetAttribute(&cus, hipDeviceAttributeMultiprocessorCount, dev) != hipSuccess) { grid = -1; return; }
        if (hipFuncSetAttribute((const void*)fwd, hipFuncAttributeMaxDynamicSharedMemorySize, LDS_BYTES) != hipSuccess) { fprintf(stderr, "kernel_launch: hipFuncSetAttribute failed\n"); grid = -1; return; }
        if (hipOccupancyMaxActiveBlocksPerMultiprocessor(&per_cu, (const void*)fwd, NTHREADS, LDS_BYTES) != hipSuccess || per_cu < 1) { fprintf(stderr, "kernel_launch: occupancy query says %d blocks per CU\n", per_cu); }
        (void)hipGetLastError();
        grid = cus < 256 ? cus : 256;
    }
    if (grid < 0) return;
    if (hipMemsetAsync((char*)d_ws + WS_CTL, 0, CTL_ZERO_BYTES, stream) != hipSuccess) return;
    Args a{};
    for (int i = 0; i < 25; ++i) a.in[i] = (const float*)d_in[i];
    a.out = (float*)d_out; a.ws = (unsigned char*)d_ws;
#if MK_ONE_LAUNCH
    a.ph_lo = 0; a.ph_hi = N_PHASES;
    hipLaunchKernelGGL(fwd, dim3(grid), dim3(NTHREADS), LDS_BYTES, stream, a);
#else
    for (int p = 0; p < N_PHASES; ++p) { a.ph_lo = p; a.ph_hi = p + 1; hipLaunchKernelGGL(fwd, dim3(grid), dim3(NTHREADS), LDS_BYTES, stream, a); }
#endif
}
```
